# Optimizing an MI355X kernel written in HIP

```python
import jax
import jax.numpy as jnp
from jax import lax
import numpy as np

D_MODEL = 2048
BATCH = 8
SEQ = 2048
DEPTH = 1

MOBA_HEAD_DIM = 128
MOBA_HEADS = D_MODEL // (2 * MOBA_HEAD_DIM)
MOBA_BLOCK = 256
MOBA_TOPK = 3
MOBA_Q_CHUNK = 16
MLA_V_DIM = 128
MLA_HEADS = D_MODEL // (2 * MLA_V_DIM)
MLA_NOPE_DIM = 128
MLA_ROPE_DIM = 64
MLA_Q_RANK = D_MODEL // 4
MLA_KV_RANK = D_MODEL // 4
ATTN_Q_BLOCK = 128
ROPE_THETA = 10000.0
MOBA_WIDTH = MOBA_HEADS * MOBA_HEAD_DIM
MLA_WIDTH = MLA_HEADS * MLA_V_DIM
MIX_WIDTH = MOBA_WIDTH + MLA_WIDTH
IN_WIDTH = 3 * MOBA_WIDTH + MLA_Q_RANK + MLA_KV_RANK + MLA_ROPE_DIM
N_EXPERTS = 64
TOP_K = 8
N_GROUPS = 8
TOPK_GROUPS = 4
EXPERTS_PER_GROUP = N_EXPERTS // N_GROUPS
EXPERT_FF = D_MODEL // 4
SHARED_FF = D_MODEL // 4
ROUTED_SCALE = 2.5
MOE_ROW_BLOCK = 256
LN_EPS = 1e-5
RMS_EPS = 1e-6
DEEPNORM_ALPHA = (2 * DEPTH) ** 0.25
DEEPNORM_BETA = (8 * DEPTH) ** -0.25

kernel_name = "hybrid_moba_mla_moe_deepnorm_block"


def layer_norm(x, g, b):
    xf = x.astype(jnp.float32)
    mu = jnp.mean(xf, axis=-1, keepdims=True)
    var = jnp.mean(jnp.square(xf - mu), axis=-1, keepdims=True)
    return ((xf - mu) * lax.rsqrt(var + LN_EPS)).astype(x.dtype) * g + b


def rms_norm(x, g):
    xf = x.astype(jnp.float32)
    return (xf * lax.rsqrt(jnp.mean(xf * xf, axis=-1, keepdims=True) + RMS_EPS)).astype(x.dtype) * g


def rope_tables(seq, dim):
    inv = 1.0 / (ROPE_THETA ** (jnp.arange(0, dim, 2, dtype=jnp.float32) / dim))
    ang = jnp.arange(seq, dtype=jnp.float32)[:, None] * inv[None, :]
    return jnp.cos(ang), jnp.sin(ang)


def apply_rope(x, cos, sin):
    x1, x2 = jnp.split(x.astype(jnp.float32), 2, axis=-1)
    return jnp.concatenate([x1 * cos - x2 * sin, x2 * cos + x1 * sin], axis=-1).astype(x.dtype)


def moba_attention(q, k, v):
    B, H, S, hd = q.shape
    nb = -(-S // MOBA_BLOCK)
    pad = nb * MOBA_BLOCK - S
    kb = jnp.pad(k, ((0, 0), (0, 0), (0, pad), (0, 0))).reshape(B, H, nb, MOBA_BLOCK, hd)
    vb = jnp.pad(v, ((0, 0), (0, 0), (0, pad), (0, 0))).reshape(B, H, nb, MOBA_BLOCK, hd)
    n_sel = min(MOBA_TOPK, nb - 1)
    scale = hd ** -0.5
    n_chunks = S // MOBA_Q_CHUNK

    def to_chunks(t):
        return jnp.moveaxis(t.reshape(B, H, n_chunks, MOBA_Q_CHUNK, *t.shape[3:]), 2, 0)

    starts = jnp.arange(n_chunks, dtype=jnp.int32) * MOBA_Q_CHUNK
    xs = [to_chunks(q), starts]
    if n_sel > 0:
        k_mean = jnp.mean(kb.astype(jnp.float32), axis=3)
        gate = jnp.einsum('bhsd,bhnd->bhsn', q.astype(jnp.float32), k_mean)
        q_blk = jnp.arange(S, dtype=jnp.int32) // MOBA_BLOCK
        fully_past = jnp.arange(nb, dtype=jnp.int32)[None, :] < q_blk[:, None]
        gate = jnp.where(fully_past, gate, -jnp.inf)
        _, sel = lax.top_k(gate, n_sel)
        xs.append(to_chunks(sel))
    b_idx = jnp.arange(B)[:, None, None, None]
    h_idx = jnp.arange(H)[None, :, None, None]

    def chunk(args):
        q_c, start = args[0], args[1]
        own = start // MOBA_BLOCK
        q_pos = start + jnp.arange(MOBA_Q_CHUNK, dtype=jnp.int32)
        k_pos = own * MOBA_BLOCK + jnp.arange(MOBA_BLOCK, dtype=jnp.int32)
        k_own = lax.dynamic_index_in_dim(kb, own, axis=2, keepdims=False)
        v_own = lax.dynamic_index_in_dim(vb, own, axis=2, keepdims=False)
        s_own = jnp.einsum('bhqd,bhkd->bhqk', q_c, k_own, preferred_element_type=jnp.float32) * scale
        s_own = jnp.where(k_pos[None, :] <= q_pos[:, None], s_own, -jnp.inf)
        if n_sel == 0:
            p = jax.nn.softmax(s_own, axis=-1).astype(v.dtype)
            return jnp.einsum('bhqk,bhkd->bhqd', p, v_own)
        sel_c = args[2]
        k_sel = kb[b_idx, h_idx, sel_c]
        v_sel = vb[b_idx, h_idx, sel_c]
        s_sel = jnp.einsum('bhqd,bhqnkd->bhqnk', q_c, k_sel, preferred_element_type=jnp.float32) * scale
        s_sel = jnp.where((sel_c < own)[..., None], s_sel, -jnp.inf)
        n_keys = n_sel * MOBA_BLOCK
        s_all = jnp.concatenate([s_sel.reshape(B, H, MOBA_Q_CHUNK, n_keys), s_own], axis=-1)
        p = jax.nn.softmax(s_all, axis=-1).astype(v.dtype)
        p_sel = p[..., :n_keys].reshape(B, H, MOBA_Q_CHUNK, n_sel, MOBA_BLOCK)
        return (jnp.einsum('bhqnk,bhqnkd->bhqd', p_sel, v_sel)
                + jnp.einsum('bhqk,bhkd->bhqd', p[..., n_keys:], v_own))

    out = lax.map(chunk, tuple(xs))
    return out.transpose(1, 0, 3, 2, 4).reshape(B, S, H * hd)


def causal_attention(q, k, v, scale):
    B, H, S, _ = q.shape
    dv = v.shape[-1]
    nq = S // ATTN_Q_BLOCK
    qb = jnp.moveaxis(q.reshape(B, H, nq, ATTN_Q_BLOCK, q.shape[-1]), 2, 0)
    k_pos = jnp.arange(S, dtype=jnp.int32)

    def block(args):
        q_blk, start = args
        q_pos = start + jnp.arange(ATTN_Q_BLOCK, dtype=jnp.int32)
        s = jnp.einsum('bhqd,bhkd->bhqk', q_blk, k, preferred_element_type=jnp.float32) * scale
        s = jnp.where(k_pos[None, :] <= q_pos[:, None], s, -jnp.inf)
        p = jax.nn.softmax(s, axis=-1).astype(v.dtype)
        return jnp.einsum('bhqk,bhkd->bhqd', p, v)

    out = lax.map(block, (qb, jnp.arange(nq, dtype=jnp.int32) * ATTN_Q_BLOCK))
    return out.transpose(1, 0, 3, 2, 4).reshape(B, S, H * dv)


def token_mixer(h, w_in, g_cq, w_uq, g_ckv, w_ukv, w_o):
    B, S, _ = h.shape
    proj = h @ w_in
    split_at = [MOBA_WIDTH, 2 * MOBA_WIDTH, 3 * MOBA_WIDTH,
                3 * MOBA_WIDTH + MLA_Q_RANK, 3 * MOBA_WIDTH + MLA_Q_RANK + MLA_KV_RANK]
    q_a, k_a, v_a, c_q, c_kv, k_r = jnp.split(proj, split_at, axis=-1)

    def heads(t, n, d):
        return t.reshape(B, S, n, d).transpose(0, 2, 1, 3)
    cos_a, sin_a = rope_tables(S, MOBA_HEAD_DIM)
    q_a = apply_rope(heads(q_a, MOBA_HEADS, MOBA_HEAD_DIM), cos_a, sin_a)
    k_a = apply_rope(heads(k_a, MOBA_HEADS, MOBA_HEAD_DIM), cos_a, sin_a)
    out_a = moba_attention(q_a, k_a, heads(v_a, MOBA_HEADS, MOBA_HEAD_DIM))

    cos_r, sin_r = rope_tables(S, MLA_ROPE_DIM)
    q_m = heads(rms_norm(c_q, g_cq) @ w_uq, MLA_HEADS, MLA_NOPE_DIM + MLA_ROPE_DIM)
    q_m = jnp.concatenate([q_m[..., :MLA_NOPE_DIM],
                           apply_rope(q_m[..., MLA_NOPE_DIM:], cos_r, sin_r)], axis=-1)
    kv = heads(rms_norm(c_kv, g_ckv) @ w_ukv, MLA_HEADS, MLA_NOPE_DIM + MLA_V_DIM)
    k_rope = jnp.broadcast_to(apply_rope(k_r, cos_r, sin_r)[:, None], (B, MLA_HEADS, S, MLA_ROPE_DIM))
    k_m = jnp.concatenate([kv[..., :MLA_NOPE_DIM], k_rope], axis=-1)
    out_m = causal_attention(q_m, k_m, kv[..., MLA_NOPE_DIM:],
                             (MLA_NOPE_DIM + MLA_ROPE_DIM) ** -0.5)

    return jnp.concatenate([out_a, out_m], axis=-1) @ w_o


def routed_experts(t, expert_idx, expert_w, w_gate, w_up, w_down):
    T, D = t.shape
    TK = T * TOP_K
    flat_e = expert_idx.reshape(-1)
    order = jnp.argsort(flat_e)
    sorted_e = flat_e[order]
    sorted_tok = (order // TOP_K).astype(jnp.int32)
    sorted_w = expert_w.reshape(-1)[order]
    sizes = jnp.bincount(flat_e, length=N_EXPERTS)
    padded = (sizes + MOE_ROW_BLOCK - 1) // MOE_ROW_BLOCK * MOE_ROW_BLOCK
    starts = jnp.cumsum(sizes) - sizes
    pends = jnp.cumsum(padded)
    pstarts = pends - padded
    dest = pstarts[sorted_e] + jnp.arange(TK) - starts[sorted_e]
    n_blocks = -(-TK // MOE_ROW_BLOCK) + N_EXPERTS
    n_rows = n_blocks * MOE_ROW_BLOCK
    row_tok = jnp.full((n_rows,), T, jnp.int32).at[dest].set(sorted_tok)
    row_w = jnp.zeros((n_rows,), t.dtype).at[dest].set(sorted_w.astype(t.dtype))
    block_start = jnp.arange(n_blocks) * MOE_ROW_BLOCK
    block_e = jnp.minimum(jnp.searchsorted(pends, block_start, side='right'), N_EXPERTS - 1)
    t_pad = jnp.concatenate([t, jnp.zeros((1, D), t.dtype)], axis=0)

    def block(args):
        toks, e = args
        xb = t_pad[toks]
        hb = jax.nn.silu(xb @ w_gate[e]) * (xb @ w_up[e])
        return hb @ w_down[e]

    y = lax.map(block, (row_tok.reshape(n_blocks, MOE_ROW_BLOCK), block_e))
    y = y.reshape(n_rows, D) * row_w[:, None]
    return jax.ops.segment_sum(y, row_tok, num_segments=T + 1)[:T]


def moe_ffn(h, w_router, router_bias, w_gate, w_up, w_down, ws_gate, ws_up, ws_down):
    B, S, D = h.shape
    t = h.reshape(B * S, D)
    T = t.shape[0]
    scores = jax.nn.sigmoid((t @ w_router).astype(jnp.float32))
    sel_scores = scores + router_bias.astype(jnp.float32)
    grp_score = lax.top_k(sel_scores.reshape(T, N_GROUPS, EXPERTS_PER_GROUP), 2)[0].sum(-1)
    _, grp_idx = lax.top_k(grp_score, TOPK_GROUPS)
    grp_mask = jnp.any(grp_idx[..., None] == jnp.arange(N_GROUPS), axis=-2)
    masked = jnp.where(jnp.repeat(grp_mask, EXPERTS_PER_GROUP, axis=-1), sel_scores, -jnp.inf)
    _, expert_idx = lax.top_k(masked, TOP_K)
    w = jnp.take_along_axis(scores, expert_idx, axis=-1)
    w = w / jnp.sum(w, axis=-1, keepdims=True) * ROUTED_SCALE
    routed = routed_experts(t, expert_idx, w, w_gate, w_up, w_down)
    shared = (jax.nn.silu(t @ ws_gate) * (t @ ws_up)) @ ws_down
    return (routed + shared).reshape(B, S, D)


def hybrid_layer(x, c, w_ada, b_ada, w_in, g_cq, w_uq, g_ckv, w_ukv, w_o, ln1_g, ln1_b,
                 w_router, router_bias, w_gate, w_up, w_down, ws_gate, ws_up, ws_down, ln2_g, ln2_b):
    mod = jax.nn.silu(c) @ w_ada + b_ada
    sh1, sc1, g1, sh2, sc2, g2 = [m[:, None, :] for m in jnp.split(mod, 6, axis=-1)]
    h = x * (1 + sc1) + sh1
    x = layer_norm(DEEPNORM_ALPHA * x + (1 + g1) * token_mixer(h, w_in, g_cq, w_uq, g_ckv, w_ukv, w_o),
                   ln1_g, ln1_b)
    h = x * (1 + sc2) + sh2
    x = layer_norm(DEEPNORM_ALPHA * x + (1 + g2) * moe_ffn(h, w_router, router_bias, w_gate, w_up, w_down,
                                                           ws_gate, ws_up, ws_down),
                   ln2_g, ln2_b)
    return x


def setup_inputs(seed: int = 0) -> dict:
    key = jax.random.key(seed)
    ks = jax.random.split(key, 24)
    L, D = DEPTH, D_MODEL

    def nrm(k, shape, s):
        return jax.random.normal(k, shape, jnp.float32) * s

    x = nrm(ks[0], (BATCH, SEQ, D), 1.0)
    c = nrm(ks[1], (BATCH, D), 1.0)
    w_ada = nrm(ks[2], (L, D, 6 * D), 0.5 * D ** -0.5)
    b_ada = nrm(ks[3], (L, 6 * D), 0.02)
    w_in = nrm(ks[4], (L, D, IN_WIDTH), D ** -0.5)
    w_in = w_in.at[:, :, 2 * MOBA_WIDTH:3 * MOBA_WIDTH].multiply(DEEPNORM_BETA)
    g_cq = 1.0 + nrm(ks[5], (L, MLA_Q_RANK), 0.05)
    w_uq = nrm(ks[6], (L, MLA_Q_RANK, MLA_HEADS * (MLA_NOPE_DIM + MLA_ROPE_DIM)), MLA_Q_RANK ** -0.5)
    g_ckv = 1.0 + nrm(ks[7], (L, MLA_KV_RANK), 0.05)
    kv_col_scale = jnp.concatenate([jnp.ones((MLA_NOPE_DIM,), jnp.float32),
                                    jnp.full((MLA_V_DIM,), DEEPNORM_BETA, jnp.float32)])
    w_ukv = (nrm(ks[8], (L, MLA_KV_RANK, MLA_HEADS, MLA_NOPE_DIM + MLA_V_DIM), MLA_KV_RANK ** -0.5)
             * kv_col_scale).reshape(L, MLA_KV_RANK, MLA_HEADS * (MLA_NOPE_DIM + MLA_V_DIM))
    w_o = nrm(ks[9], (L, MIX_WIDTH, D), MIX_WIDTH ** -0.5 * DEEPNORM_BETA)
    ln1_g = 1.0 + nrm(ks[10], (L, D), 0.05)
    ln1_b = nrm(ks[11], (L, D), 0.02)
    w_router = nrm(ks[12], (L, D, N_EXPERTS), D ** -0.5)
    router_bias = nrm(ks[13], (L, N_EXPERTS), 0.01)
    w_gate = nrm(ks[14], (L, N_EXPERTS, D, EXPERT_FF), D ** -0.5)
    w_up = nrm(ks[15], (L, N_EXPERTS, D, EXPERT_FF), D ** -0.5)
    w_down = nrm(ks[16], (L, N_EXPERTS, EXPERT_FF, D), EXPERT_FF ** -0.5 * DEEPNORM_BETA)
    ws_gate = nrm(ks[17], (L, D, SHARED_FF), D ** -0.5)
    ws_up = nrm(ks[18], (L, D, SHARED_FF), D ** -0.5)
    ws_down = nrm(ks[19], (L, SHARED_FF, D), SHARED_FF ** -0.5 * DEEPNORM_BETA)
    ln2_g = 1.0 + nrm(ks[20], (L, D), 0.05)
    ln2_b = nrm(ks[21], (L, D), 0.02)
    return {"x": x, "c": c, "w_ada": w_ada, "b_ada": b_ada, "w_in": w_in, "g_cq": g_cq,
            "w_uq": w_uq, "g_ckv": g_ckv, "w_ukv": w_ukv, "w_o": w_o, "ln1_g": ln1_g,
            "ln1_b": ln1_b, "w_router": w_router, "router_bias": router_bias, "w_gate": w_gate,
            "w_up": w_up, "w_down": w_down, "ws_gate": ws_gate, "ws_up": ws_up,
            "ws_down": ws_down, "ln2_g": ln2_g, "ln2_b": ln2_b}


def reference(x, c, w_ada, b_ada, w_in, g_cq, w_uq, g_ckv, w_ukv, w_o, ln1_g, ln1_b,
              w_router, router_bias, w_gate, w_up, w_down, ws_gate, ws_up, ws_down, ln2_g, ln2_b):
    for l in range(DEPTH):
        x = hybrid_layer(x, c, w_ada[l], b_ada[l], w_in[l], g_cq[l], w_uq[l], g_ckv[l], w_ukv[l],
                         w_o[l], ln1_g[l], ln1_b[l], w_router[l], router_bias[l], w_gate[l],
                         w_up[l], w_down[l], ws_gate[l], ws_up[l], ws_down[l], ln2_g[l], ln2_b[l])
    return x
```

```cpp
#define MK_N_LAUNCHES 1
#include <hip/hip_runtime.h>
#include <stdint.h>
#include <stdio.h>

constexpr int Bn = 8, S = 2048, D = 2048, T = Bn * S;
constexpr int INW = 4160;
constexpr float ALPHA = 1.189207115002721f;
constexpr size_t MiB = 1u << 20;
namespace nv {

__device__ __forceinline__ float wsum(float v) {
#pragma unroll
    for (int o = 1; o < 64; o <<= 1) v += __shfl_xor(v, o);
    return v;
}
__device__ __forceinline__ float wmax(float v) {
#pragma unroll
    for (int o = 1; o < 64; o <<= 1) v = fmaxf(v, __shfl_xor(v, o));
    return v;
}

__global__ __launch_bounds__(256) void k_mod(const float* __restrict__ c, const float* __restrict__ w_ada, const float* __restrict__ b_ada, float* __restrict__ mod) {
    const int col = blockIdx.x * 256 + threadIdx.x, b = blockIdx.y;
    float acc = b_ada[col];
    for (int k = 0; k < D; ++k) { const float v = c[b * D + k]; const float s = v / (1.f + expf(-v)); acc += s * w_ada[(size_t)k * 6 * D + col]; }
    mod[b * 6 * D + col] = acc;
}
__global__ void k_rope_tab(float2* cs128, float2* cs64) {
    const int idx = blockIdx.x * 256 + threadIdx.x;
    if (idx < S * 64) { const int pos = idx / 64, i = idx % 64; const float inv = (float)(1.0 / pow(10000.0, (double)(2 * i) / 128.0)); const float a = (float)pos * inv; cs128[idx] = make_float2((float)cos((double)a), (float)sin((double)a)); }
    if (idx < S * 32) { const int pos = idx / 32, i = idx % 32; const float inv = (float)(1.0 / pow(10000.0, (double)(2 * i) / 64.0)); const float a = (float)pos * inv; cs64[idx] = make_float2((float)cos((double)a), (float)sin((double)a)); }
}
__global__ __launch_bounds__(256) void k_modulate(const float* __restrict__ x, const float* __restrict__ mod, int sh_off, int sc_off, float* __restrict__ h) {
    const size_t i = (size_t)blockIdx.x * 256 + threadIdx.x; const int d = (int)(i % D); const int b = (int)(i / ((size_t)S * D));
    h[i] = x[i] * (1.f + mod[b * 6 * D + sc_off + d]) + mod[b * 6 * D + sh_off + d];
}

template <int MODE, bool REL>
__global__ __launch_bounds__(256) void k_gemm(const float* __restrict__ A, const float* __restrict__ Bm, float* __restrict__ C, int M, int N, int K, int lda, int ldb, int ldc,
                                              const int* __restrict__ list, const float* __restrict__ wts, const int* __restrict__ starts, const int* __restrict__ cnts, int e) {
    int m_total = M, off = 0;
    if (MODE) { off = starts[e]; m_total = cnts[e]; }
    const int m0 = blockIdx.y * 64, n0 = blockIdx.x * 64;
    if (m0 >= m_total) return;
    __shared__ float As[16][65];
    __shared__ float Bs[16][64];
    const int tid = threadIdx.x, tx = tid & 15, ty = tid >> 4;
    const int ar = tid >> 2, ak = (tid & 3) * 4;
    const int bk = tid >> 4, bn = (tid & 15) * 4;
    const int r = m0 + ar; const bool av = r < m_total;
    size_t arow = 0;
    if (av) { if (MODE == 1) arow = (size_t)list[off + r]; else if (MODE == 2) arow = (size_t)(REL ? r : off + r); else arow = (size_t)r; }
    const float* ap = A + arow * lda + ak;
    const float* bp = Bm + (size_t)bk * ldb + n0 + bn;
    float acc[4][4];
#pragma unroll
    for (int i = 0; i < 4; ++i)
#pragma unroll
        for (int j = 0; j < 4; ++j) acc[i][j] = 0.f;
    for (int k0 = 0; k0 < K; k0 += 16) {
        float4 a4 = av ? *(const float4*)(ap + k0) : make_float4(0.f, 0.f, 0.f, 0.f);
        float4 b4 = *(const float4*)(bp + (size_t)k0 * ldb);
        __syncthreads();
        As[ak + 0][ar] = a4.x; As[ak + 1][ar] = a4.y; As[ak + 2][ar] = a4.z; As[ak + 3][ar] = a4.w;
        *(float4*)&Bs[bk][bn] = b4;
        __syncthreads();
#pragma unroll
        for (int kk = 0; kk < 16; ++kk) {
            float a[4], b[4];
#pragma unroll
            for (int i = 0; i < 4; ++i) a[i] = As[kk][ty * 4 + i];
#pragma unroll
            for (int j = 0; j < 4; ++j) b[j] = Bs[kk][tx * 4 + j];
#pragma unroll
            for (int i = 0; i < 4; ++i)
#pragma unroll
                for (int j = 0; j < 4; ++j) acc[i][j] = fmaf(a[i], b[j], acc[i][j]);
        }
    }
#pragma unroll
    for (int i = 0; i < 4; ++i) {
        const int rr = m0 + ty * 4 + i; if (rr >= m_total) continue;
        if (MODE == 2) { const int tok = list[off + rr]; const float w = wts[off + rr]; float* cp = C + (size_t)tok * ldc + n0 + tx * 4;
#pragma unroll
            for (int j = 0; j < 4; ++j) cp[j] += w * acc[i][j]; }
        else { float* cp = C + (size_t)((MODE == 1 && !REL) ? off + rr : rr) * ldc + n0 + tx * 4; *(float4*)cp = make_float4(acc[i][0], acc[i][1], acc[i][2], acc[i][3]); }
    }
}

__global__ __launch_bounds__(256) void k_rope_proj(float* __restrict__ proj, const float2* __restrict__ cs128, const float2* __restrict__ cs64) {
    const int t = blockIdx.x, pos = t % S; float* row = proj + (size_t)t * INW;
    for (int idx = threadIdx.x; idx < 2 * 8 * 64 + 32; idx += 256) {
        if (idx < 1024) { const int which = idx >> 9, h = (idx >> 6) & 7, i = idx & 63; float* p = row + which * 1024 + h * 128; const float2 c = cs128[pos * 64 + i];
            const float x1 = p[i], x2 = p[i + 64]; p[i] = x1 * c.x - x2 * c.y; p[i + 64] = x2 * c.x + x1 * c.y; }
        else { const int i = idx - 1024; float* p = row + 4096; const float2 c = cs64[pos * 32 + i];
            const float x1 = p[i], x2 = p[i + 32]; p[i] = x1 * c.x - x2 * c.y; p[i + 32] = x2 * c.x + x1 * c.y; }
    }
}
__global__ __launch_bounds__(256) void k_rope_qm(float* __restrict__ qm, const float2* __restrict__ cs64) {
    const int t = blockIdx.x, pos = t % S; const int h = threadIdx.x >> 5, i = threadIdx.x & 31;
    float* p = qm + (size_t)t * 1536 + h * 192 + 128; const float2 c = cs64[pos * 32 + i];
    const float x1 = p[i], x2 = p[i + 32]; p[i] = x1 * c.x - x2 * c.y; p[i + 32] = x2 * c.x + x1 * c.y;
}
__global__ __launch_bounds__(128) void k_kmean(const float* __restrict__ proj, float* __restrict__ kmean) {
    const int n = blockIdx.x & 7, h = (blockIdx.x >> 3) & 7, b = blockIdx.x >> 6, d = threadIdx.x;
    float s = 0.f;
    for (int j = 0; j < 256; ++j) s += proj[(size_t)(b * S + n * 256 + j) * INW + 1024 + h * 128 + d];
    kmean[((b * 8 + h) * 8 + n) * 128 + d] = s * (1.f / 256.f);
}
__global__ __launch_bounds__(256) void k_rms(const float* __restrict__ proj, int col0, const float* __restrict__ g, float* __restrict__ dst) {
    const int wave = threadIdx.x >> 6, lane = threadIdx.x & 63; const int t = blockIdx.x * 4 + wave;
    const float* p = proj + (size_t)t * INW + col0; float v[8]; float ss = 0.f;
#pragma unroll
    for (int j = 0; j < 8; ++j) { v[j] = p[lane + 64 * j]; ss += v[j] * v[j]; }
    ss = wsum(ss); const float r = 1.f / sqrtf(ss * (1.f / 512.f) + 1e-6f);
#pragma unroll
    for (int j = 0; j < 8; ++j) dst[(size_t)t * 512 + lane + 64 * j] = v[j] * r * g[lane + 64 * j];
}

template <bool MOBA>
__global__ __launch_bounds__(256) void k_attn(const float* __restrict__ proj, const float* __restrict__ qm, const float* __restrict__ kv, const float* __restrict__ kmean, float* __restrict__ mix) {
    constexpr int DK = MOBA ? 128 : 192, MAXK = MOBA ? 1024 : 2048;
    __shared__ float qs[4][192];
    __shared__ float sc[4][MAXK];
    const int wave = threadIdx.x >> 6, lane = threadIdx.x & 63;
    const int gid = blockIdx.x * 4 + wave; const int h = gid & 7, t = gid >> 3, b = t / S, s = t % S;
    const float* qrow = MOBA ? proj + (size_t)t * INW + h * 128 : qm + (size_t)t * 1536 + h * 192;
    for (int d = lane; d < DK; d += 64) qs[wave][d] = qrow[d];
    __syncthreads();
    const float* q = qs[wave];
    const int own = s >> 8;
    int nkeys = 0;
    unsigned att = 0;
    if (MOBA) {
        float g[8];
#pragma unroll
        for (int n = 0; n < 8; ++n) { const float* km = kmean + ((b * 8 + h) * 8 + n) * 128; float p = q[lane] * km[lane] + q[lane + 64] * km[lane + 64]; g[n] = wsum(p); }
#pragma unroll
        for (int n = 0; n < 8; ++n) { if (n < own) { int rank = 0;
#pragma unroll
                for (int j = 0; j < 8; ++j) if (j < own && (g[j] > g[n] || (g[j] == g[n] && j < n))) ++rank;
                if (rank < 3) att |= 1u << n; } }
    }
    const float scale = MOBA ? 0.08838834764831845f : 0.07216878364870323f;
    float mx = -__builtin_inff();
    if (MOBA) {
        for (int n = 0; n <= own; ++n) {
            if (n < own && !((att >> n) & 1u)) continue;
            const int cnt = (n < own) ? 256 : (s - own * 256 + 1);
            for (int j = lane; j < cnt; j += 64) { const float* kr = proj + (size_t)(b * S + n * 256 + j) * INW + 1024 + h * 128; float a = 0.f;
                for (int d = 0; d < 128; d += 4) { const float4 kk = *(const float4*)(kr + d); a += q[d] * kk.x + q[d + 1] * kk.y + q[d + 2] * kk.z + q[d + 3] * kk.w; }
                a *= scale; sc[wave][nkeys + j] = a; mx = fmaxf(mx, a); }
            nkeys += cnt;
        }
    } else {
        nkeys = s + 1;
        for (int j = lane; j < nkeys; j += 64) { const float* kn = kv + (size_t)(b * S + j) * 2048 + h * 256; const float* kr = proj + (size_t)(b * S + j) * INW + 4096; float a = 0.f;
            for (int d = 0; d < 128; d += 4) { const float4 kk = *(const float4*)(kn + d); a += q[d] * kk.x + q[d + 1] * kk.y + q[d + 2] * kk.z + q[d + 3] * kk.w; }
            for (int d = 0; d < 64; d += 4) { const float4 kk = *(const float4*)(kr + d); a += q[128 + d] * kk.x + q[129 + d] * kk.y + q[130 + d] * kk.z + q[131 + d] * kk.w; }
            a *= scale; sc[wave][j] = a; mx = fmaxf(mx, a); }
    }
    mx = wmax(mx);
    float sum = 0.f;
    for (int j = lane; j < nkeys; j += 64) { const float p = expf(sc[wave][j] - mx); sc[wave][j] = p; sum += p; }
    sum = wsum(sum);
    __syncthreads();
    const float inv = 1.f / sum;
    float o0 = 0.f, o1 = 0.f;
    if (MOBA) {
        int e = 0;
        for (int n = 0; n <= own; ++n) {
            if (n < own && !((att >> n) & 1u)) continue;
            const int cnt = (n < own) ? 256 : (s - own * 256 + 1);
            for (int j = 0; j < cnt; ++j) { const float p = sc[wave][e + j]; const float* vr = proj + (size_t)(b * S + n * 256 + j) * INW + 2048 + h * 128; o0 += p * vr[lane]; o1 += p * vr[lane + 64]; }
            e += cnt;
        }
        float* orow = mix + (size_t)t * 2048 + h * 128; orow[lane] = o0 * inv; orow[lane + 64] = o1 * inv;
    } else {
        for (int j = 0; j < nkeys; ++j) { const float p = sc[wave][j]; const float* vr = kv + (size_t)(b * S + j) * 2048 + h * 256 + 128; o0 += p * vr[lane]; o1 += p * vr[lane + 64]; }
        float* orow = mix + (size_t)t * 2048 + 1024 + h * 128; orow[lane] = o0 * inv; orow[lane + 64] = o1 * inv;
    }
}

__global__ __launch_bounds__(256) void k_ln(const float* __restrict__ xres, const float* __restrict__ f, const float* __restrict__ mod, int gate_off, const float* __restrict__ lg, const float* __restrict__ lb,
                                            float* __restrict__ xo, float* __restrict__ h, int sh_off, int sc_off) {
    const int wave = threadIdx.x >> 6, lane = threadIdx.x & 63; const int t = blockIdx.x * 4 + wave, b = t / S;
    const float* m = mod + b * 6 * D;
    float v[32]; float s1 = 0.f;
#pragma unroll
    for (int j = 0; j < 32; ++j) { const int d = lane + 64 * j; v[j] = ALPHA * xres[(size_t)t * D + d] + (1.f + m[gate_off + d]) * f[(size_t)t * D + d]; s1 += v[j]; }
    const float mu = wsum(s1) * (1.f / D); float s2 = 0.f;
#pragma unroll
    for (int j = 0; j < 32; ++j) { v[j] -= mu; s2 += v[j] * v[j]; }
    const float r = 1.f / sqrtf(wsum(s2) * (1.f / D) + 1e-5f);
#pragma unroll
    for (int j = 0; j < 32; ++j) { const int d = lane + 64 * j; const float o = v[j] * r * lg[d] + lb[d]; xo[(size_t)t * D + d] = o; if (h) h[(size_t)t * D + d] = o * (1.f + m[sc_off + d]) + m[sh_off + d]; }
}
__global__ __launch_bounds__(256) void k_silu_mul(float* __restrict__ g, const float* __restrict__ u, const int* __restrict__ cnts, int e) {
    const size_t i = (size_t)blockIdx.x * 256 + threadIdx.x; const int row = (int)(i / 512);
    if (row >= cnts[e]) return;
    const float a = g[i]; g[i] = a / (1.f + expf(-a)) * u[i];
}
__global__ __launch_bounds__(256) void k_zero(float* p, size_t n) { const size_t i = (size_t)blockIdx.x * 256 + threadIdx.x; if (i < n) p[i] = 0.f; }
__global__ __launch_bounds__(256) void k_iota(int* list, float* w, int* starts, int* cnts) { const int i = blockIdx.x * 256 + threadIdx.x; if (i < T) { list[i] = i; w[i] = 1.f; } if (i == 0) { starts[0] = 0; cnts[0] = T; } }

}
namespace rt {
__device__ __forceinline__ void route_token(const float logit, const float bias, int lane, unsigned long long& mask, float& w) {
    const float score = 1.f / (1.f + expf(-logit));
    const float sel = score + bias;
    const int gbase = lane & ~7;
    int r = 0;
#pragma unroll
    for (int k = 0; k < 8; ++k) { const float o = __shfl(sel, gbase + k); const int j = gbase + k; r += (o > sel || (o == sel && j < lane)) ? 1 : 0; }
    float gs = (r < 2) ? sel : 0.f;
    gs += __shfl_xor(gs, 1); gs += __shfl_xor(gs, 2); gs += __shfl_xor(gs, 4);
    const int g = lane >> 3; int gr = 0;
#pragma unroll
    for (int k = 0; k < 8; ++k) { const float o = __shfl(gs, 8 * k); gr += (o > gs || (o == gs && k < g)) ? 1 : 0; }
    const float m = (gr < 4) ? sel : -__builtin_inff();
    int er = 0;
    for (int k = 0; k < 64; ++k) { const float o = __shfl(m, k); er += (o > m || (o == m && k < lane)) ? 1 : 0; }
    const bool chosen = er < 8;
    mask = __ballot(chosen);
    float ws = chosen ? score : 0.f;
#pragma unroll
    for (int o = 1; o < 64; o <<= 1) ws += __shfl_xor(ws, o);
    w = chosen ? score / ws * 2.5f : 0.f;
}
__device__ __forceinline__ void route_block(int blk, const float* __restrict__ logits, const float* __restrict__ rbias, unsigned long long* __restrict__ tokmask, float* __restrict__ tw, int* __restrict__ hist,
                                            unsigned long long* lds_mask  , int nwaves) {
    const int wave = threadIdx.x >> 6, lane = threadIdx.x & 63;
    const float bias = rbias[lane];
    for (int i = wave; i < 64; i += nwaves) {
        const int t = blk * 64 + i; unsigned long long mask; float w;
        route_token(logits[(size_t)t * 64 + lane], bias, lane, mask, w);
        tw[(size_t)t * 64 + lane] = w;
        if (lane == 0) { tokmask[t] = mask; lds_mask[i] = mask; }
    }
    __syncthreads();
    if (threadIdx.x < 64) { int c = 0; for (int i = 0; i < 64; ++i) c += (int)((lds_mask[i] >> threadIdx.x) & 1ull); hist[blk * 64 + threadIdx.x] = c; }
    __syncthreads();
}
__device__ __forceinline__ void scatter_block(int blk, const int* __restrict__ hist, const unsigned long long* __restrict__ tokmask, const float* __restrict__ tw,
                                              int* __restrict__ stok, float* __restrict__ sw, int* __restrict__ tokpos, int* __restrict__ starts, int* __restrict__ cnts, int* lds_i  ) {
    const int e = threadIdx.x;
    if (e < 64) { int tot = 0, before = 0; for (int b = 0; b < 256; ++b) { const int c = hist[b * 64 + e]; tot += c; if (b < blk) before += c; }
        lds_i[e] = tot; lds_i[64 + e] = before; }
    __syncthreads();
    if (e < 64) { int st = 0; for (int j = 0; j < e; ++j) st += lds_i[j];
        if (blk == 0) { starts[e] = st; cnts[e] = lds_i[e]; }
        int pos = st + lds_i[64 + e];
        for (int i = 0; i < 64; ++i) { const int t = blk * 64 + i; const unsigned long long m = tokmask[t];
            if ((m >> e) & 1ull) { stok[pos] = t; sw[pos] = tw[(size_t)t * 64 + e]; tokpos[t * 8 + __popcll(m & ((1ull << e) - 1ull))] = pos; ++pos; } } }
    __syncthreads();
}
__global__ __launch_bounds__(256) void k_route(const float* logits, const float* rbias, unsigned long long* tokmask, float* tw, int* hist) {
    __shared__ unsigned long long lm[64];
    route_block(blockIdx.x, logits, rbias, tokmask, tw, hist, lm, 4);
}
__global__ __launch_bounds__(256) void k_scatter(const int* hist, const unsigned long long* tokmask, const float* tw, int* stok, float* sw, int* tokpos, int* starts, int* cnts) {
    __shared__ int li[128];
    scatter_block(blockIdx.x, hist, tokmask, tw, stok, sw, tokpos, starts, cnts, li);
}
}
namespace nvh {
constexpr size_t O_MOD = 0;
constexpr size_t O_CS128 = 1 * MiB;
constexpr size_t O_CS64 = 2 * MiB;
constexpr size_t O_KMEAN = 3 * MiB;
constexpr size_t O_HIST = 4 * MiB;
constexpr size_t O_STARTS = 4 * MiB + 128 * 1024;
constexpr size_t O_CNTS = 4 * MiB + 192 * 1024;
constexpr size_t O_TOKMASK = 5 * MiB;
constexpr size_t O_TOKPOS = 6 * MiB;
constexpr size_t O_STOK = 7 * MiB;
constexpr size_t O_SW = 8 * MiB;
constexpr size_t O_TW = 9 * MiB;
constexpr size_t O_LOGITS = 13 * MiB;
constexpr size_t O_SHLIST = 17 * MiB;
constexpr size_t O_R1 = 20 * MiB;
constexpr size_t O_PROJ = 148 * MiB;
constexpr size_t O_CQN = O_R1;
constexpr size_t O_CKVN = O_R1 + 32 * MiB;
constexpr size_t O_QM = 408 * MiB;
constexpr size_t O_KV = 504 * MiB;
constexpr size_t O_GE = O_PROJ + 128 * MiB;
constexpr size_t O_END = 632 * MiB;
struct Hooks { void (*after_mod)(void*, hipStream_t); void (*after_proj)(void*, hipStream_t); void (*after_mla)(void*, hipStream_t); void (*after_attn)(void*, hipStream_t); void* ctx; };

static void run(void* const* d_in, float* out, unsigned char* ws, hipStream_t st, const Hooks* hk = nullptr) {
    const float *x = (const float*)d_in[0], *c = (const float*)d_in[1], *w_ada = (const float*)d_in[2], *b_ada = (const float*)d_in[3], *w_in = (const float*)d_in[4], *g_cq = (const float*)d_in[5],
                *w_uq = (const float*)d_in[6], *g_ckv = (const float*)d_in[7], *w_ukv = (const float*)d_in[8], *w_o = (const float*)d_in[9], *ln1_g = (const float*)d_in[10], *ln1_b = (const float*)d_in[11],
                *w_router = (const float*)d_in[12], *rbias = (const float*)d_in[13], *w_gate = (const float*)d_in[14], *w_up = (const float*)d_in[15], *w_down = (const float*)d_in[16],
                *ws_gate = (const float*)d_in[17], *ws_up = (const float*)d_in[18], *ws_down = (const float*)d_in[19], *ln2_g = (const float*)d_in[20], *ln2_b = (const float*)d_in[21];
    float* mod = (float*)(ws + O_MOD); float2* cs128 = (float2*)(ws + O_CS128); float2* cs64 = (float2*)(ws + O_CS64); float* kmean = (float*)(ws + O_KMEAN);
    int* hist = (int*)(ws + O_HIST); int* starts = (int*)(ws + O_STARTS); int* cnts = (int*)(ws + O_CNTS); unsigned long long* tokmask = (unsigned long long*)(ws + O_TOKMASK);
    int* tokpos = (int*)(ws + O_TOKPOS); int* stok = (int*)(ws + O_STOK); float* sw = (float*)(ws + O_SW); float* tw = (float*)(ws + O_TW); float* logits = (float*)(ws + O_LOGITS);
    int* shlist = (int*)(ws + O_SHLIST); float* shw = (float*)(ws + O_SHLIST + 64 * 1024); int* shstarts = (int*)(ws + O_SHLIST + 128 * 1024); int* shcnts = (int*)(ws + O_SHLIST + 129 * 1024);
    float* r1 = (float*)(ws + O_R1); float* proj = (float*)(ws + O_PROJ); float* x1 = proj; float* cqn = (float*)(ws + O_CQN); float* ckvn = (float*)(ws + O_CKVN);
    float* qm = (float*)(ws + O_QM); float* out2 = qm; float* kv = (float*)(ws + O_KV); float* mix = out; float* Ge = (float*)(ws + O_GE); float* Ue = Ge + (size_t)16384 * 512;
    const int* ni = nullptr; const float* nf = nullptr;
    nv::k_mod<<<dim3(6 * D / 256, Bn), 256, 0, st>>>(c, w_ada, b_ada, mod);
    nv::k_rope_tab<<<S * 64 / 256, 256, 0, st>>>(cs128, cs64);
    if (hk && hk->after_mod) hk->after_mod(hk->ctx, st);
    nv::k_modulate<<<(unsigned)((size_t)T * D / 256), 256, 0, st>>>(x, mod, 0, D, r1);
    nv::k_gemm<0, false><<<dim3(INW / 64, T / 64), 256, 0, st>>>(r1, w_in, proj, T, INW, D, D, INW, INW, ni, nf, ni, ni, 0);
    nv::k_rope_proj<<<T, 256, 0, st>>>(proj, cs128, cs64);
    nv::k_kmean<<<Bn * 8 * 8, 128, 0, st>>>(proj, kmean);
    if (hk && hk->after_proj) hk->after_proj(hk->ctx, st);
    nv::k_rms<<<T / 4, 256, 0, st>>>(proj, 3072, g_cq, cqn);
    nv::k_rms<<<T / 4, 256, 0, st>>>(proj, 3584, g_ckv, ckvn);
    nv::k_gemm<0, false><<<dim3(1536 / 64, T / 64), 256, 0, st>>>(cqn, w_uq, qm, T, 1536, 512, 512, 1536, 1536, ni, nf, ni, ni, 0);
    nv::k_gemm<0, false><<<dim3(2048 / 64, T / 64), 256, 0, st>>>(ckvn, w_ukv, kv, T, 2048, 512, 512, 2048, 2048, ni, nf, ni, ni, 0);
    nv::k_rope_qm<<<T, 256, 0, st>>>(qm, cs64);
    if (hk && hk->after_mla) hk->after_mla(hk->ctx, st);
    nv::k_attn<true><<<T * 8 / 4, 256, 0, st>>>(proj, qm, kv, kmean, mix);
    nv::k_attn<false><<<T * 8 / 4, 256, 0, st>>>(proj, qm, kv, kmean, mix);
    if (hk && hk->after_attn) hk->after_attn(hk->ctx, st);
    nv::k_gemm<0, false><<<dim3(D / 64, T / 64), 256, 0, st>>>(mix, w_o, r1, T, D, D, D, D, D, ni, nf, ni, ni, 0);
    nv::k_ln<<<T / 4, 256, 0, st>>>(x, r1, mod, 2 * D, ln1_g, ln1_b, x1, r1, 3 * D, 4 * D);
    nv::k_gemm<0, false><<<dim3(1, T / 64), 256, 0, st>>>(r1, w_router, logits, T, 64, D, D, 64, 64, ni, nf, ni, ni, 0);
    rt::k_route<<<256, 256, 0, st>>>(logits, rbias, tokmask, tw, hist);
    rt::k_scatter<<<256, 256, 0, st>>>(hist, tokmask, tw, stok, sw, tokpos, starts, cnts);
    nv::k_zero<<<(unsigned)((size_t)T * D / 256), 256, 0, st>>>(out2, (size_t)T * D);
    nv::k_iota<<<T / 256, 256, 0, st>>>(shlist, shw, shstarts, shcnts);
    for (int e = 0; e <= 64; ++e) {
        const float* wg = e < 64 ? w_gate + (size_t)e * D * 512 : ws_gate; const float* wu = e < 64 ? w_up + (size_t)e * D * 512 : ws_up; const float* wd = e < 64 ? w_down + (size_t)e * 512 * D : ws_down;
        const int* lst = e < 64 ? stok : shlist; const float* wt = e < 64 ? sw : shw; const int* stt = e < 64 ? starts : shstarts; const int* cn = e < 64 ? cnts : shcnts; const int ee = e < 64 ? e : 0;
        nv::k_gemm<1, true><<<dim3(512 / 64, 16384 / 64), 256, 0, st>>>(r1, wg, Ge, T, 512, D, D, 512, 512, lst, wt, stt, cn, ee);
        nv::k_gemm<1, true><<<dim3(512 / 64, 16384 / 64), 256, 0, st>>>(r1, wu, Ue, T, 512, D, D, 512, 512, lst, wt, stt, cn, ee);
        nv::k_silu_mul<<<16384 * 512 / 256, 256, 0, st>>>(Ge, Ue, cn, ee);
        nv::k_gemm<2, true><<<dim3(D / 64, 16384 / 64), 256, 0, st>>>(Ge, wd, out2, T, D, 512, 512, D, D, lst, wt, stt, cn, ee);
    }
    nv::k_ln<<<T / 4, 256, 0, st>>>(x1, out2, mod, 5 * D, ln2_g, ln2_b, out, nullptr, 0, 0);
}
}
#define LAS __attribute__((address_space(3)))
#define GAS __attribute__((address_space(1)))
typedef unsigned short bf16_t;
typedef short bf16x8 __attribute__((ext_vector_type(8)));
typedef short s16x4 __attribute__((ext_vector_type(4)));
typedef float f32x4 __attribute__((ext_vector_type(4)));
typedef float f32x16 __attribute__((ext_vector_type(16)));
typedef unsigned u32x4 __attribute__((ext_vector_type(4)));
typedef unsigned u32x2 __attribute__((ext_vector_type(2)));

__device__ __forceinline__ unsigned cvt_pk_bf16(float lo, float hi) { unsigned r; asm volatile("v_cvt_pk_bf16_f32 %0, %1, %2" : "=v"(r) : "v"(lo), "v"(hi)); return r; }
__device__ __forceinline__ unsigned f2bf(float f) { unsigned u = __builtin_bit_cast(unsigned, f); return (u + 0x7fffu + ((u >> 16) & 1u)) >> 16; }
__device__ __forceinline__ float bf2f(unsigned b) { return __builtin_bit_cast(float, b << 16); }
__device__ __forceinline__ unsigned pk2(float lo, float hi) { return f2bf(lo) | (f2bf(hi) << 16); }
__device__ __forceinline__ float siluf(float a) { return a / (1.f + __expf(-a)); }

#define XB_TMO      128
#define XB_XCNT(j)  (256  + 64 * (j))
#define XB_XSUB(j)  (1280 + 64 * (j))
#define XB_XGEN(j)  (2304 + 64 * (j))
#define XB_TOP      3328
#define XB_TOPGEN   3392
#define XCD_BAR_WORDS 3456
#define XB_SPIN_CAP (1u << 18)

__device__ __forceinline__ unsigned xb_ld(unsigned* p)              { return __hip_atomic_load(p, __ATOMIC_RELAXED, __HIP_MEMORY_SCOPE_AGENT); }
__device__ __forceinline__ unsigned xb_add(unsigned* p, unsigned v) { return __hip_atomic_fetch_add(p, v, __ATOMIC_RELAXED, __HIP_MEMORY_SCOPE_AGENT); }
__device__ __forceinline__ unsigned xb_xcc_id() { return (unsigned)__builtin_amdgcn_s_getreg((3 << 11) | 20) & 0xFu; }
#define XB_SPIN(cond, bar) do { unsigned _sp = 0; while (cond) { __builtin_amdgcn_s_sleep(1); \
    if ((++_sp & 255u) == 0u) { if (xb_ld(&(bar)[XB_TMO])) break; if (_sp > XB_SPIN_CAP) { atomicAdd(&(bar)[XB_TMO], 1u); break; } } } } while (0)

struct XcdBarrier {
    unsigned* bar; unsigned x;
    volatile LAS unsigned* st;
};
__device__ __forceinline__ XcdBarrier xcd_barrier_post(unsigned* bar, volatile LAS unsigned* st) {
    XcdBarrier b; b.bar = bar; b.x = xb_xcc_id(); b.st = st;
    if (threadIdx.x == 0) (void)xb_add(&bar[XB_XCNT(b.x)], 1u);
    return b;
}
__device__ __forceinline__ void xcd_barrier_complete(unsigned* bar, unsigned x, unsigned& nloc, unsigned& nx) {
    const unsigned G = gridDim.x * gridDim.y * gridDim.z;
    unsigned sum, cnt, mine, sp = 0u;
    for (;;) {
        sum = 0u; cnt = 0u; mine = 0u;
#pragma unroll
        for (unsigned j = 0; j < 16; ++j) { const unsigned c = xb_ld(&bar[XB_XCNT(j)]); sum += c; cnt += (c > 0u) ? 1u : 0u; mine = (j == x) ? c : mine; }
        if (sum == G) break;
        __builtin_amdgcn_s_sleep(1);
        if ((++sp & 255u) == 0u) { if (xb_ld(&bar[XB_TMO])) break; if (sp > XB_SPIN_CAP) { atomicAdd(&bar[XB_TMO], 1u); break; } }
    }
    nloc = mine > 0u ? mine : 1u; nx = cnt > 0u ? cnt : 1u;
}
__device__ __forceinline__ void xcd_barrier(const XcdBarrier& b) {
    asm volatile("s_waitcnt vmcnt(0)" ::: "memory");
    __syncthreads();
    if (threadIdx.x == 0) {
        unsigned* bar = b.bar;
        __builtin_amdgcn_s_waitcnt(0);
        unsigned nloc = b.st[0], nx = b.st[1];
        if (nloc == 0u) { xcd_barrier_complete(bar, b.x, nloc, nx); b.st[0] = nloc; b.st[1] = nx; }
        const unsigned old = xb_add(&bar[XB_XSUB(b.x)], 1u);
        const unsigned gen = old / nloc;
        if (old + 1u == (gen + 1u) * nloc) {
            __builtin_amdgcn_fence(__ATOMIC_RELEASE, "agent");
            asm volatile("s_waitcnt vmcnt(0)" ::: "memory");
            const unsigned og = xb_add(&bar[XB_TOP], 1u);
            const unsigned tg = og / nx;
            if (og + 1u == (tg + 1u) * nx) xb_add(&bar[XB_TOPGEN], 1u);
            else XB_SPIN(xb_ld(&bar[XB_TOPGEN]) == tg, bar);
            __builtin_amdgcn_fence(__ATOMIC_ACQUIRE, "agent");
            xb_add(&bar[XB_XGEN(b.x)], 1u);
            asm volatile("s_waitcnt vmcnt(0)" ::: "memory");
        } else {
            XB_SPIN(xb_ld(&bar[XB_XGEN(b.x)]) == gen, bar);
            __builtin_amdgcn_fence(__ATOMIC_ACQUIRE, "agent");
            asm volatile("s_waitcnt vmcnt(0)" ::: "memory");
        }
    }
    __syncthreads();
}

namespace pg8 {
constexpr int BM = 256, BK = 64, HALF = 128, HTB = HALF * BK * 2  , STAGE_BYTES = 8 * HTB, NXCD = 8;

__host__ __device__ __forceinline__ int lds_byte(int r, int c) { const int st = (r >> 4) * 2 + (c >> 5), rr = r & 15, cc = c & 31, ob = rr * 64 + cc * 2; return st * 1024 + (ob ^ (((ob >> 9) & 1) << 5)); }
__host__ __device__ __forceinline__ void stage_rc(int b, int& R, int& C) { const int st = b / 1024, sb = b % 1024, swz = sb ^ (((sb >> 9) & 1) << 5); R = (st >> 1) * 16 + swz / 64; C = (st & 1) * 32 + (swz % 64) / 2; }
__host__ __device__ __forceinline__ int perm32(int rho) { const int n = rho >> 4, i = rho & 15; return 8 * (i >> 2) + 4 * n + (i & 3); }

struct Unit { const char* a; const char* b; const int* rows; int nvalid; int pm, pn, kind, aux; };

__host__ __device__ __forceinline__ int xcd_remap(int L, int nwg) { const int q = nwg / NXCD, r = nwg % NXCD, xcd = L % NXCD, off = L / NXCD; return (xcd < r ? xcd * (q + 1) : r * (q + 1) + (xcd - r) * q) + off; }

template <class Epi, class Sched, bool GATHER, bool ALIGN_EPI = true, bool SP2 = true>
__device__ __forceinline__ void gemm_phase(LAS unsigned char* lds, const int K, const Sched& S, const Epi& E) {
    const int tid = threadIdx.x, wid = __builtin_amdgcn_readfirstlane(tid >> 6), lane = tid & 63, wr = wid >> 2, wc = wid & 3, fr = lane & 15, fq = lane >> 4;
    const int nt = K / BK;
    unsigned voffA[2], voffB[2]; int RA[2], CA[2];
#pragma unroll
    for (int i = 0; i < 2; ++i) { int R, C; stage_rc(tid * 16 + i * 8192, R, C); const int Rb = Epi::PERM ? ((R & ~31) + perm32(R & 31)) : R; RA[i] = R; CA[i] = C;
        voffA[i] = (unsigned)(R * K + C) * 2u; voffB[i] = (unsigned)(Rb * K + C) * 2u; }
    const size_t kstep = (size_t)(BK * 2);
    const size_t hstep = (size_t)HALF * K * 2;
    const unsigned ldsw = (unsigned)wid * 1024u;
    const int aoff = lds_byte(wr * 64 + fr, fq * 8), boff = lds_byte(wc * 32 + fr, fq * 8);
#define PG8_SA(b, h) (((b) * 2 + (h)) * HTB)
#define PG8_SB(b, h) ((4 + (b) * 2 + (h)) * HTB)
#define PG8_STAGE(bufoff, gbase, voff) do { _Pragma("unroll") for (int _i = 0; _i < 2; ++_i) \
        __builtin_amdgcn_global_load_lds((const unsigned*)((const char*)(gbase) + (voff)[_i]), (LAS unsigned*)(lds + (bufoff) + ldsw + _i * 8192), 16, 0, 0); } while (0)
#define PG8_LDA(dst, b, h) do { _Pragma("unroll") for (int m = 0; m < 4; ++m) _Pragma("unroll") for (int k = 0; k < 2; ++k) dst[m][k] = *(const LAS bf16x8*)(lds + PG8_SA(b, h) + aoff + m * 2048 + k * 1024); } while (0)
#define PG8_LDB(dst, b, h) do { _Pragma("unroll") for (int n = 0; n < 2; ++n) _Pragma("unroll") for (int k = 0; k < 2; ++k) dst[n][k] = *(const LAS bf16x8*)(lds + PG8_SB(b, h) + boff + n * 2048 + k * 1024); } while (0)
#define PG8_MMA(ai, bj, At, Bt) do { __builtin_amdgcn_s_setprio(1); _Pragma("unroll") for (int m = 0; m < 4; ++m) _Pragma("unroll") for (int n = 0; n < 2; ++n) _Pragma("unroll") for (int k = 0; k < 2; ++k) \
        acc[ai][bj][m][n] = __builtin_amdgcn_mfma_f32_16x16x32_bf16(Bt[n][k], At[m][k], acc[ai][bj][m][n], 0, 0, 0); __builtin_amdgcn_s_setprio(0); } while (0)
#define PG8_WAIT_V(n) asm volatile("s_waitcnt vmcnt(" #n ")" ::: "memory")
#define PG8_WAIT_L(n) asm volatile("s_waitcnt lgkmcnt(" #n ")" ::: "memory")
#define PG8_BAR __builtin_amdgcn_s_barrier()
#define PG8_SCHED __builtin_amdgcn_sched_barrier(0)
#define PG8_STAGE_A(bufoff, ubase, gv, koff, h) do { if constexpr (GATHER) { PG8_STAGE(bufoff, (ubase) + (koff), gv[h]); } else { PG8_STAGE(bufoff, (ubase) + (koff) + (h) * hstep, voffA); } } while (0)
#define PG8_GSWITCH() do { if constexpr (GATHER) { if (last && has_next) { _Pragma("unroll") for (int h_ = 0; h_ < 2; ++h_) _Pragma("unroll") for (int i_ = 0; i_ < 2; ++i_) \
        gcur[h_][i_] = ((unsigned)rnx[h_][i_] * (unsigned)K + (unsigned)CA[i_]) * 2u; } } } while (0)
    Unit cur, nxt; int ui = 0;
    if (!S.next(0, cur)) return;
    f32x4 acc[2][2][4][2];
#pragma unroll
    for (int a = 0; a < 2; ++a)
#pragma unroll
        for (int b = 0; b < 2; ++b)
#pragma unroll
            for (int m = 0; m < 4; ++m)
#pragma unroll
                for (int n = 0; n < 2; ++n) acc[a][b][m][n] = (f32x4){0.f, 0.f, 0.f, 0.f};
    bf16x8 At[4][2], B0[2][2], B1[2][2];
    unsigned gcur[2][2]; int rnx[2][2];
    if constexpr (GATHER) {
#pragma unroll
        for (int h = 0; h < 2; ++h)
#pragma unroll
            for (int i = 0; i < 2; ++i) { const int r = RA[i] + h * HALF; const int row = (r < cur.nvalid) ? (cur.rows ? cur.rows[r] : r) : 0; gcur[h][i] = ((unsigned)row * (unsigned)K + (unsigned)CA[i]) * 2u; rnx[h][i] = 0; }
    }
    const char* cA = cur.a; const char* cB = cur.b;
    if constexpr (SP2) {
        PG8_STAGE(PG8_SB(0, 0), cB, voffB); PG8_STAGE(PG8_SB(0, 1), cB + hstep, voffB); PG8_STAGE_A(PG8_SA(0, 0), cA, gcur, 0, 0); PG8_STAGE_A(PG8_SA(0, 1), cA, gcur, 0, 1);
        if (wr == 1) PG8_BAR;
        PG8_WAIT_V(2); PG8_BAR;
        PG8_STAGE(PG8_SB(1, 0), cB + kstep, voffB); PG8_STAGE_A(PG8_SA(1, 0), cA, gcur, kstep, 0); PG8_STAGE(PG8_SB(1, 1), cB + hstep + kstep, voffB);
        PG8_WAIT_V(6); PG8_BAR;
    } else {
        PG8_STAGE(PG8_SB(0, 0), cB, voffB); PG8_STAGE_A(PG8_SA(0, 0), cA, gcur, 0, 0); PG8_STAGE(PG8_SB(0, 1), cB + hstep, voffB); PG8_STAGE_A(PG8_SA(0, 1), cA, gcur, 0, 1);
        if (wr == 1) PG8_BAR;
        PG8_WAIT_V(4); PG8_BAR;
        PG8_STAGE(PG8_SB(1, 0), cB + kstep, voffB); PG8_STAGE_A(PG8_SA(1, 0), cA, gcur, kstep, 0); PG8_STAGE(PG8_SB(1, 1), cB + hstep + kstep, voffB);
        PG8_WAIT_V(6); PG8_BAR;
    }
    for (;;) {
        const bool has_next = S.next(ui + 1, nxt);
        const char* nA = has_next ? nxt.a : cA; const char* nB = has_next ? nxt.b : cB;
        if constexpr (GATHER) { if (has_next) {
#pragma unroll
            for (int h = 0; h < 2; ++h)
#pragma unroll
                for (int i = 0; i < 2; ++i) { const int r = RA[i] + h * HALF; rnx[h][i] = (r < nxt.nvalid) ? (nxt.rows ? nxt.rows[r] : r) : 0; } } }
        for (int t = 0; t < nt; t += 2) {
            const bool last = (t == nt - 2);
            const size_t k1 = (size_t)(t + 1) * kstep;
            const char* a2 = last ? nA : cA; const char* b2 = last ? nB : cB + (size_t)(t + 2) * kstep;
            const size_t k2 = last ? 0 : (size_t)(t + 2) * kstep, k3 = k2 + kstep;
            const char* b3 = b2 + kstep;
            if constexpr (SP2) {
            PG8_LDB(B0, 0, 0); PG8_LDB(B1, 0, 1); PG8_SCHED; PG8_LDA(At, 0, 0); PG8_STAGE_A(PG8_SA(1, 1), cA, gcur, k1, 1); PG8_GSWITCH();
            PG8_WAIT_V(8); PG8_WAIT_L(0); PG8_BAR; PG8_MMA(0, 0, At, B0); PG8_MMA(0, 1, At, B1); PG8_BAR; PG8_SCHED;
            PG8_LDA(At, 0, 1); PG8_STAGE(PG8_SB(0, 0), b2, voffB); PG8_STAGE(PG8_SB(0, 1), b2 + hstep, voffB); PG8_STAGE_A(PG8_SA(0, 0), a2, gcur, k2, 0);
            PG8_WAIT_V(8); PG8_WAIT_L(0); PG8_BAR; PG8_MMA(1, 0, At, B0); PG8_MMA(1, 1, At, B1); PG8_BAR; PG8_SCHED;
            PG8_LDB(B0, 1, 0); PG8_LDB(B1, 1, 1); PG8_SCHED; PG8_LDA(At, 1, 0); PG8_STAGE_A(PG8_SA(0, 1), a2, gcur, k2, 1);
            PG8_WAIT_V(8); PG8_WAIT_L(0); PG8_BAR; PG8_MMA(0, 0, At, B0); PG8_MMA(0, 1, At, B1); PG8_BAR; PG8_SCHED;
            PG8_LDA(At, 1, 1); PG8_STAGE(PG8_SB(1, 0), b3, voffB); PG8_STAGE(PG8_SB(1, 1), b3 + hstep, voffB); PG8_STAGE_A(PG8_SA(1, 0), a2, gcur, k3, 0);
            PG8_WAIT_V(8); PG8_WAIT_L(0); PG8_BAR; PG8_MMA(1, 0, At, B0); PG8_MMA(1, 1, At, B1); PG8_BAR; PG8_SCHED;
            } else {
            PG8_LDB(B0, 0, 0); PG8_SCHED; PG8_LDA(At, 0, 0); PG8_STAGE_A(PG8_SA(1, 1), cA, gcur, k1, 1); PG8_GSWITCH();
            PG8_WAIT_L(8); PG8_BAR; PG8_WAIT_L(0); PG8_MMA(0, 0, At, B0); PG8_BAR; PG8_SCHED;
            PG8_LDB(B1, 0, 1); PG8_STAGE(PG8_SB(0, 0), b2, voffB);
            PG8_BAR; PG8_WAIT_L(0); PG8_MMA(0, 1, At, B1); PG8_BAR;
            PG8_LDA(At, 0, 1); PG8_STAGE_A(PG8_SA(0, 0), a2, gcur, k2, 0);
            PG8_BAR; PG8_WAIT_L(0); PG8_MMA(1, 0, At, B0); PG8_BAR; PG8_SCHED;
            PG8_STAGE(PG8_SB(0, 1), b2 + hstep, voffB);
            PG8_WAIT_V(6); PG8_BAR; PG8_MMA(1, 1, At, B1); PG8_BAR;
            PG8_LDB(B0, 1, 0); PG8_SCHED; PG8_LDA(At, 1, 0); PG8_STAGE_A(PG8_SA(0, 1), a2, gcur, k2, 1);
            PG8_WAIT_L(8); PG8_BAR; PG8_WAIT_L(0); PG8_MMA(0, 0, At, B0); PG8_BAR; PG8_SCHED;
            PG8_LDB(B1, 1, 1); PG8_STAGE(PG8_SB(1, 0), b3, voffB);
            PG8_BAR; PG8_WAIT_L(0); PG8_MMA(0, 1, At, B1); PG8_BAR;
            PG8_LDA(At, 1, 1); PG8_STAGE_A(PG8_SA(1, 0), a2, gcur, k3, 0);
            PG8_BAR; PG8_WAIT_L(0); PG8_MMA(1, 0, At, B0); PG8_BAR; PG8_SCHED;
            PG8_STAGE(PG8_SB(1, 1), b3 + hstep, voffB);
            PG8_WAIT_V(6); PG8_BAR; PG8_MMA(1, 1, At, B1); PG8_BAR;
            }
        }
        if constexpr (ALIGN_EPI) { if (wr == 0) PG8_BAR; }
        E(acc, cur, wr, wc, fr, fq);
        if (!has_next) break;
#pragma unroll
        for (int a = 0; a < 2; ++a)
#pragma unroll
            for (int b = 0; b < 2; ++b)
#pragma unroll
                for (int m = 0; m < 4; ++m)
#pragma unroll
                    for (int n = 0; n < 2; ++n) acc[a][b][m][n] = (f32x4){0.f, 0.f, 0.f, 0.f};
        cur = nxt; cA = nA; cB = nB; ++ui;
        if constexpr (ALIGN_EPI) { if (wr == 1) PG8_BAR; }
    }
    PG8_WAIT_V(0);
    if constexpr (!ALIGN_EPI) { if (wr == 0) PG8_BAR; }
    PG8_BAR;
#undef PG8_SA
#undef PG8_SB
#undef PG8_STAGE
#undef PG8_STAGE_A
#undef PG8_GSWITCH
#undef PG8_LDA
#undef PG8_LDB
#undef PG8_MMA
#undef PG8_WAIT_V
#undef PG8_WAIT_L
#undef PG8_BAR
#undef PG8_SCHED
}
}
constexpr int NWAVES = 8, NTHR = 512;
constexpr int NEXP = 64, NEXP1 = 65;
constexpr int LDS_BYTES = 147456;
constexpr int RING_OFF = 0, RING_BYTES = 131072, LDSCTL_OFF = RING_BYTES, MISC_OFF = LDSCTL_OFF + 320;

struct Lay {
    size_t ctl, mod, cs128, cs64, kmean, ssq, hist, starts, cnts, tokmask, tokpos, stok, sw, tw, logits;
    size_t wd, wgu, win, wuq, wukv, wo, wr;
    size_t h1, qa, ka, va, cq, ckv, kr, qmn, qmr, kn, vm, mix, y, x1, h2, hb, slot, end;
};
constexpr size_t CTL_BYTES = 64 * 1024;
constexpr Lay make_lay_fast() {
    Lay L{};
    L.ctl = 0; L.mod = 1 * MiB; L.cs128 = 2 * MiB; L.cs64 = 3 * MiB; L.kmean = 3 * MiB + 512 * 1024; L.ssq = 4 * MiB  ; L.hist = 5 * MiB; L.starts = 5 * MiB + 128 * 1024; L.cnts = 5 * MiB + 192 * 1024;
    L.tokmask = 5 * MiB + 256 * 1024; L.tokpos = 6 * MiB; L.stok = 6 * MiB + 512 * 1024  ; L.sw = 7 * MiB + 64 * 1024; L.tw = 8 * MiB; L.logits = 12 * MiB;
    L.wd = 16 * MiB; L.x1 = 146 * MiB; L.hb = 274 * MiB; L.win = 420 * MiB; L.wuq = 438 * MiB; L.wukv = 440 * MiB; L.wo = 442 * MiB; L.wr = 450 * MiB; L.wgu = 452 * MiB;
    L.h1 = 146 * MiB; L.qa = 210 * MiB; L.ka = 242 * MiB; L.va = 274 * MiB; L.cq = 306 * MiB; L.ckv = 322 * MiB; L.kr = 338 * MiB; L.qmn = 340 * MiB; L.qmr = 372 * MiB; L.kn = 388 * MiB;
    L.vm = 712 * MiB; L.mix = 744 * MiB; L.y = 808 * MiB; L.h2 = 936 * MiB; L.slot = 548 * MiB; L.end = 1060 * MiB;
    return L;
}
constexpr Lay make_lay_dbg() {
    Lay L{}; const size_t B0 = 632 * MiB;
    L.ctl = B0; L.mod = B0 + 1 * MiB; L.cs128 = B0 + 2 * MiB; L.cs64 = B0 + 3 * MiB; L.kmean = B0 + 3 * MiB + 512 * 1024; L.ssq = B0 + 4 * MiB; L.hist = B0 + 5 * MiB; L.starts = B0 + 5 * MiB + 128 * 1024; L.cnts = B0 + 5 * MiB + 192 * 1024;
    L.tokmask = B0 + 5 * MiB + 256 * 1024; L.tokpos = B0 + 6 * MiB; L.stok = B0 + 6 * MiB + 512 * 1024; L.sw = B0 + 7 * MiB + 64 * 1024; L.tw = 0; L.logits = 0;
    L.win = B0 + 8 * MiB; L.wuq = B0 + 26 * MiB; L.wukv = B0 + 28 * MiB; L.wo = B0 + 30 * MiB; L.wr = B0 + 38 * MiB;
    L.h1 = B0 + 40 * MiB; L.qa = B0 + 104 * MiB; L.ka = B0 + 136 * MiB; L.va = B0 + 168 * MiB; L.cq = B0 + 200 * MiB; L.ckv = B0 + 216 * MiB; L.kr = B0 + 232 * MiB; L.qmn = B0 + 234 * MiB; L.qmr = B0 + 266 * MiB; L.kn = B0 + 282 * MiB;
    L.vm = B0 + 314 * MiB; L.mix = B0 + 346 * MiB; L.end = B0 + 410 * MiB;
    L.wd = 0; L.wgu = 0; L.x1 = 0; L.hb = 0; L.y = 0; L.h2 = 0; L.slot = 0;
    return L;
}
#ifndef MK_LAYOUT_DBG
#define MK_LAYOUT_DBG 0
#endif
constexpr Lay WL = MK_LAYOUT_DBG ? make_lay_dbg() : make_lay_fast();

struct Args { const float* in[22]; float* out; unsigned char* ws; int ph_lo, ph_hi; unsigned flags; int pad; };
struct Frame {
    LAS unsigned char* lds; volatile LAS unsigned* MISC;
    int tid, lane, wave, G, vcu;
    unsigned char* ws;
};
#define LDS_WAIT() asm volatile("s_waitcnt lgkmcnt(0)" ::: "memory")
#define VM_WAIT() asm volatile("s_waitcnt vmcnt(0)" ::: "memory")

__device__ __forceinline__ float wave_sum(float v) {
#pragma unroll
    for (int o = 1; o < 64; o <<= 1) v += __shfl_xor(v, o);
    return v;
}

struct TileOrder {
    int nM, nN, nwg, G, c;
    __device__ __forceinline__ void init(int nM_, int nN_, int G_, int c_) { nM = nM_; nN = nN_; nwg = nM * nN; G = G_; c = c_; }
    __device__ __forceinline__ bool get(int i, int& pm, int& pn) const {
        const long L = (long)i * G + c; if (L >= nwg) return false;
        const int wgid = pg8::xcd_remap((int)L, nwg);
        const int nig = 8 * nN, gid = wgid / nig, fm = gid * 8, gsz = (nM - fm) < 8 ? (nM - fm) : 8;
        pm = fm + ((wgid % nig) % gsz); pn = (wgid % nig) / gsz; return true;
    }
};
template <class Map>
__device__ __forceinline__ void tr_item(const float* __restrict__ W, int ldw, int k0, int n0, bf16_t* __restrict__ WT, int ldk, const Map& map, const float* __restrict__ kscale, LAS float* scr, int lane) {
#pragma unroll 8
    for (int i = 0; i < 32; ++i) { const int kk = 2 * i + (lane >> 5); float v = W[(size_t)(k0 + kk) * ldw + n0 + (lane & 31)]; if (kscale) v *= kscale[k0 + kk]; scr[kk * 33 + (lane & 31)] = v; }
    LDS_WAIT(); asm volatile("" ::: "memory");
    const int c = lane & 7;
#pragma unroll
    for (int j = 0; j < 4; ++j) { const int n = (lane >> 3) + 8 * j; const LAS float* s = scr + (8 * c) * 33 + n; const int row = map(n0 + n);
        u32x4 o; o.x = pk2(s[0 * 33], s[1 * 33]); o.y = pk2(s[2 * 33], s[3 * 33]); o.z = pk2(s[4 * 33], s[5 * 33]); o.w = pk2(s[6 * 33], s[7 * 33]);
        if (row >= 0) *(u32x4*)(WT + (size_t)row * ldk + k0 + 8 * c) = o; }
    LDS_WAIT(); asm volatile("" ::: "memory");
}
struct MapId { __device__ __forceinline__ int operator()(int n) const { return n; } };
struct MapWin { __device__ __forceinline__ int operator()(int n) const {
    if (n < 2048) { const int d = n & 127; return (n & ~127) + (d < 64 ? 2 * d : 2 * (d - 64) + 1); }
    if (n < 4096) return n;
    const int d = n - 4096; return 4096 + (d < 32 ? 2 * d : 2 * (d - 32) + 1); } };
struct MapWuq { __device__ __forceinline__ int operator()(int n) const { const int h = n / 192, d = n - 192 * h; if (d < 128) return 128 * h + d; const int r = d - 128; return 1024 + 64 * h + (r < 32 ? 2 * r : 2 * (r - 32) + 1); } };
struct MapGu { int up; __device__ __forceinline__ int operator()(int n) const { return 256 * (n >> 7) + 128 * up + (n & 127); } };

__device__ __forceinline__ void p0_mod(Frame& F, const float* __restrict__ c, const float* __restrict__ w_ada, const float* __restrict__ b_ada, float* __restrict__ mod) {
    LAS float* sc = (LAS float*)(F.lds + RING_OFF); LAS float* red = (LAS float*)(F.lds + RING_OFF + 65536);
    for (int i = F.tid; i < 8 * 2048; i += NTHR) { const float v = c[i]; sc[i] = v / (1.f + __expf(-v)); }
    __syncthreads();
    const int q = F.tid % 12, kg = F.tid / 12;
    for (int item = F.vcu; item < 256; item += F.G) {
        const int col = item * 48 + q * 4;
        if (kg < 40) {
            f32x4 a[8];
#pragma unroll
            for (int b = 0; b < 8; ++b) a[b] = (f32x4){0.f, 0.f, 0.f, 0.f};
            for (int k = kg; k < 2048; k += 40) { const f32x4 w = *(const f32x4*)(w_ada + (size_t)k * 12288 + col);
#pragma unroll
                for (int b = 0; b < 8; ++b) a[b] += w * sc[b * 2048 + k]; }
#pragma unroll
            for (int b = 0; b < 8; ++b) *(LAS f32x4*)(red + (kg * 8 + b) * 48 + q * 4) = a[b];
        }
        __syncthreads();
        if (F.tid < 384) { const int b = F.tid / 48, cc = F.tid % 48; float s = b_ada[item * 48 + cc];
            for (int g = 0; g < 40; ++g) s += red[(g * 8 + b) * 48 + cc];
            mod[b * 12288 + item * 48 + cc] = s; }
        __syncthreads();
    }
}
__device__ __forceinline__ void p0_rope_tab(Frame& F, float2* __restrict__ cs128, float2* __restrict__ cs64) {
    for (int idx = F.vcu * NTHR + F.tid; idx < S * 64; idx += F.G * NTHR) {
        { const int pos = idx / 64, i = idx % 64; const float inv = (float)(1.0 / pow(10000.0, (double)(2 * i) / 128.0)); const float a = (float)pos * inv; cs128[idx] = make_float2((float)cos((double)a), (float)sin((double)a)); }
        if (idx < S * 32) { const int pos = idx / 32, i = idx % 32; const float inv = (float)(1.0 / pow(10000.0, (double)(2 * i) / 64.0)); const float a = (float)pos * inv; cs64[idx] = make_float2((float)cos((double)a), (float)sin((double)a)); }
    }
}
__device__ __forceinline__ void p0_convert(Frame& F, const Args& A, unsigned flags) {
    LAS float* scr = (LAS float*)(F.lds + RING_OFF + F.wave * 16384);
    const int gw = F.vcu * NWAVES + F.wave, NGW = F.G * NWAVES;
    const float *w_in = A.in[4], *g_cq = A.in[5], *w_uq = A.in[6], *g_ckv = A.in[7], *w_ukv = A.in[8], *w_o = A.in[9], *w_router = A.in[12];
    const float *w_gate = A.in[14], *w_up = A.in[15], *w_down = A.in[16], *ws_gate = A.in[17], *ws_up = A.in[18], *ws_down = A.in[19];
    bf16_t* WinT = (bf16_t*)(F.ws + WL.win); bf16_t* WuqT = (bf16_t*)(F.ws + WL.wuq); bf16_t* WukvT = (bf16_t*)(F.ws + WL.wukv); bf16_t* WoT = (bf16_t*)(F.ws + WL.wo); bf16_t* WrT = (bf16_t*)(F.ws + WL.wr);
    bf16_t* WguT = (bf16_t*)(F.ws + WL.wgu); bf16_t* WdT = (bf16_t*)(F.ws + WL.wd);
    if (flags & 1u) {
        constexpr int I_IN = 32 * 130, I_UQ = 8 * 48, I_UKV = 8 * 64, I_O = 32 * 64, I_ALL = I_IN + I_UQ + I_UKV + I_O;
        for (int it = gw; it < I_ALL; it += NGW) { int r = it;
            if (r < I_IN) { tr_item(w_in, INW, 64 * (r / 130), 32 * (r % 130), WinT, 2048, MapWin{}, nullptr, scr, F.lane); continue; } r -= I_IN;
            if (r < I_UQ) { tr_item(w_uq, 1536, 64 * (r / 48), 32 * (r % 48), WuqT, 512, MapWuq{}, g_cq, scr, F.lane); continue; } r -= I_UQ;
            if (r < I_UKV) { tr_item(w_ukv, 2048, 64 * (r / 64), 32 * (r % 64), WukvT, 512, MapId{}, g_ckv, scr, F.lane); continue; } r -= I_UKV;
            tr_item(w_o, 2048, 64 * (r / 64), 32 * (r % 64), WoT, 2048, MapId{}, nullptr, scr, F.lane); }
        for (size_t i = (size_t)gw * 64 + F.lane; i < (size_t)192 * 2048 / 8; i += (size_t)NGW * 64) *(u32x4*)(WinT + (size_t)4160 * 2048 + i * 8) = (u32x4){0u, 0u, 0u, 0u};
        for (int i = gw * 64 + F.lane; i < 2048 * 64; i += NGW * 64) { const int k = i >> 6, e = i & 63; const float v = w_router[i]; const unsigned hi = f2bf(v); const float lo = v - bf2f(hi);
            WrT[(size_t)e * 2048 + k] = (bf16_t)hi; WrT[(size_t)(64 + e) * 2048 + k] = (bf16_t)f2bf(lo); }
    }
    if (flags & 2u) {
        constexpr int I_G = 32 * 16, I_D = 8 * 64, I_E = 2 * I_G + I_D;
        for (int it = gw; it < NEXP1 * I_E; it += NGW) { const int e = it / I_E; int r = it % I_E;
            const float* wg = e < NEXP ? w_gate + (size_t)e * 2048 * 512 : ws_gate; const float* wu = e < NEXP ? w_up + (size_t)e * 2048 * 512 : ws_up; const float* wd = e < NEXP ? w_down + (size_t)e * 512 * 2048 : ws_down;
            if (r < I_G) { tr_item(wg, 512, 64 * (r / 16), 32 * (r % 16), WguT + (size_t)e * 1024 * 2048, 2048, MapGu{0}, nullptr, scr, F.lane); continue; } r -= I_G;
            if (r < I_G) { tr_item(wu, 512, 64 * (r / 16), 32 * (r % 16), WguT + (size_t)e * 1024 * 2048, 2048, MapGu{1}, nullptr, scr, F.lane); continue; } r -= I_G;
            tr_item(wd, 2048, 64 * (r / 64), 32 * (r % 64), WdT + (size_t)e * 2048 * 512, 512, MapId{}, nullptr, scr, F.lane); }
    }
}
__device__ __forceinline__ void p1_h1(Frame& F, const float* __restrict__ x, const float* __restrict__ mod, bf16_t* __restrict__ H1) {
    const int gw = F.vcu * NWAVES + F.wave, NGW = F.G * NWAVES;
    for (int t = gw; t < T; t += NGW) { const int b = t >> 11; const float* m = mod + b * 12288;
        const GAS f32x4* xr = (const GAS f32x4*)(x + (size_t)t * D) + F.lane; GAS u32x2* o = (GAS u32x2*)(H1 + (size_t)t * D) + F.lane;
#pragma unroll
        for (int j = 0; j < 8; ++j) { const f32x4 v = xr[64 * j]; const f32x4 sh = *(const f32x4*)(m + 256 * j + 4 * F.lane), sc = *(const f32x4*)(m + 2048 + 256 * j + 4 * F.lane);
            const f32x4 h = v * (sc + 1.f) + sh; u32x2 w; w.x = cvt_pk_bf16(h[0], h[1]); w.y = cvt_pk_bf16(h[2], h[3]); o[64 * j] = w; } }
}
struct SchedIn {
    TileOrder o; const char* A; const char* Bt;
    __device__ __forceinline__ bool next(int i, pg8::Unit& u) const { int pm, pn; if (!o.get(i, pm, pn)) return false;
        u.pm = pm; u.pn = pn; u.kind = pn < 8 ? 0 : (pn < 12 ? 1 : (pn < 16 ? 2 : 3)); u.aux = 0; u.rows = nullptr; u.nvalid = 256;
        u.a = A + (size_t)pm * 256 * 2048 * 2; u.b = Bt + (size_t)pn * 256 * 2048 * 2; return true; }
};
__device__ __forceinline__ void rope8(f32x4& v0, f32x4& v1, const f32x4 c0, const f32x4 c1) {
    const f32x4 a = v0, b = v1;
    v0[0] = a[0] * c0[0] - a[1] * c0[1]; v0[1] = a[1] * c0[0] + a[0] * c0[1]; v0[2] = a[2] * c0[2] - a[3] * c0[3]; v0[3] = a[3] * c0[2] + a[2] * c0[3];
    v1[0] = b[0] * c1[0] - b[1] * c1[1]; v1[1] = b[1] * c1[0] + b[0] * c1[1]; v1[2] = b[2] * c1[2] - b[3] * c1[3]; v1[3] = b[3] * c1[2] + b[2] * c1[3];
}
__device__ __forceinline__ u32x4 pack8(const f32x4 v0, const f32x4 v1) { u32x4 w; w.x = cvt_pk_bf16(v0[0], v0[1]); w.y = cvt_pk_bf16(v0[2], v0[3]); w.z = cvt_pk_bf16(v1[0], v1[1]); w.w = cvt_pk_bf16(v1[2], v1[3]); return w; }
struct EpiIn {
    static constexpr bool PERM = true;
    bf16_t *QA, *KA, *VA, *CQ, *CKV, *KR; float* SSQ; const float* cs128; const float* cs64;
    __device__ __forceinline__ void operator()(const f32x4 (&acc)[2][2][4][2], const pg8::Unit& u, int wr, int wc, int fr, int fq) const {
        const int row0 = u.pm * 256 + wr * 64 + fr, cl = wc * 32 + 8 * fq;
        if (u.kind == 0) {
            bf16_t* dst = (u.pn < 4 ? QA : KA) + (u.pn & 3) * 256 + cl;
#pragma unroll
            for (int ai = 0; ai < 2; ++ai)
#pragma unroll
                for (int m = 0; m < 4; ++m) { const int row = row0 + ai * 128 + m * 16; const float* cp = cs128 + ((size_t)(row & 2047) * 64 + (cl >> 1)) * 2;
                    const f32x4 c0 = *(const f32x4*)cp, c1 = *(const f32x4*)(cp + 4);
#pragma unroll
                    for (int bj = 0; bj < 2; ++bj) { f32x4 v0 = acc[ai][bj][m][0], v1 = acc[ai][bj][m][1]; rope8(v0, v1, c0, c1);
                        *(u32x4*)(dst + (size_t)row * 1024 + bj * 128) = pack8(v0, v1); } }
        } else if (u.kind == 1) {
            bf16_t* dst = VA + (u.pn - 8) * 256 + cl;
#pragma unroll
            for (int ai = 0; ai < 2; ++ai)
#pragma unroll
                for (int m = 0; m < 4; ++m) { const int row = row0 + ai * 128 + m * 16;
#pragma unroll
                    for (int bj = 0; bj < 2; ++bj) *(u32x4*)(dst + (size_t)row * 1024 + bj * 128) = pack8(acc[ai][bj][m][0], acc[ai][bj][m][1]); }
        } else if (u.kind == 2) {
            const int which = (u.pn - 12) >> 1, half = (u.pn - 12) & 1;
            bf16_t* dst = (which ? CKV : CQ) + half * 256 + cl; float* sq = SSQ + (size_t)which * T * 8 + half * 4 + wc;
#pragma unroll
            for (int ai = 0; ai < 2; ++ai)
#pragma unroll
                for (int m = 0; m < 4; ++m) { const int row = row0 + ai * 128 + m * 16; float s = 0.f;
#pragma unroll
                    for (int bj = 0; bj < 2; ++bj) { const f32x4 v0 = acc[ai][bj][m][0], v1 = acc[ai][bj][m][1];
                        s += (v0[0] * v0[0] + v0[1] * v0[1]) + (v0[2] * v0[2] + v0[3] * v0[3]) + (v1[0] * v1[0] + v1[1] * v1[1]) + (v1[2] * v1[2] + v1[3] * v1[3]);
                        *(u32x4*)(dst + (size_t)row * 512 + bj * 128) = pack8(v0, v1); }
                    s += __shfl_xor(s, 16); s += __shfl_xor(s, 32);
                    if (fq == 0) sq[(size_t)row * 8] = s; }
        } else {
            if (wc < 2) {
#pragma unroll
                for (int ai = 0; ai < 2; ++ai)
#pragma unroll
                    for (int m = 0; m < 4; ++m) { const int row = row0 + ai * 128 + m * 16; const float* cp = cs64 + ((size_t)(row & 2047) * 32 + (cl >> 1)) * 2;
                        const f32x4 c0 = *(const f32x4*)cp, c1 = *(const f32x4*)(cp + 4);
                        f32x4 v0 = acc[ai][0][m][0], v1 = acc[ai][0][m][1]; rope8(v0, v1, c0, c1);
                        *(u32x4*)(KR + (size_t)row * 64 + cl) = pack8(v0, v1); }
            }
        }
    }
};

__device__ __forceinline__ void p3_kmean(Frame& F, const bf16_t* __restrict__ KA, float* __restrict__ KMEAN) {
    LAS float* red = (LAS float*)(F.lds + RING_OFF);
    const int rg = F.tid >> 4, c8 = (F.tid & 15) * 8;
    for (int item = F.vcu; item < 512; item += F.G) { const int h = item & 7, blk = (item >> 3) & 7, b = item >> 6;
        float a[8];
#pragma unroll
        for (int j = 0; j < 8; ++j) a[j] = 0.f;
        for (int r = rg; r < 256; r += 32) { const u32x4 w = *(const u32x4*)(KA + (size_t)(b * 2048 + blk * 256 + r) * 1024 + h * 128 + c8);
            a[0] += bf2f(w.x & 0xffffu); a[1] += bf2f(w.x >> 16); a[2] += bf2f(w.y & 0xffffu); a[3] += bf2f(w.y >> 16); a[4] += bf2f(w.z & 0xffffu); a[5] += bf2f(w.z >> 16); a[6] += bf2f(w.w & 0xffffu); a[7] += bf2f(w.w >> 16); }
#pragma unroll
        for (int j = 0; j < 8; ++j) red[rg * 128 + c8 + j] = a[j];
        __syncthreads();
        if (F.tid < 128) { float s = 0.f; for (int g = 0; g < 32; ++g) s += red[g * 128 + F.tid]; KMEAN[((b * 8 + h) * 8 + blk) * 128 + F.tid] = s * (1.f / 256.f); }
        __syncthreads();
    }
}
struct SchedMla {
    TileOrder o; const char *CQ, *CKV, *WuqT, *WukvT;
    __device__ __forceinline__ bool next(int i, pg8::Unit& u) const { int pm, pn; if (!o.get(i, pm, pn)) return false;
        u.pm = pm; u.pn = pn; u.rows = nullptr; u.nvalid = 256; u.aux = 0;
        if (pn < 6) { u.kind = pn < 4 ? 0 : 1; u.a = CQ + (size_t)pm * 256 * 512 * 2; u.b = WuqT + (size_t)pn * 256 * 512 * 2; }
        else { u.kind = 2; u.a = CKV + (size_t)pm * 256 * 512 * 2; u.b = WukvT + (size_t)(pn - 6) * 256 * 512 * 2; }
        return true; }
};
struct EpiMla {
    static constexpr bool PERM = true;
    bf16_t *QMN, *QMR, *KN, *VM; const float* SSQ; const float* cs64;
    __device__ __forceinline__ void operator()(const f32x4 (&acc)[2][2][4][2], const pg8::Unit& u, int wr, int wc, int fr, int fq) const {
        const int row0 = u.pm * 256 + wr * 64 + fr, cl = wc * 32 + 8 * fq;
        const float* sq = SSQ + (u.kind == 2 ? (size_t)T * 8 : 0);
#pragma unroll
        for (int ai = 0; ai < 2; ++ai)
#pragma unroll
            for (int m = 0; m < 4; ++m) { const int row = row0 + ai * 128 + m * 16;
                const f32x4 p0 = *(const f32x4*)(sq + (size_t)row * 8), p1 = *(const f32x4*)(sq + (size_t)row * 8 + 4);
                const float rs = 1.f / sqrtf((((p0[0] + p0[1]) + (p0[2] + p0[3])) + ((p1[0] + p1[1]) + (p1[2] + p1[3]))) * (1.f / 512.f) + 1e-6f);
                if (u.kind == 0) {
#pragma unroll
                    for (int bj = 0; bj < 2; ++bj) *(u32x4*)(QMN + (size_t)row * 1024 + u.pn * 256 + bj * 128 + cl) = pack8(acc[ai][bj][m][0] * rs, acc[ai][bj][m][1] * rs);
                } else if (u.kind == 1) {
                    const float* cp = cs64 + ((size_t)(row & 2047) * 32 + ((cl & 63) >> 1)) * 2; const f32x4 c0 = *(const f32x4*)cp, c1 = *(const f32x4*)(cp + 4);
#pragma unroll
                    for (int bj = 0; bj < 2; ++bj) { f32x4 v0 = acc[ai][bj][m][0] * rs, v1 = acc[ai][bj][m][1] * rs; rope8(v0, v1, c0, c1);
                        *(u32x4*)(QMR + (size_t)row * 512 + (u.pn - 4) * 256 + bj * 128 + cl) = pack8(v0, v1); }
                } else {
                    *(u32x4*)(KN + (size_t)row * 1024 + (u.pn - 6) * 128 + cl) = pack8(acc[ai][0][m][0] * rs, acc[ai][0][m][1] * rs);
                    *(u32x4*)(VM + (size_t)row * 1024 + (u.pn - 6) * 128 + cl) = pack8(acc[ai][1][m][0] * rs, acc[ai][1][m][1] * rs);
                } }
    }
};
namespace att {
constexpr int NW = 8, QBLK = 32, KVBLK = 64, QB = NW * QBLK;
constexpr int SHM_V = KVBLK * 128 * 2, SHM_K = KVBLK * 128 * 2, SHM_KR = KVBLK * 64 * 2;
constexpr int OFF_V = 0, OFF_K = 2 * SHM_V, OFF_KR = OFF_K + 2 * SHM_K, OFF_WS = OFF_KR + 2 * SHM_KR, OFF_QR = OFF_WS + NW * 64 * 4, ATT_LDS = OFF_QR + NW * 4096;
constexpr float THR = 8.f;

#define KSWZ(row, colB) ((row) * 256 + ((colB) ^ (((row) & 7) << 4)))
#define KRSWZ(row, colB) ((row) * 128 + ((colB) ^ (((row) & 7) << 4)))
#define SBAR() __builtin_amdgcn_sched_barrier(0)
__device__ __forceinline__ int v_st(int k, int c) { const int kk = (k & ~0xC) | ((k & 4) << 1) | ((k & 8) >> 1); return ((kk >> 3) * 4 + (c >> 5)) * 512 + ((kk & 7) * 32 + (c & 31)) * 2; }
__device__ __forceinline__ int v_rd_base(int lane) { return ((lane & 3) << 3) | (((lane >> 2) & 3) << 6) | (((lane >> 4) & 1) << 5) | (((lane >> 5) & 1) << 8); }
constexpr int v_rd_off(int d0, int ks, int half) { return d0 * 512 + ks * 4096 + half * 2048; }
__device__ __forceinline__ int crow(int r, int hi) { return (r & 3) + 8 * (r >> 2) + 4 * hi; }
__device__ __forceinline__ bf16x8 load8(const bf16_t* p) { return *reinterpret_cast<const bf16x8*>(p); }

__device__ __forceinline__ void mask_tile(f32x16& p0, f32x16& p1, int dq) {
    const float NEG = -__builtin_inff();
#pragma unroll
    for (int r = 0; r < 16; ++r) {
        const int c = (r & 3) + 8 * (r >> 2);
        if (dq - c < 0) p0[r] = NEG;
        if (dq - c - 32 < 0) p1[r] = NEG;
    }
}
template <bool MLA>
__device__ __forceinline__ void partialSM(f32x16& p0, f32x16& p1, float& m_reg, float& mn, float& alpha, bool keep) {
    constexpr float SCALE = MLA ? 0.07216878364870323f : 0.08838834764831845f;
    float pmax = p0[0]; for (int r = 1; r < 16; ++r) pmax = fmaxf(pmax, p0[r]); for (int r = 0; r < 16; ++r) pmax = fmaxf(pmax, p1[r]);
    if (!MLA) { if (!keep) pmax = -__builtin_inff(); }
    { auto rr = __builtin_amdgcn_permlane32_swap(__float_as_uint(pmax), __float_as_uint(pmax), false, false);
      pmax = fmaxf(__uint_as_float(rr[0]), __uint_as_float(rr[1])); }
    constexpr float C2 = 1.4426950408889634f * SCALE;
    if (__builtin_expect(__all((pmax - m_reg) * SCALE <= THR), 1)) { mn = m_reg; alpha = 1.f; }
    else { mn = fmaxf(m_reg, pmax); alpha = __builtin_amdgcn_exp2f((m_reg - mn) * C2); m_reg = mn; }
    float mnL = -mn * C2;
    if (!MLA) { if (!keep) mnL = -__builtin_inff(); }
    for (int r = 0; r < 16; ++r) p0[r] = fmaf(p0[r], C2, mnL); for (int r = 0; r < 16; ++r) p1[r] = fmaf(p1[r], C2, mnL);
    for (int r = 0; r < 16; ++r) p0[r] = __builtin_amdgcn_exp2f(p0[r]);
}
__device__ __forceinline__ void finishSM(f32x16& p0, f32x16& p1, float alpha, float& l_reg, bf16x8& pa0, bf16x8& pa1, bf16x8& pa2, bf16x8& pa3) {
    for (int r = 0; r < 16; ++r) p1[r] = __builtin_amdgcn_exp2f(p1[r]);
    float ps = 0; for (int r = 0; r < 16; ++r) ps += p0[r]; for (int r = 0; r < 16; ++r) ps += p1[r];
    { auto rr = __builtin_amdgcn_permlane32_swap(__float_as_uint(ps), __float_as_uint(ps), false, false);
      ps = __uint_as_float(rr[0]) + __uint_as_float(rr[1]); }
    l_reg = l_reg * alpha + ps;
#define PK4(P, B_, OUT) do { unsigned a0 = cvt_pk_bf16(P[B_+0], P[B_+1]), a1 = cvt_pk_bf16(P[B_+2], P[B_+3]);                          \
        unsigned b0 = cvt_pk_bf16(P[B_+4], P[B_+5]), b1 = cvt_pk_bf16(P[B_+6], P[B_+7]);                                             \
        auto r0 = __builtin_amdgcn_permlane32_swap(a0, b0, false, false); auto r1 = __builtin_amdgcn_permlane32_swap(a1, b1, false, false); \
        u32x4 w = {r0[0], r1[0], r0[1], r1[1]}; OUT = *reinterpret_cast<bf16x8*>(&w); } while (0)
    PK4(p0, 0, pa0); PK4(p0, 8, pa1); PK4(p1, 0, pa2); PK4(p1, 8, pa3);
#undef PK4
}
template <int KB, bool MLA>
__device__ __forceinline__ void qkt(f32x16& p0, f32x16& p1, const char* lds, int r32, int hi, const bf16x8* qr, const char* qr2l) {
    p0 = f32x16{}; p1 = f32x16{};
    const char* kb[4];
#pragma unroll
    for (int dd = 0; dd < 4; ++dd) kb[dd] = lds + OFF_K + KB * SHM_K + KSWZ(r32, (dd * 16 + hi * 8) * 2);
#pragma unroll
    for (int d0 = 0; d0 < 8; ++d0) { const char* a = kb[d0 & 3] + (d0 >> 2) * 128;
        bf16x8 b0 = *reinterpret_cast<const bf16x8*>(a);
        bf16x8 b1 = *reinterpret_cast<const bf16x8*>(a + 32 * 256);
        p0 = __builtin_amdgcn_mfma_f32_32x32x16_bf16(b0, qr[d0], p0, 0, 0, 0);
        p1 = __builtin_amdgcn_mfma_f32_32x32x16_bf16(b1, qr[d0], p1, 0, 0, 0); }
    if constexpr (MLA) {
#pragma unroll
        for (int d0 = 0; d0 < 4; ++d0) { const char* a = lds + OFF_KR + KB * SHM_KR + KRSWZ(r32, (d0 * 16 + hi * 8) * 2);
            bf16x8 b0 = *reinterpret_cast<const bf16x8*>(a);
            bf16x8 b1 = *reinterpret_cast<const bf16x8*>(a + 32 * 128);
            const bf16x8 q2 = *reinterpret_cast<const bf16x8*>(qr2l + KRSWZ(r32, (d0 * 16 + hi * 8) * 2));
            p0 = __builtin_amdgcn_mfma_f32_32x32x16_bf16(b0, q2, p0, 0, 0, 0);
            p1 = __builtin_amdgcn_mfma_f32_32x32x16_bf16(b1, q2, p1, 0, 0, 0); }
    }
}
template <int VB>
__device__ __forceinline__ void pv_tile(f32x16* o, int vb0, bf16x8 pa0, bf16x8 pa1, bf16x8 pa2, bf16x8 pa3) {
#define TRRD(dst, off) asm volatile("ds_read_b64_tr_b16 %0, %1 offset:%2" : "=&v"(dst) : "v"(vb0), "i"(off) : "memory")
#define PV_D0(d0) do { s16x4 l0, l1, l2, l3, h0, h1, h2, h3; constexpr int b_ = OFF_V + VB * SHM_V + v_rd_off(d0, 0, 0);   \
        TRRD(l0, b_); TRRD(h0, b_ + 2048); TRRD(l1, b_ + 4096); TRRD(h1, b_ + 6144); TRRD(l2, b_ + 8192); TRRD(h2, b_ + 10240); TRRD(l3, b_ + 12288); TRRD(h3, b_ + 14336); \
        asm volatile("s_waitcnt lgkmcnt(0)" ::: "memory"); SBAR();   \
        o[d0] = __builtin_amdgcn_mfma_f32_32x32x16_bf16(pa0, (bf16x8){l0[0], l0[1], l0[2], l0[3], h0[0], h0[1], h0[2], h0[3]}, o[d0], 0, 0, 0);   \
        o[d0] = __builtin_amdgcn_mfma_f32_32x32x16_bf16(pa1, (bf16x8){l1[0], l1[1], l1[2], l1[3], h1[0], h1[1], h1[2], h1[3]}, o[d0], 0, 0, 0);   \
        o[d0] = __builtin_amdgcn_mfma_f32_32x32x16_bf16(pa2, (bf16x8){l2[0], l2[1], l2[2], l2[3], h2[0], h2[1], h2[2], h2[3]}, o[d0], 0, 0, 0);   \
        o[d0] = __builtin_amdgcn_mfma_f32_32x32x16_bf16(pa3, (bf16x8){l3[0], l3[1], l3[2], l3[3], h3[0], h3[1], h3[2], h3[3]}, o[d0], 0, 0, 0); } while (0)
    PV_D0(0); PV_D0(1); PV_D0(2); PV_D0(3);
#undef PV_D0
#undef TRRD
}
struct BlockRef { const bf16_t* Q; const bf16_t* Qr; const bf16_t* K; const bf16_t* Kr; const bf16_t* V; bf16_t* O; const float* kmean; int P0; };
template <bool MLA> struct Seam { bf16x8 qr[8]; bf16x8 st_v0, st_v1, st_k0, st_k1; };

#define ROWK(p, k0, rr) ((p) + (size_t)((k0) + (rr)) * 1024 + sc)
#define VMW() asm volatile("s_waitcnt vmcnt(0)" ::: "memory")
#define VMWN(n) asm volatile("s_waitcnt vmcnt(%0)" :: "i"(n) : "memory")
#define SLOAD_H(Kp, Krp, Vp, k0, bf) do { S.st_v0 = load8(ROWK(Vp, k0, sr)); S.st_v1 = load8(ROWK(Vp, k0, 32 + sr));              \
                         if constexpr (MLA) {   \
                             __builtin_amdgcn_global_load_lds((const unsigned*)((Kp) + (size_t)(k0) * 1024 + kd0), (LAS unsigned*)(ldsl + OFF_K + (bf) * SHM_K + wid * 1024), 16, 0, 0);          \
                             __builtin_amdgcn_global_load_lds((const unsigned*)((Kp) + (size_t)(k0) * 1024 + kd1), (LAS unsigned*)(ldsl + OFF_K + (bf) * SHM_K + 8192 + wid * 1024), 16, 0, 0);   \
                             __builtin_amdgcn_global_load_lds((const unsigned*)((Krp) + (size_t)(k0) * 64 + kdr), (LAS unsigned*)(ldsl + OFF_KR + (bf) * SHM_KR + wid * 1024), 16, 0, 0); }          \
                         else { S.st_k0 = load8(ROWK(Kp, k0, sr)); S.st_k1 = load8(ROWK(Kp, k0, 32 + sr)); } } while (0)
#define SWRITE_HK(bf) do { if constexpr (!MLA) { *(bf16x8*)(lds + OFF_K + (bf) * SHM_K + kws) = S.st_k0; *(bf16x8*)(lds + OFF_K + (bf) * SHM_K + kws + 32 * 256) = S.st_k1; } } while (0)
#define SWRITE_HV(bf) do { *(bf16x8*)(lds + OFF_V + (bf) * SHM_V + vst0) = S.st_v0; *(bf16x8*)(lds + OFF_V + (bf) * SHM_V + vst1) = S.st_v1; } while (0)
#define SWRITE_H(bf) do { SWRITE_HV(bf); SWRITE_HK(bf); } while (0)
#define QLOAD(ref) do { _Pragma("unroll") for (int d0 = 0; d0 < 8; ++d0) S.qr[d0] = load8((ref).Q + (size_t)(wid * QBLK + r32) * 1024 + d0 * 16 + hi * 8); } while (0)

template <bool MLA>
__device__ __forceinline__ void prime(const BlockRef& cur, char* lds, LAS char* ldsl, Seam<MLA>& S) {
    const int tid = threadIdx.x, wid = __builtin_amdgcn_readfirstlane(tid >> 6), lane = tid & 63, r32 = lane & 31, hi = lane >> 5;
    const int sr = tid >> 4, sc = (tid & 15) * 8, kws = KSWZ(sr, sc * 2);
    int kd0, kd1, kdr; { const int g0 = wid * 64 + lane, r0 = g0 >> 4, p0 = g0 & 15; kd0 = r0 * 1024 + ((p0 ^ (r0 & 7)) << 3); const int g1 = 512 + g0, r1 = g1 >> 4, p1 = g1 & 15; kd1 = r1 * 1024 + ((p1 ^ (r1 & 7)) << 3);
        const int rr = g0 >> 3, pr = g0 & 7; kdr = rr * 64 + ((pr ^ (rr & 7)) << 3); }
    QLOAD(cur);
    S.st_v0 = load8(ROWK(cur.V, 0, sr)); S.st_v1 = load8(ROWK(cur.V, 0, 32 + sr));
    __builtin_amdgcn_global_load_lds((const unsigned*)(cur.K + kd0), (LAS unsigned*)(ldsl + OFF_K + wid * 1024), 16, 0, 0);
    __builtin_amdgcn_global_load_lds((const unsigned*)(cur.K + kd1), (LAS unsigned*)(ldsl + OFF_K + 8192 + wid * 1024), 16, 0, 0);
    if constexpr (MLA) __builtin_amdgcn_global_load_lds((const unsigned*)(cur.Kr + kdr), (LAS unsigned*)(ldsl + OFF_KR + wid * 1024), 16, 0, 0);
    VMW(); (void)kws;
    __syncthreads();
}
template <bool MLA>
__device__ __forceinline__ void block(const BlockRef& cur, const BlockRef& nxt, char* lds, LAS char* ldsl, Seam<MLA>& S) {
    const int tid = threadIdx.x, wid = __builtin_amdgcn_readfirstlane(tid >> 6), lane = tid & 63, r32 = lane & 31, hi = lane >> 5;
    const int NT = (cur.P0 + QB) / KVBLK;
    const int qlo = cur.P0 + wid * QBLK, qm = qlo + r32 - 4 * hi;
    float* ws = (float*)(lds + OFF_WS) + wid * 64; float* li_l = ws, * al_l = ws + 32;
    float m_reg = -1e30f, l_reg = 0; f32x16 o[4] = {};
    const int sr = tid >> 4, sc = (tid & 15) * 8, vst0 = v_st(sr, sc), vst1 = v_st(32 + sr, sc), kws = KSWZ(sr, sc * 2);
    int kd0, kd1, kdr; { const int g0 = wid * 64 + lane, r0 = g0 >> 4, p0 = g0 & 15; kd0 = r0 * 1024 + ((p0 ^ (r0 & 7)) << 3); const int g1 = 512 + g0, r1 = g1 >> 4, p1 = g1 & 15; kd1 = r1 * 1024 + ((p1 ^ (r1 & 7)) << 3);
        const int rr = g0 >> 3, pr = g0 & 7; kdr = rr * 64 + ((pr ^ (rr & 7)) << 3); }
    const int vb0 = (int)(uintptr_t)lds + v_rd_base(lane);
    const bf16_t* Kh = cur.K; const bf16_t* Krh = cur.Kr; const bf16_t* Vh = cur.V;
    const char* qr2l = lds + OFF_QR + wid * 4096;
    if constexpr (MLA) {
        bf16x8 tq[4];
#pragma unroll
        for (int d0 = 0; d0 < 4; ++d0) tq[d0] = load8(cur.Qr + (size_t)(wid * QBLK + r32) * 512 + d0 * 16 + hi * 8);
#pragma unroll
        for (int d0 = 0; d0 < 4; ++d0) *(bf16x8*)(lds + OFF_QR + wid * 4096 + KRSWZ(r32, (d0 * 16 + hi * 8) * 2)) = tq[d0];
        asm volatile("s_waitcnt lgkmcnt(0)" ::: "memory");
    }
    unsigned selm = 0u; const int own = cur.P0 >> 8;
    if constexpr (!MLA) {
        if (own > 0) {
            f32x16 g = {};
#pragma unroll
            for (int d0 = 0; d0 < 8; ++d0) { bf16x8 ah = {0, 0, 0, 0, 0, 0, 0, 0}, al = {0, 0, 0, 0, 0, 0, 0, 0};
                if (r32 < 8) { const float* kp = cur.kmean + r32 * 128 + d0 * 16 + hi * 8; const f32x4 x0 = *(const f32x4*)kp, x1 = *(const f32x4*)(kp + 4);
                    unsigned hh[4], ll[4];
#pragma unroll
                    for (int j = 0; j < 2; ++j) { const float a0 = x0[2 * j], a1 = x0[2 * j + 1], b0 = x1[2 * j], b1 = x1[2 * j + 1];
                        const unsigned ha0 = f2bf(a0), ha1 = f2bf(a1), hb0 = f2bf(b0), hb1 = f2bf(b1);
                        hh[j] = ha0 | (ha1 << 16); hh[2 + j] = hb0 | (hb1 << 16);
                        ll[j] = f2bf(a0 - bf2f(ha0)) | (f2bf(a1 - bf2f(ha1)) << 16); ll[2 + j] = f2bf(b0 - bf2f(hb0)) | (f2bf(b1 - bf2f(hb1)) << 16); }
                    u32x4 wh = {hh[0], hh[1], hh[2], hh[3]}, wl = {ll[0], ll[1], ll[2], ll[3]}; ah = *reinterpret_cast<bf16x8*>(&wh); al = *reinterpret_cast<bf16x8*>(&wl); }
                g = __builtin_amdgcn_mfma_f32_32x32x16_bf16(ah, S.qr[d0], g, 0, 0, 0);
                g = __builtin_amdgcn_mfma_f32_32x32x16_bf16(al, S.qr[d0], g, 0, 0, 0); }
            float gt[8];
#pragma unroll
            for (int r = 0; r < 4; ++r) { auto rr = __builtin_amdgcn_permlane32_swap(__float_as_uint(g[r]), __float_as_uint(g[r]), false, false); gt[r] = __uint_as_float(rr[0]); gt[r + 4] = __uint_as_float(rr[1]); }
#pragma unroll
            for (int n = 0; n < 8; ++n) { int rank = 0;
#pragma unroll
                for (int j = 0; j < 8; ++j) rank += (j < own && (gt[j] > gt[n] || (gt[j] == gt[n] && j < n))) ? 1 : 0;
                if (n < own && rank < 3) selm |= 1u << n; }
        }
    }
#define RESC(a) do { if (__any((a) < 1.f)) { if (hi == 0) al_l[r32] = (a); asm volatile("s_waitcnt lgkmcnt(0)" ::: "memory");              \
                     for (int d_ = 0; d_ < 4; ++d_) for (int r = 0; r < 16; ++r) o[d_][r] *= al_l[crow(r, hi)]; } } while (0)
#define KBASE(t) ((t) * KVBLK)
#define KEEP(t) (MLA || (KBASE(t) >> 8) >= own || ((selm >> (KBASE(t) >> 8)) & 1u))
#define MASKT(P0_, P1_, t) do { const int kb_ = KBASE(t); if (kb_ + KVBLK - 1 > qlo) mask_tile(P0_, P1_, qm - kb_); } while (0)
    constexpr int NQL = 8;
#define SEAM_K0() do { VMWN(NQL); SWRITE_HK(0); SBAR(); } while (0)
    f32x16 pA0, pA1, pB0, pB1; float mnA, mnB, alA, alB; bf16x8 pa0, pa1, pa2, pa3;
    SWRITE_HV(0); SBAR();
    if (NT > 1) SLOAD_H(Kh, Krh, Vh, KBASE(1), 1);
    SBAR(); qkt<0, MLA>(pA0, pA1, lds, r32, hi, S.qr, qr2l);
    MASKT(pA0, pA1, 0); partialSM<MLA>(pA0, pA1, m_reg, mnA, alA, KEEP(0));
    if (NT > 1) { VMW(); SWRITE_H(1); }
    __syncthreads();
#define HALF_STEP(PX0, PX1, mnX, alX, PY0, PY1, alY, t, KB, VB, SB) do {                                                      \
        SBAR(); qkt<KB, MLA>(PX0, PX1, lds, r32, hi, S.qr, qr2l);                                                            \
        finishSM(PY0, PY1, alY, l_reg, pa0, pa1, pa2, pa3); SBAR();                                                           \
        if ((t) + 1 < NT) { SLOAD_H(Kh, Krh, Vh, KBASE((t) + 1), SB); SBAR(); }                                                   \
        pv_tile<VB>(o, vb0, pa0, pa1, pa2, pa3); MASKT(PX0, PX1, (t)); partialSM<MLA>(PX0, PX1, m_reg, mnX, alX, KEEP(t));    \
        __syncthreads();                                                                                                      \
        if ((t) + 1 < NT) { VMW(); SWRITE_H(SB); }                                                                            \
        RESC(alX); __syncthreads(); } while (0)
    for (int t = 1; t + 1 < NT; t += 2) {
        HALF_STEP(pB0, pB1, mnB, alB, pA0, pA1, alA, t, 1, 0, 0);
        HALF_STEP(pA0, pA1, mnA, alA, pB0, pB1, alB, t + 1, 0, 1, 1);
    }
    SBAR(); qkt<1, MLA>(pB0, pB1, lds, r32, hi, S.qr, qr2l); SBAR();
    SLOAD_H(nxt.K, nxt.Kr, nxt.V, 0, 0); SBAR();
    QLOAD(nxt);
    SBAR();
    finishSM(pA0, pA1, alA, l_reg, pa0, pa1, pa2, pa3); SBAR();
    pv_tile<0>(o, vb0, pa0, pa1, pa2, pa3);
    MASKT(pB0, pB1, NT - 1); partialSM<MLA>(pB0, pB1, m_reg, mnB, alB, KEEP(NT - 1)); __syncthreads(); RESC(alB);
    finishSM(pB0, pB1, alB, l_reg, pa0, pa1, pa2, pa3); SBAR(); pv_tile<1>(o, vb0, pa0, pa1, pa2, pa3);
    SBAR(); SEAM_K0();
    if (hi == 0) li_l[r32] = l_reg; asm volatile("s_waitcnt lgkmcnt(0)" ::: "memory");
    float rli[16];
#pragma unroll
    for (int r = 0; r < 16; ++r) rli[r] = __builtin_amdgcn_rcpf(li_l[crow(r, hi)]);
    bf16_t* Ow = cur.O + (size_t)(wid * QBLK) * 2048;
#pragma unroll
    for (int r = 0; r < 16; ++r) { const int orow = crow(r, hi);
#pragma unroll
        for (int d0 = 0; d0 < 4; ++d0) { const float v = o[d0][r] * rli[r];
            const float vn = __shfl_xor(v, 1);
            if ((r32 & 1) == 0) *(unsigned*)(Ow + (size_t)orow * 2048 + d0 * 32 + r32) = cvt_pk_bf16(v, vn); } }
    if constexpr (MLA) VMW();
    __syncthreads();
#undef RESC
#undef KBASE
#undef KEEP
#undef MASKT
#undef SEAM_K0
#undef HALF_STEP
}
template <bool MLA>
__device__ __forceinline__ void block_np(const BlockRef& cur, const BlockRef& nxt, char* lds, LAS char* ldsl, Seam<MLA>& S) {
    const int tid = threadIdx.x, wid = __builtin_amdgcn_readfirstlane(tid >> 6), lane = tid & 63, r32 = lane & 31, hi = lane >> 5;
    const int NT = (cur.P0 + QB) / KVBLK;
    const int qlo = cur.P0 + wid * QBLK, qm = qlo + r32 - 4 * hi;
    float* ws = (float*)(lds + OFF_WS) + wid * 64; float* li_l = ws, * al_l = ws + 32;
    float m_reg = -1e30f, l_reg = 0; f32x16 o[4] = {};
    const int sr = tid >> 4, sc = (tid & 15) * 8, vst0 = v_st(sr, sc), vst1 = v_st(32 + sr, sc), kws = 0; (void)kws;
    int kd0, kd1, kdr; { const int g0 = wid * 64 + lane, r0 = g0 >> 4, p0 = g0 & 15; kd0 = r0 * 1024 + ((p0 ^ (r0 & 7)) << 3); const int g1 = 512 + g0, r1 = g1 >> 4, p1 = g1 & 15; kd1 = r1 * 1024 + ((p1 ^ (r1 & 7)) << 3);
        const int rr = g0 >> 3, pr = g0 & 7; kdr = rr * 64 + ((pr ^ (rr & 7)) << 3); }
    const int vb0 = (int)(uintptr_t)lds + v_rd_base(lane);
    const char* qr2l = lds + OFF_QR + wid * 4096;
#define KV_LOAD(Kp, Krp, Vp, k0, bf) do { S.st_v0 = load8(ROWK(Vp, k0, sr)); S.st_v1 = load8(ROWK(Vp, k0, 32 + sr));                                                                        \
        __builtin_amdgcn_global_load_lds((const unsigned*)((Kp) + (size_t)(k0) * 1024 + kd0), (LAS unsigned*)(ldsl + OFF_K + (bf) * SHM_K + wid * 1024), 16, 0, 0);                       \
        __builtin_amdgcn_global_load_lds((const unsigned*)((Kp) + (size_t)(k0) * 1024 + kd1), (LAS unsigned*)(ldsl + OFF_K + (bf) * SHM_K + 8192 + wid * 1024), 16, 0, 0);                \
        if constexpr (MLA) __builtin_amdgcn_global_load_lds((const unsigned*)((Krp) + (size_t)(k0) * 64 + kdr), (LAS unsigned*)(ldsl + OFF_KR + (bf) * SHM_KR + wid * 1024), 16, 0, 0); } while (0)
    if constexpr (MLA) {
        bf16x8 tq[4];
#pragma unroll
        for (int d0 = 0; d0 < 4; ++d0) tq[d0] = load8(cur.Qr + (size_t)(wid * QBLK + r32) * 512 + d0 * 16 + hi * 8);
#pragma unroll
        for (int d0 = 0; d0 < 4; ++d0) *(bf16x8*)(lds + OFF_QR + wid * 4096 + KRSWZ(r32, (d0 * 16 + hi * 8) * 2)) = tq[d0];
    }
    unsigned selm = 0u; const int own = cur.P0 >> 8;
    if constexpr (!MLA) {
        if (own > 0) {
            f32x16 g = {};
#pragma unroll
            for (int d0 = 0; d0 < 8; ++d0) { bf16x8 ah = {0, 0, 0, 0, 0, 0, 0, 0}, al = {0, 0, 0, 0, 0, 0, 0, 0};
                if (r32 < 8) { const float* kp = cur.kmean + r32 * 128 + d0 * 16 + hi * 8; const f32x4 x0 = *(const f32x4*)kp, x1 = *(const f32x4*)(kp + 4);
                    unsigned hh[4], ll[4];
#pragma unroll
                    for (int j = 0; j < 2; ++j) { const float a0 = x0[2 * j], a1 = x0[2 * j + 1], b0 = x1[2 * j], b1 = x1[2 * j + 1];
                        const unsigned ha0 = f2bf(a0), ha1 = f2bf(a1), hb0 = f2bf(b0), hb1 = f2bf(b1);
                        hh[j] = ha0 | (ha1 << 16); hh[2 + j] = hb0 | (hb1 << 16);
                        ll[j] = f2bf(a0 - bf2f(ha0)) | (f2bf(a1 - bf2f(ha1)) << 16); ll[2 + j] = f2bf(b0 - bf2f(hb0)) | (f2bf(b1 - bf2f(hb1)) << 16); }
                    u32x4 wh = {hh[0], hh[1], hh[2], hh[3]}, wl = {ll[0], ll[1], ll[2], ll[3]}; ah = *reinterpret_cast<bf16x8*>(&wh); al = *reinterpret_cast<bf16x8*>(&wl); }
                g = __builtin_amdgcn_mfma_f32_32x32x16_bf16(ah, S.qr[d0], g, 0, 0, 0);
                g = __builtin_amdgcn_mfma_f32_32x32x16_bf16(al, S.qr[d0], g, 0, 0, 0); }
            float gt[8];
#pragma unroll
            for (int r = 0; r < 4; ++r) { auto rr = __builtin_amdgcn_permlane32_swap(__float_as_uint(g[r]), __float_as_uint(g[r]), false, false); gt[r] = __uint_as_float(rr[0]); gt[r + 4] = __uint_as_float(rr[1]); }
#pragma unroll
            for (int n = 0; n < 8; ++n) { int rank = 0;
#pragma unroll
                for (int j = 0; j < 8; ++j) rank += (j < own && (gt[j] > gt[n] || (gt[j] == gt[n] && j < n))) ? 1 : 0;
                if (n < own && rank < 3) selm |= 1u << n; }
        }
    }
    SWRITE_HV(0);
    asm volatile("s_waitcnt lgkmcnt(0)" ::: "memory");
    __syncthreads();
    f32x16 p0, p1; float mn, al; bf16x8 pa0, pa1, pa2, pa3;
#define RESC(a) do { if (__any((a) < 1.f)) { if (hi == 0) al_l[r32] = (a); asm volatile("s_waitcnt lgkmcnt(0)" ::: "memory");              \
                     for (int d_ = 0; d_ < 4; ++d_) for (int r = 0; r < 16; ++r) o[d_][r] *= al_l[crow(r, hi)]; } } while (0)
#define MSTEP(t, BUF, NB) do {                                                                                               \
        const bool lastt = ((t) + 1 >= NT);                                                                                  \
        { const bf16_t* Kp_ = lastt ? nxt.K : cur.K; const bf16_t* Krp_ = lastt ? nxt.Kr : cur.Kr; const bf16_t* Vp_ = lastt ? nxt.V : cur.V; const int k0_ = lastt ? 0 : ((t) + 1) * KVBLK; \
          KV_LOAD(Kp_, Krp_, Vp_, k0_, NB); }                                                                                  \
        SBAR(); qkt<BUF, MLA>(p0, p1, lds, r32, hi, S.qr, qr2l); SBAR();                                                      \
        if (lastt) { QLOAD(nxt); SBAR(); }                                                                                   \
        { const int kb_ = (t) * KVBLK; if (kb_ + KVBLK - 1 > qlo) mask_tile(p0, p1, qm - kb_); }                              \
        partialSM<MLA>(p0, p1, m_reg, mn, al, MLA || (((t) * KVBLK) >> 8) >= own || ((selm >> (((t) * KVBLK) >> 8)) & 1u)); finishSM(p0, p1, al, l_reg, pa0, pa1, pa2, pa3); RESC(al); SBAR(); \
        pv_tile<BUF>(o, vb0, pa0, pa1, pa2, pa3);                                                                            \
        if (!lastt) { VMW(); SWRITE_HV(NB); asm volatile("s_waitcnt lgkmcnt(0)" ::: "memory"); __syncthreads(); } } while (0)
    for (int t = 0; t < NT; t += 2) { MSTEP(t, 0, 1); MSTEP(t + 1, 1, 0); }
#undef MSTEP
#undef KV_LOAD
    if (hi == 0) li_l[r32] = l_reg; asm volatile("s_waitcnt lgkmcnt(0)" ::: "memory");
    float rli[16];
#pragma unroll
    for (int r = 0; r < 16; ++r) rli[r] = __builtin_amdgcn_rcpf(li_l[crow(r, hi)]);
    bf16_t* Ow = cur.O + (size_t)(wid * QBLK) * 2048;
#pragma unroll
    for (int r = 0; r < 16; ++r) { const int orow = crow(r, hi);
#pragma unroll
        for (int d0 = 0; d0 < 4; ++d0) { const float v = o[d0][r] * rli[r];
            const float vn = __shfl_xor(v, 1);
            if ((r32 & 1) == 0) *(unsigned*)(Ow + (size_t)orow * 2048 + d0 * 32 + r32) = cvt_pk_bf16(v, vn); } }
    VMW();
    __syncthreads();
#undef RESC
}
#undef ROWK
#undef VMW
#undef VMWN
#undef SLOAD_H
#undef SWRITE_HK
#undef SWRITE_HV
#undef SWRITE_H
#undef QLOAD

struct Tensors { const bf16_t *QA, *KA, *VA, *QMN, *QMR, *KN, *KR, *VM; bf16_t* MIX; const float* KMEAN; };
template <bool MLA>
__device__ __forceinline__ BlockRef make_ref(const Tensors& Tn, int item, int pass) {
    const int bh = item >> 2, y = item & 3, b = bh >> 3, h = bh & 7, qb = pass ? 7 - y : y;
    BlockRef r; const size_t t0 = (size_t)b * 2048, tq = t0 + (size_t)qb * 256;
    if (MLA) { r.Q = Tn.QMN + tq * 1024 + h * 128; r.Qr = Tn.QMR + tq * 512 + h * 64; r.K = Tn.KN + t0 * 1024 + h * 128; r.Kr = Tn.KR + t0 * 64; r.V = Tn.VM + t0 * 1024 + h * 128; r.O = Tn.MIX + tq * 2048 + 1024 + h * 128; r.kmean = nullptr; }
    else { r.Q = Tn.QA + tq * 1024 + h * 128; r.Qr = nullptr; r.K = Tn.KA + t0 * 1024 + h * 128; r.Kr = nullptr; r.V = Tn.VA + t0 * 1024 + h * 128; r.O = Tn.MIX + tq * 2048 + h * 128; r.kmean = Tn.KMEAN + (size_t)bh * 8 * 128; }
    r.P0 = qb * 256; return r;
}
template <bool MLA>
__device__ __forceinline__ void phase(char* lds, LAS char* ldsl, const Tensors& Tn, int vcu, int G) {
    constexpr int total = 256;
    int L = vcu; if (L >= total) return;
    int pass = 0;
    BlockRef cur = make_ref<MLA>(Tn, L, 0);
    Seam<MLA> S;
    prime<MLA>(cur, lds, ldsl, S);
    for (;;) {
        const bool more_pass = pass == 0, more_item = L + G < total, last = !more_pass && !more_item;
        int passn = pass + 1, Ln = L;
        if (!more_pass) { passn = 0; Ln = more_item ? L + G : L; }
        const BlockRef nxt = last ? cur : make_ref<MLA>(Tn, Ln, passn);
        block_np<MLA>(cur, nxt, lds, ldsl, S);
        if (last) break;
        cur = nxt; pass = passn; L = Ln;
    }
}
}
struct SchedOut {
    TileOrder o; const char* A; const char* Bt;
    __device__ __forceinline__ bool next(int i, pg8::Unit& u) const { int pm, pn; if (!o.get(i, pm, pn)) return false;
        u.pm = pm; u.pn = pn; u.kind = 0; u.aux = 0; u.rows = nullptr; u.nvalid = 256; u.a = A + (size_t)pm * 256 * 2048 * 2; u.b = Bt + (size_t)pn * 256 * 2048 * 2; return true; }
};
struct EpiOut {
    static constexpr bool PERM = false;
    const float* x; const float* mod; float* Y;
    __device__ __forceinline__ void operator()(const f32x4 (&acc)[2][2][4][2], const pg8::Unit& u, int wr, int wc, int fr, int fq) const {
        const int row0 = u.pm * 256 + wr * 64 + fr, col0 = u.pn * 256 + wc * 32 + 4 * fq;
        const float* g1 = mod + (size_t)(u.pm >> 3) * 12288 + 2 * 2048;
        f32x4 gv[2][2];
#pragma unroll
        for (int bj = 0; bj < 2; ++bj)
#pragma unroll
            for (int n = 0; n < 2; ++n) gv[bj][n] = *(const f32x4*)(g1 + col0 + bj * 128 + n * 16) + 1.f;
#pragma unroll
        for (int ai = 0; ai < 2; ++ai)
#pragma unroll
            for (int m = 0; m < 4; ++m) { const size_t off = (size_t)(row0 + ai * 128 + m * 16) * 2048 + col0;
#pragma unroll
                for (int bj = 0; bj < 2; ++bj)
#pragma unroll
                    for (int n = 0; n < 2; ++n) { const f32x4 xv = *(const f32x4*)(x + off + bj * 128 + n * 16); *(f32x4*)(Y + off + bj * 128 + n * 16) = xv * ALPHA + gv[bj][n] * acc[ai][bj][m][n]; }
                asm volatile("" ::: "memory"); }
    }
};

__device__ __forceinline__ void p6_ln_route(Frame& F, const float* __restrict__ Y, const float* __restrict__ mod, const float* __restrict__ lg, const float* __restrict__ lb, float* __restrict__ X1, bf16_t* __restrict__ H2,
                                            const bf16_t* __restrict__ WrT, const float* __restrict__ rbias, float* __restrict__ logits, unsigned long long* __restrict__ tokmask, float* __restrict__ tw, int* __restrict__ hist) {
    for (int blk = F.vcu; blk < 256; blk += F.G) {
        for (int i = F.wave; i < 64; i += NWAVES) { const int t = blk * 64 + i, b = t >> 11; const float* m = mod + b * 12288;
            const GAS f32x4* yr = (const GAS f32x4*)(Y + (size_t)t * D) + F.lane; f32x4 v[8]; float s = 0.f;
#pragma unroll
            for (int j = 0; j < 8; ++j) { v[j] = yr[64 * j]; s += (v[j][0] + v[j][1]) + (v[j][2] + v[j][3]); }
            const float mean = wave_sum(s) * (1.f / D); float s2 = 0.f;
#pragma unroll
            for (int j = 0; j < 8; ++j) { v[j] = v[j] - mean; s2 += (v[j][0] * v[j][0] + v[j][1] * v[j][1]) + (v[j][2] * v[j][2] + v[j][3] * v[j][3]); }
            const float rstd = 1.f / sqrtf(wave_sum(s2) * (1.f / D) + 1e-5f);
            GAS f32x4* xo = (GAS f32x4*)(X1 + (size_t)t * D) + F.lane; GAS u32x2* ho = (GAS u32x2*)(H2 + (size_t)t * D) + F.lane;
#pragma unroll
            for (int j = 0; j < 8; ++j) { const int d = 256 * j + 4 * F.lane; const f32x4 o = v[j] * rstd * *(const f32x4*)(lg + d) + *(const f32x4*)(lb + d); xo[64 * j] = o;
                const f32x4 h = o * (*(const f32x4*)(m + 4 * 2048 + d) + 1.f) + *(const f32x4*)(m + 3 * 2048 + d); u32x2 w; w.x = cvt_pk_bf16(h[0], h[1]); w.y = cvt_pk_bf16(h[2], h[3]); ho[64 * j] = w; } }
        VM_WAIT(); __syncthreads();
        { const int fr = F.lane & 15, fq = F.lane >> 4; f32x4 acc[4][4];
#pragma unroll
            for (int mi = 0; mi < 4; ++mi)
#pragma unroll
                for (int ni = 0; ni < 4; ++ni) acc[mi][ni] = (f32x4){0.f, 0.f, 0.f, 0.f};
#pragma unroll 1
            for (int ks = 0; ks < 8; ++ks) { const int k = F.wave * 256 + ks * 32 + fq * 8; bf16x8 a[4], bh[4], bl[4];
#pragma unroll
                for (int mi = 0; mi < 4; ++mi) a[mi] = *(const bf16x8*)(H2 + (size_t)(blk * 64 + mi * 16 + fr) * D + k);
#pragma unroll
                for (int ni = 0; ni < 4; ++ni) { bh[ni] = *(const bf16x8*)(WrT + (size_t)(ni * 16 + fr) * D + k); bl[ni] = *(const bf16x8*)(WrT + (size_t)(64 + ni * 16 + fr) * D + k); }
#pragma unroll
                for (int mi = 0; mi < 4; ++mi)
#pragma unroll
                    for (int ni = 0; ni < 4; ++ni) { acc[mi][ni] = __builtin_amdgcn_mfma_f32_16x16x32_bf16(a[mi], bh[ni], acc[mi][ni], 0, 0, 0); acc[mi][ni] = __builtin_amdgcn_mfma_f32_16x16x32_bf16(a[mi], bl[ni], acc[mi][ni], 0, 0, 0); } }
            LAS float* red = (LAS float*)(F.lds + RING_OFF) + F.wave * 4096;
#pragma unroll
            for (int mi = 0; mi < 4; ++mi)
#pragma unroll
                for (int ni = 0; ni < 4; ++ni)
#pragma unroll
                    for (int r = 0; r < 4; ++r) red[(mi * 16 + 4 * fq + r) * 64 + ni * 16 + fr] = acc[mi][ni][r];
            __syncthreads();
            float sums[8];
#pragma unroll
            for (int q = 0; q < 8; ++q) { const int i = F.tid + q * NTHR; float s = 0.f;
#pragma unroll
                for (int w = 0; w < 8; ++w) s += ((LAS float*)(F.lds + RING_OFF))[w * 4096 + i];
                sums[q] = s; }
            __syncthreads();
#pragma unroll
            for (int q = 0; q < 8; ++q) { const int i = F.tid + q * NTHR; logits[(size_t)blk * 4096 + i] = sums[q]; ((LAS float*)(F.lds + RING_OFF))[i] = sums[q]; }
            __syncthreads();
        }
        { LAS float* lg_l = (LAS float*)(F.lds + RING_OFF); LAS unsigned long long* lm = (LAS unsigned long long*)(F.lds + RING_OFF + 16384);
            const float bias = rbias[F.lane];
            for (int i = F.wave; i < 64; i += NWAVES) { const int t = blk * 64 + i; unsigned long long mask; float w;
                rt::route_token(lg_l[i * 64 + F.lane], bias, F.lane, mask, w);
                tw[(size_t)t * 64 + F.lane] = w; if (F.lane == 0) { tokmask[t] = mask; lm[i] = mask; } }
            __syncthreads();
            if (F.tid < 64) { int c = 0; for (int i = 0; i < 64; ++i) c += (int)((lm[i] >> F.tid) & 1ull); hist[blk * 64 + F.tid] = c; }
            __syncthreads();
        }
    }
}
__device__ __forceinline__ void p7_scatter(Frame& F, const int* hist, const unsigned long long* tokmask, const float* tw, int* stok, float* sw, int* tokpos, int* starts, int* cnts) {
    LAS int* li = (LAS int*)(F.lds + RING_OFF);
    for (int blk = F.vcu; blk < 256; blk += F.G) {
        const int e = F.tid;
        if (e < 64) { int tot = 0, before = 0; for (int b = 0; b < 256; ++b) { const int c = hist[b * 64 + e]; tot += c; if (b < blk) before += c; } li[e] = tot; li[64 + e] = before; }
        __syncthreads();
        if (e < 64) { int st = 0; for (int j = 0; j < e; ++j) st += li[j];
            if (blk == 0) { starts[e] = st; cnts[e] = li[e]; }
            int pos = st + li[64 + e];
            for (int i = 0; i < 64; ++i) { const int t = blk * 64 + i; const unsigned long long m = tokmask[t];
                if ((m >> e) & 1ull) { stok[pos] = t; sw[pos] = tw[(size_t)t * 64 + e]; tokpos[t * 8 + __popcll(m & ((1ull << e) - 1ull))] = pos; ++pos; } } }
        __syncthreads();
    }
}
struct SchedMoe {
    const LAS int* tstart; const int* starts; const int* cnts; int ntiles, nN, G, c; int K;
    const char* A; const char* Bt; size_t bstride; const int* stok; bool gather;
    __device__ __forceinline__ bool next(int i, pg8::Unit& u) const {
        const long L = (long)i * G + c; const int nwg = ntiles * nN; if (L >= nwg) return false;
        const int wgid = pg8::xcd_remap((int)L, nwg);
        const int nig = 8 * nN, gid = wgid / nig, fm = gid * 8, gsz = (ntiles - fm) < 8 ? (ntiles - fm) : 8;
        const int rt_ = fm + ((wgid % nig) % gsz), pn = (wgid % nig) / gsz;
        int e = 0;
#pragma unroll 1
        for (int s = 32; s >= 1; s >>= 1) if (e + s <= 64 && tstart[e + s] <= rt_) e += s;
        if (e < 64 && tstart[64] <= rt_) e = 64;
        const int mt = rt_ - tstart[e];
        const int cnt = e < 64 ? cnts[e] : T, st = e < 64 ? starts[e] : 131072;
        u.pm = st + mt * 256;
        u.pn = pn; u.kind = e < 64 ? 0 : 1; u.aux = e; u.nvalid = (cnt - mt * 256) < 256 ? (cnt - mt * 256) : 256;
        if (gather) { u.rows = e < 64 ? stok + st + mt * 256 : nullptr; u.a = A; if (e == 64) u.a = A + (size_t)mt * 256 * K * 2; }
        else { u.rows = nullptr; u.a = A + (size_t)u.pm * K * 2; }
        u.b = Bt + (size_t)e * bstride + (size_t)pn * 256 * K * 2;
        return true; }
};
__device__ __forceinline__ int build_tiles(Frame& F, const int* cnts, LAS int* tstart) {
    if (F.tid == 0) { int acc = 0; for (int e = 0; e < 64; ++e) { tstart[e] = acc; acc += (cnts[e] + 255) >> 8; } tstart[64] = acc; acc += T / 256; tstart[65] = acc; }
    __syncthreads();
    return tstart[65];
}
struct EpiGu {
    static constexpr bool PERM = true;
    bf16_t* HB;
    __device__ __forceinline__ void operator()(const f32x4 (&acc)[2][2][4][2], const pg8::Unit& u, int wr, int wc, int fr, int fq) const {
        const int r0 = wr * 64 + fr, cl = wc * 32 + 8 * fq;
#pragma unroll
        for (int ai = 0; ai < 2; ++ai)
#pragma unroll
            for (int m = 0; m < 4; ++m) { const int r = r0 + ai * 128 + m * 16; if (r < u.nvalid) {
                f32x4 h0, h1;
#pragma unroll
                for (int j = 0; j < 4; ++j) { h0[j] = siluf(acc[ai][0][m][0][j]) * acc[ai][1][m][0][j]; h1[j] = siluf(acc[ai][0][m][1][j]) * acc[ai][1][m][1][j]; }
                *(u32x4*)(HB + (size_t)(u.pm + r) * 512 + u.pn * 128 + cl) = pack8(h0, h1); } }
    }
};
struct EpiDown {
    static constexpr bool PERM = true;
    bf16_t* SLOT; const float* sw; float* X1; const float* mod;
    __device__ __forceinline__ void operator()(const f32x4 (&acc)[2][2][4][2], const pg8::Unit& u, int wr, int wc, int fr, int fq) const {
        const int r0 = wr * 64 + fr, cl = wc * 32 + 8 * fq;
        if (u.kind == 0) {
#pragma unroll
            for (int ai = 0; ai < 2; ++ai)
#pragma unroll
                for (int m = 0; m < 4; ++m) { const int r = r0 + ai * 128 + m * 16; if (r < u.nvalid) { const float w = sw[u.pm + r];
#pragma unroll
                    for (int bj = 0; bj < 2; ++bj) *(u32x4*)(SLOT + (size_t)(u.pm + r) * 2048 + u.pn * 256 + bj * 128 + cl) = pack8(acc[ai][bj][m][0] * w, acc[ai][bj][m][1] * w); } }
        } else {
            const int t0 = u.pm - 131072; const float* g2 = mod + (size_t)(t0 >> 11) * 12288 + 5 * 2048 + u.pn * 256 + cl;
#pragma unroll
            for (int ai = 0; ai < 2; ++ai)
#pragma unroll
                for (int m = 0; m < 4; ++m) { const int t = t0 + r0 + ai * 128 + m * 16; float* xp = X1 + (size_t)t * 2048 + u.pn * 256 + cl;
#pragma unroll
                    for (int bj = 0; bj < 2; ++bj)
#pragma unroll
                        for (int n = 0; n < 2; ++n) { const f32x4 xv = *(const f32x4*)(xp + bj * 128 + 4 * n); const f32x4 gv = *(const f32x4*)(g2 + bj * 128 + 4 * n) + 1.f;
                            *(f32x4*)(xp + bj * 128 + 4 * n) = xv * ALPHA + gv * acc[ai][bj][m][n]; }
                    asm volatile("" ::: "memory"); }
        }
    }
};
__device__ __forceinline__ void p10_final(Frame& F, const float* __restrict__ Z, const bf16_t* __restrict__ SLOT, const int* __restrict__ tokpos, const float* __restrict__ mod, const float* __restrict__ lg, const float* __restrict__ lb, float* __restrict__ out) {
    const int gw = F.vcu * NWAVES + F.wave, NGW = F.G * NWAVES;
    for (int t = gw; t < T; t += NGW) { const int b = t >> 11; const float* g2 = mod + b * 12288 + 5 * 2048;
        int pos[8];
#pragma unroll
        for (int j = 0; j < 8; ++j) pos[j] = __builtin_amdgcn_readfirstlane(tokpos[t * 8 + j]);
        f32x4 v[4][2]; float s = 0.f;
#pragma unroll
        for (int q = 0; q < 4; ++q) { const int d = 512 * q + 8 * F.lane; f32x4 a0 = {0.f, 0.f, 0.f, 0.f}, a1 = {0.f, 0.f, 0.f, 0.f};
#pragma unroll
            for (int j = 0; j < 8; ++j) { const u32x4 w = *(const u32x4*)(SLOT + (size_t)pos[j] * 2048 + d);
                a0[0] += bf2f(w.x & 0xffffu); a0[1] += bf2f(w.x >> 16); a0[2] += bf2f(w.y & 0xffffu); a0[3] += bf2f(w.y >> 16); a1[0] += bf2f(w.z & 0xffffu); a1[1] += bf2f(w.z >> 16); a1[2] += bf2f(w.w & 0xffffu); a1[3] += bf2f(w.w >> 16); }
            const f32x4 z0 = *(const f32x4*)(Z + (size_t)t * D + d), z1 = *(const f32x4*)(Z + (size_t)t * D + d + 4);
            v[q][0] = z0 + (*(const f32x4*)(g2 + d) + 1.f) * a0; v[q][1] = z1 + (*(const f32x4*)(g2 + d + 4) + 1.f) * a1;
            s += ((v[q][0][0] + v[q][0][1]) + (v[q][0][2] + v[q][0][3])) + ((v[q][1][0] + v[q][1][1]) + (v[q][1][2] + v[q][1][3]));
            asm volatile("" : "+v"(v[q][0]), "+v"(v[q][1]) :: "memory"); }
        const float mean = wave_sum(s) * (1.f / D); float s2 = 0.f;
#pragma unroll
        for (int q = 0; q < 4; ++q)
#pragma unroll
            for (int k = 0; k < 2; ++k) { v[q][k] = v[q][k] - mean; s2 += (v[q][k][0] * v[q][k][0] + v[q][k][1] * v[q][k][1]) + (v[q][k][2] * v[q][k][2] + v[q][k][3] * v[q][k][3]); }
        const float rstd = 1.f / sqrtf(wave_sum(s2) * (1.f / D) + 1e-5f);
#pragma unroll
        for (int q = 0; q < 4; ++q)
#pragma unroll
            for (int k = 0; k < 2; ++k) { const int d = 512 * q + 8 * F.lane + 4 * k; *(f32x4*)(out + (size_t)t * D + d) = v[q][k] * rstd * *(const f32x4*)(lg + d) + *(const f32x4*)(lb + d); }
    }
}
constexpr int N_PHASES = 11;
__global__ void __launch_bounds__(NTHR, 2) mk_fwd(Args args) {
    extern __shared__ __attribute__((aligned(16))) unsigned char lds[];
    Frame F;
    F.lds = (LAS unsigned char*)lds; F.MISC = (volatile LAS unsigned*)(F.lds + MISC_OFF);
    F.tid = threadIdx.x; F.lane = F.tid & 63; F.wave = __builtin_amdgcn_readfirstlane(F.tid >> 6);
    F.G = gridDim.x; { const int bx = blockIdx.x; F.vcu = (F.G % 8 == 0) ? (bx % 8) * (F.G / 8) + bx / 8 : bx; }
    F.ws = args.ws;
    unsigned char* ws = args.ws;
    for (int u = F.tid; u < (LDS_BYTES - LDSCTL_OFF) / 4; u += NTHR) ((LAS unsigned*)(F.lds + LDSCTL_OFF))[u] = 0u;
    __syncthreads();
    const int lo = args.ph_lo, hi = args.ph_hi;
    XcdBarrier bar; bar.bar = (unsigned*)(ws + WL.ctl) + 1024; bar.x = 0; bar.st = nullptr;
    if (hi - lo > 1) bar = xcd_barrier_post((unsigned*)(ws + WL.ctl) + 1024, F.MISC + 8);
#ifndef MK_PHASE_MASK
#define MK_PHASE_MASK 0x7ffu
#endif
#define IN(k) ((((MK_PHASE_MASK) >> (k)) & 1u) && lo <= (k) && (k) < hi)
#define SEAM(k) do { if (IN(k) && IN((k) + 1)) xcd_barrier(bar); } while (0)
    const float* x = args.in[0]; const float* mod = (const float*)(ws + WL.mod);
    const float* cs128 = (const float*)(ws + WL.cs128); const float* cs64 = (const float*)(ws + WL.cs64);

    if (IN(0)) { p0_mod(F, args.in[1], args.in[2], args.in[3], (float*)(ws + WL.mod)); p0_rope_tab(F, (float2*)(ws + WL.cs128), (float2*)(ws + WL.cs64)); p0_convert(F, args, args.flags); }
    SEAM(0);
    if (IN(1)) { p1_h1(F, x, mod, (bf16_t*)(ws + WL.h1)); }
    SEAM(1);
    if (IN(2)) {
        SchedIn Sx; Sx.o.init(64, 17, F.G, (int)blockIdx.x); Sx.A = (const char*)(ws + WL.h1); Sx.Bt = (const char*)(ws + WL.win);
        EpiIn E{(bf16_t*)(ws + WL.qa), (bf16_t*)(ws + WL.ka), (bf16_t*)(ws + WL.va), (bf16_t*)(ws + WL.cq), (bf16_t*)(ws + WL.ckv), (bf16_t*)(ws + WL.kr), (float*)(ws + WL.ssq), cs128, cs64};
        pg8::gemm_phase<EpiIn, SchedIn, false>(F.lds + RING_OFF, 2048, Sx, E);
    }
    SEAM(2);
    if (IN(3)) {
        p3_kmean(F, (const bf16_t*)(ws + WL.ka), (float*)(ws + WL.kmean));
        SchedMla Sx; Sx.o.init(64, 14, F.G, (int)blockIdx.x); Sx.CQ = (const char*)(ws + WL.cq); Sx.CKV = (const char*)(ws + WL.ckv); Sx.WuqT = (const char*)(ws + WL.wuq); Sx.WukvT = (const char*)(ws + WL.wukv);
        EpiMla E{(bf16_t*)(ws + WL.qmn), (bf16_t*)(ws + WL.qmr), (bf16_t*)(ws + WL.kn), (bf16_t*)(ws + WL.vm), (const float*)(ws + WL.ssq), cs64};
        pg8::gemm_phase<EpiMla, SchedMla, false>(F.lds + RING_OFF, 512, Sx, E);
    }
    SEAM(3);
    if (IN(4)) {
        att::Tensors Tn{(const bf16_t*)(ws + WL.qa), (const bf16_t*)(ws + WL.ka), (const bf16_t*)(ws + WL.va), (const bf16_t*)(ws + WL.qmn), (const bf16_t*)(ws + WL.qmr), (const bf16_t*)(ws + WL.kn), (const bf16_t*)(ws + WL.kr),
                        (const bf16_t*)(ws + WL.vm), (bf16_t*)(ws + WL.mix), (const float*)(ws + WL.kmean)};
        att::phase<false>((char*)lds + RING_OFF, (LAS char*)(F.lds + RING_OFF), Tn, F.vcu, F.G);
        att::phase<true>((char*)lds + RING_OFF, (LAS char*)(F.lds + RING_OFF), Tn, F.vcu, F.G);
    }
    SEAM(4);
    if (IN(5)) {
        SchedOut Sx; Sx.o.init(64, 8, F.G, (int)blockIdx.x); Sx.A = (const char*)(ws + WL.mix); Sx.Bt = (const char*)(ws + WL.wo);
        EpiOut E{x, mod, (float*)(ws + WL.y)};
        pg8::gemm_phase<EpiOut, SchedOut, false>(F.lds + RING_OFF, 2048, Sx, E);
    }
    SEAM(5);
    if (IN(6)) { p6_ln_route(F, (const float*)(ws + WL.y), mod, args.in[10], args.in[11], (float*)(ws + WL.x1), (bf16_t*)(ws + WL.h2), (const bf16_t*)(ws + WL.wr), args.in[13], (float*)(ws + WL.logits),
                             (unsigned long long*)(ws + WL.tokmask), (float*)(ws + WL.tw), (int*)(ws + WL.hist)); }
    SEAM(6);
    if (IN(7)) { p7_scatter(F, (const int*)(ws + WL.hist), (const unsigned long long*)(ws + WL.tokmask), (const float*)(ws + WL.tw), (int*)(ws + WL.stok), (float*)(ws + WL.sw), (int*)(ws + WL.tokpos), (int*)(ws + WL.starts), (int*)(ws + WL.cnts)); }
    SEAM(7);
    LAS int* tstart = (LAS int*)(F.lds + LDSCTL_OFF + 1024);
    if (IN(8)) {
        const int ntiles = build_tiles(F, (const int*)(ws + WL.cnts), tstart);
        SchedMoe Sx; Sx.tstart = tstart; Sx.starts = (const int*)(ws + WL.starts); Sx.cnts = (const int*)(ws + WL.cnts); Sx.ntiles = ntiles; Sx.nN = 4; Sx.G = F.G; Sx.c = (int)blockIdx.x; Sx.K = 2048;
        Sx.A = (const char*)(ws + WL.h2); Sx.Bt = (const char*)(ws + WL.wgu); Sx.bstride = (size_t)1024 * 2048 * 2; Sx.stok = (const int*)(ws + WL.stok); Sx.gather = true;
        EpiGu E{(bf16_t*)(ws + WL.hb)};
        pg8::gemm_phase<EpiGu, SchedMoe, true>(F.lds + RING_OFF, 2048, Sx, E);
    }
    SEAM(8);
    if (IN(9)) {
        const int ntiles = build_tiles(F, (const int*)(ws + WL.cnts), tstart);
        SchedMoe Sx; Sx.tstart = tstart; Sx.starts = (const int*)(ws + WL.starts); Sx.cnts = (const int*)(ws + WL.cnts); Sx.ntiles = ntiles; Sx.nN = 8; Sx.G = F.G; Sx.c = (int)blockIdx.x; Sx.K = 512;
        Sx.A = (const char*)(ws + WL.hb); Sx.Bt = (const char*)(ws + WL.wd); Sx.bstride = (size_t)2048 * 512 * 2; Sx.stok = nullptr; Sx.gather = false;
        EpiDown E{(bf16_t*)(ws + WL.slot), (const float*)(ws + WL.sw), (float*)(ws + WL.x1), mod};
        pg8::gemm_phase<EpiDown, SchedMoe, false>(F.lds + RING_OFF, 512, Sx, E);
    }
    SEAM(9);
    if (IN(10)) { p10_final(F, (const float*)(ws + WL.x1), (const bf16_t*)(ws + WL.slot), (const int*)(ws + WL.tokpos), mod, args.in[20], args.in[21], args.out); }
#undef IN
#undef SEAM
}

namespace fh {
static int g_grid = 0;
static void setup() {
    if (g_grid) return;
    int dev = 0, cus = 0; hipGetDevice(&dev); hipDeviceGetAttribute(&cus, hipDeviceAttributeMultiprocessorCount, dev);
    hipFuncSetAttribute((const void*)mk_fwd, hipFuncAttributeMaxDynamicSharedMemorySize, LDS_BYTES);
    int per_cu = 0; hipOccupancyMaxActiveBlocksPerMultiprocessor(&per_cu, (const void*)mk_fwd, NTHR, LDS_BYTES); (void)hipGetLastError();
    g_grid = cus > 0 ? cus : 256; if (per_cu < 1) fprintf(stderr, "mk_fwd: occupancy query reports %d blocks/CU\n", per_cu);
}
static void launch(void* const* d_in, float* out, unsigned char* ws, int lo, int hi, unsigned flags, hipStream_t st) {
    setup();
    Args a{}; for (int i = 0; i < 22; ++i) a.in[i] = (const float*)d_in[i];
    a.out = out; a.ws = ws; a.ph_lo = lo; a.ph_hi = hi; a.flags = flags; a.pad = 0;
    hipLaunchKernelGGL(mk_fwd, dim3(g_grid), dim3(NTHR), LDS_BYTES, st, a);
}
}
#ifndef MK_N_LAUNCHES
#define MK_N_LAUNCHES 1
#endif
extern "C" void kernel_launch(void* const* d_in, const int* in_sizes, int n_in, void* d_out, int out_size, void* d_ws, size_t ws_size, hipStream_t stream) {
    (void)in_sizes; (void)n_in; (void)out_size;
    unsigned char* ws = (unsigned char*)d_ws; float* out = (float*)d_out;
    if (ws_size < WL.end) { nvh::run(d_in, out, ws, stream); return; }
    hipMemsetAsync(ws + WL.ctl, 0, CTL_BYTES, stream);
    if (MK_N_LAUNCHES == 1) fh::launch(d_in, out, ws, 0, N_PHASES, 3u, stream);
    else for (int ph = 0; ph < N_PHASES; ++ph) fh::launch(d_in, out, ws, ph, ph + 1, 3u, stream);
}
```

```cpp
#define MK_N_LAUNCHES 1
#include <hip/hip_runtime.h>
#include <stdint.h>
#include <stdio.h>

constexpr int Bn = 8, S = 2048, D = 2048, T = Bn * S;
constexpr int INW = 4160;
constexpr float ALPHA = 1.189207115002721f;
constexpr size_t MiB = 1u << 20;
namespace nv {

__device__ __forceinline__ float wsum(float v) {
#pragma unroll
    for (int o = 1; o < 64; o <<= 1) v += __shfl_xor(v, o);
    return v;
}
__device__ __forceinline__ float wmax(float v) {
#pragma unroll
    for (int o = 1; o < 64; o <<= 1) v = fmaxf(v, __shfl_xor(v, o));
    return v;
}

__global__ __launch_bounds__(256) void k_mod(const float* __restrict__ c, const float* __restrict__ w_ada, const float* __restrict__ b_ada, float* __restrict__ mod) {
    const int col = blockIdx.x * 256 + threadIdx.x, b = blockIdx.y;
    float acc = b_ada[col];
    for (int k = 0; k < D; ++k) { const float v = c[b * D + k]; const float s = v / (1.f + expf(-v)); acc += s * w_ada[(size_t)k * 6 * D + col]; }
    mod[b * 6 * D + col] = acc;
}
__global__ void k_rope_tab(float2* cs128, float2* cs64) {
    const int idx = blockIdx.x * 256 + threadIdx.x;
    if (idx < S * 64) { const int pos = idx / 64, i = idx % 64; const float inv = (float)(1.0 / pow(10000.0, (double)(2 * i) / 128.0)); const float a = (float)pos * inv; cs128[idx] = make_float2((float)cos((double)a), (float)sin((double)a)); }
    if (idx < S * 32) { const int pos = idx / 32, i = idx % 32; const float inv = (float)(1.0 / pow(10000.0, (double)(2 * i) / 64.0)); const float a = (float)pos * inv; cs64[idx] = make_float2((float)cos((double)a), (float)sin((double)a)); }
}
__global__ __launch_bounds__(256) void k_modulate(const float* __restrict__ x, const float* __restrict__ mod, int sh_off, int sc_off, float* __restrict__ h) {
    const size_t i = (size_t)blockIdx.x * 256 + threadIdx.x; const int d = (int)(i % D); const int b = (int)(i / ((size_t)S * D));
    h[i] = x[i] * (1.f + mod[b * 6 * D + sc_off + d]) + mod[b * 6 * D + sh_off + d];
}

template <int MODE, bool REL>
__global__ __launch_bounds__(256) void k_gemm(const float* __restrict__ A, const float* __restrict__ Bm, float* __restrict__ C, int M, int N, int K, int lda, int ldb, int ldc,
                                              const int* __restrict__ list, const float* __restrict__ wts, const int* __restrict__ starts, const int* __restrict__ cnts, int e) {
    int m_total = M, off = 0;
    if (MODE) { off = starts[e]; m_total = cnts[e]; }
    const int m0 = blockIdx.y * 64, n0 = blockIdx.x * 64;
    if (m0 >= m_total) return;
    __shared__ float As[16][65];
    __shared__ float Bs[16][64];
    const int tid = threadIdx.x, tx = tid & 15, ty = tid >> 4;
    const int ar = tid >> 2, ak = (tid & 3) * 4;
    const int bk = tid >> 4, bn = (tid & 15) * 4;
    const int r = m0 + ar; const bool av = r < m_total;
    size_t arow = 0;
    if (av) { if (MODE == 1) arow = (size_t)list[off + r]; else if (MODE == 2) arow = (size_t)(REL ? r : off + r); else arow = (size_t)r; }
    const float* ap = A + arow * lda + ak;
    const float* bp = Bm + (size_t)bk * ldb + n0 + bn;
    float acc[4][4];
#pragma unroll
    for (int i = 0; i < 4; ++i)
#pragma unroll
        for (int j = 0; j < 4; ++j) acc[i][j] = 0.f;
    for (int k0 = 0; k0 < K; k0 += 16) {
        float4 a4 = av ? *(const float4*)(ap + k0) : make_float4(0.f, 0.f, 0.f, 0.f);
        float4 b4 = *(const float4*)(bp + (size_t)k0 * ldb);
        __syncthreads();
        As[ak + 0][ar] = a4.x; As[ak + 1][ar] = a4.y; As[ak + 2][ar] = a4.z; As[ak + 3][ar] = a4.w;
        *(float4*)&Bs[bk][bn] = b4;
        __syncthreads();
#pragma unroll
        for (int kk = 0; kk < 16; ++kk) {
            float a[4], b[4];
#pragma unroll
            for (int i = 0; i < 4; ++i) a[i] = As[kk][ty * 4 + i];
#pragma unroll
            for (int j = 0; j < 4; ++j) b[j] = Bs[kk][tx * 4 + j];
#pragma unroll
            for (int i = 0; i < 4; ++i)
#pragma unroll
                for (int j = 0; j < 4; ++j) acc[i][j] = fmaf(a[i], b[j], acc[i][j]);
        }
    }
#pragma unroll
    for (int i = 0; i < 4; ++i) {
        const int rr = m0 + ty * 4 + i; if (rr >= m_total) continue;
        if (MODE == 2) { const int tok = list[off + rr]; const float w = wts[off + rr]; float* cp = C + (size_t)tok * ldc + n0 + tx * 4;
#pragma unroll
            for (int j = 0; j < 4; ++j) cp[j] += w * acc[i][j]; }
        else { float* cp = C + (size_t)((MODE == 1 && !REL) ? off + rr : rr) * ldc + n0 + tx * 4; *(float4*)cp = make_float4(acc[i][0], acc[i][1], acc[i][2], acc[i][3]); }
    }
}

__global__ __launch_bounds__(256) void k_rope_proj(float* __restrict__ proj, const float2* __restrict__ cs128, const float2* __restrict__ cs64) {
    const int t = blockIdx.x, pos = t % S; float* row = proj + (size_t)t * INW;
    for (int idx = threadIdx.x; idx < 2 * 8 * 64 + 32; idx += 256) {
        if (idx < 1024) { const int which = idx >> 9, h = (idx >> 6) & 7, i = idx & 63; float* p = row + which * 1024 + h * 128; const float2 c = cs128[pos * 64 + i];
            const float x1 = p[i], x2 = p[i + 64]; p[i] = x1 * c.x - x2 * c.y; p[i + 64] = x2 * c.x + x1 * c.y; }
        else { const int i = idx - 1024; float* p = row + 4096; const float2 c = cs64[pos * 32 + i];
            const float x1 = p[i], x2 = p[i + 32]; p[i] = x1 * c.x - x2 * c.y; p[i + 32] = x2 * c.x + x1 * c.y; }
    }
}
__global__ __launch_bounds__(256) void k_rope_qm(float* __restrict__ qm, const float2* __restrict__ cs64) {
    const int t = blockIdx.x, pos = t % S; const int h = threadIdx.x >> 5, i = threadIdx.x & 31;
    float* p = qm + (size_t)t * 1536 + h * 192 + 128; const float2 c = cs64[pos * 32 + i];
    const float x1 = p[i], x2 = p[i + 32]; p[i] = x1 * c.x - x2 * c.y; p[i + 32] = x2 * c.x + x1 * c.y;
}
__global__ __launch_bounds__(128) void k_kmean(const float* __restrict__ proj, float* __restrict__ kmean) {
    const int n = blockIdx.x & 7, h = (blockIdx.x >> 3) & 7, b = blockIdx.x >> 6, d = threadIdx.x;
    float s = 0.f;
    for (int j = 0; j < 256; ++j) s += proj[(size_t)(b * S + n * 256 + j) * INW + 1024 + h * 128 + d];
    kmean[((b * 8 + h) * 8 + n) * 128 + d] = s * (1.f / 256.f);
}
__global__ __launch_bounds__(256) void k_rms(const float* __restrict__ proj, int col0, const float* __restrict__ g, float* __restrict__ dst) {
    const int wave = threadIdx.x >> 6, lane = threadIdx.x & 63; const int t = blockIdx.x * 4 + wave;
    const float* p = proj + (size_t)t * INW + col0; float v[8]; float ss = 0.f;
#pragma unroll
    for (int j = 0; j < 8; ++j) { v[j] = p[lane + 64 * j]; ss += v[j] * v[j]; }
    ss = wsum(ss); const float r = 1.f / sqrtf(ss * (1.f / 512.f) + 1e-6f);
#pragma unroll
    for (int j = 0; j < 8; ++j) dst[(size_t)t * 512 + lane + 64 * j] = v[j] * r * g[lane + 64 * j];
}

template <bool MOBA>
__global__ __launch_bounds__(256) void k_attn(const float* __restrict__ proj, const float* __restrict__ qm, const float* __restrict__ kv, const float* __restrict__ kmean, float* __restrict__ mix) {
    constexpr int DK = MOBA ? 128 : 192, MAXK = MOBA ? 1024 : 2048;
    __shared__ float qs[4][192];
    __shared__ float sc[4][MAXK];
    const int wave = threadIdx.x >> 6, lane = threadIdx.x & 63;
    const int gid = blockIdx.x * 4 + wave; const int h = gid & 7, t = gid >> 3, b = t / S, s = t % S;
    const float* qrow = MOBA ? proj + (size_t)t * INW + h * 128 : qm + (size_t)t * 1536 + h * 192;
    for (int d = lane; d < DK; d += 64) qs[wave][d] = qrow[d];
    __syncthreads();
    const float* q = qs[wave];
    const int own = s >> 8;
    int nkeys = 0;
    unsigned att = 0;
    if (MOBA) {
        float g[8];
#pragma unroll
        for (int n = 0; n < 8; ++n) { const float* km = kmean + ((b * 8 + h) * 8 + n) * 128; float p = q[lane] * km[lane] + q[lane + 64] * km[lane + 64]; g[n] = wsum(p); }
#pragma unroll
        for (int n = 0; n < 8; ++n) { if (n < own) { int rank = 0;
#pragma unroll
                for (int j = 0; j < 8; ++j) if (j < own && (g[j] > g[n] || (g[j] == g[n] && j < n))) ++rank;
                if (rank < 3) att |= 1u << n; } }
    }
    const float scale = MOBA ? 0.08838834764831845f : 0.07216878364870323f;
    float mx = -__builtin_inff();
    if (MOBA) {
        for (int n = 0; n <= own; ++n) {
            if (n < own && !((att >> n) & 1u)) continue;
            const int cnt = (n < own) ? 256 : (s - own * 256 + 1);
            for (int j = lane; j < cnt; j += 64) { const float* kr = proj + (size_t)(b * S + n * 256 + j) * INW + 1024 + h * 128; float a = 0.f;
                for (int d = 0; d < 128; d += 4) { const float4 kk = *(const float4*)(kr + d); a += q[d] * kk.x + q[d + 1] * kk.y + q[d + 2] * kk.z + q[d + 3] * kk.w; }
                a *= scale; sc[wave][nkeys + j] = a; mx = fmaxf(mx, a); }
            nkeys += cnt;
        }
    } else {
        nkeys = s + 1;
        for (int j = lane; j < nkeys; j += 64) { const float* kn = kv + (size_t)(b * S + j) * 2048 + h * 256; const float* kr = proj + (size_t)(b * S + j) * INW + 4096; float a = 0.f;
            for (int d = 0; d < 128; d += 4) { const float4 kk = *(const float4*)(kn + d); a += q[d] * kk.x + q[d + 1] * kk.y + q[d + 2] * kk.z + q[d + 3] * kk.w; }
            for (int d = 0; d < 64; d += 4) { const float4 kk = *(const float4*)(kr + d); a += q[128 + d] * kk.x + q[129 + d] * kk.y + q[130 + d] * kk.z + q[131 + d] * kk.w; }
            a *= scale; sc[wave][j] = a; mx = fmaxf(mx, a); }
    }
    mx = wmax(mx);
    float sum = 0.f;
    for (int j = lane; j < nkeys; j += 64) { const float p = expf(sc[wave][j] - mx); sc[wave][j] = p; sum += p; }
    sum = wsum(sum);
    __syncthreads();
    const float inv = 1.f / sum;
    float o0 = 0.f, o1 = 0.f;
    if (MOBA) {
        int e = 0;
        for (int n = 0; n <= own; ++n) {
            if (n < own && !((att >> n) & 1u)) continue;
            const int cnt = (n < own) ? 256 : (s - own * 256 + 1);
            for (int j = 0; j < cnt; ++j) { const float p = sc[wave][e + j]; const float* vr = proj + (size_t)(b * S + n * 256 + j) * INW + 2048 + h * 128; o0 += p * vr[lane]; o1 += p * vr[lane + 64]; }
            e += cnt;
        }
        float* orow = mix + (size_t)t * 2048 + h * 128; orow[lane] = o0 * inv; orow[lane + 64] = o1 * inv;
    } else {
        for (int j = 0; j < nkeys; ++j) { const float p = sc[wave][j]; const float* vr = kv + (size_t)(b * S + j) * 2048 + h * 256 + 128; o0 += p * vr[lane]; o1 += p * vr[lane + 64]; }
        float* orow = mix + (size_t)t * 2048 + 1024 + h * 128; orow[lane] = o0 * inv; orow[lane + 64] = o1 * inv;
    }
}

__global__ __launch_bounds__(256) void k_ln(const float* __restrict__ xres, const float* __restrict__ f, const float* __restrict__ mod, int gate_off, const float* __restrict__ lg, const float* __restrict__ lb,
                                            float* __restrict__ xo, float* __restrict__ h, int sh_off, int sc_off) {
    const int wave = threadIdx.x >> 6, lane = threadIdx.x & 63; const int t = blockIdx.x * 4 + wave, b = t / S;
    const float* m = mod + b * 6 * D;
    float v[32]; float s1 = 0.f;
#pragma unroll
    for (int j = 0; j < 32; ++j) { const int d = lane + 64 * j; v[j] = ALPHA * xres[(size_t)t * D + d] + (1.f + m[gate_off + d]) * f[(size_t)t * D + d]; s1 += v[j]; }
    const float mu = wsum(s1) * (1.f / D); float s2 = 0.f;
#pragma unroll
    for (int j = 0; j < 32; ++j) { v[j] -= mu; s2 += v[j] * v[j]; }
    const float r = 1.f / sqrtf(wsum(s2) * (1.f / D) + 1e-5f);
#pragma unroll
    for (int j = 0; j < 32; ++j) { const int d = lane + 64 * j; const float o = v[j] * r * lg[d] + lb[d]; xo[(size_t)t * D + d] = o; if (h) h[(size_t)t * D + d] = o * (1.f + m[sc_off + d]) + m[sh_off + d]; }
}
__global__ __launch_bounds__(256) void k_silu_mul(float* __restrict__ g, const float* __restrict__ u, const int* __restrict__ cnts, int e) {
    const size_t i = (size_t)blockIdx.x * 256 + threadIdx.x; const int row = (int)(i / 512);
    if (row >= cnts[e]) return;
    const float a = g[i]; g[i] = a / (1.f + expf(-a)) * u[i];
}
__global__ __launch_bounds__(256) void k_zero(float* p, size_t n) { const size_t i = (size_t)blockIdx.x * 256 + threadIdx.x; if (i < n) p[i] = 0.f; }
__global__ __launch_bounds__(256) void k_iota(int* list, float* w, int* starts, int* cnts) { const int i = blockIdx.x * 256 + threadIdx.x; if (i < T) { list[i] = i; w[i] = 1.f; } if (i == 0) { starts[0] = 0; cnts[0] = T; } }

}
namespace rt {
__device__ __forceinline__ void route_token(const float logit, const float bias, int lane, unsigned long long& mask, float& w) {
    const float score = 1.f / (1.f + expf(-logit));
    const float sel = score + bias;
    const int gbase = lane & ~7;
    int r = 0;
#pragma unroll
    for (int k = 0; k < 8; ++k) { const float o = __shfl(sel, gbase + k); const int j = gbase + k; r += (o > sel || (o == sel && j < lane)) ? 1 : 0; }
    float gs = (r < 2) ? sel : 0.f;
    gs += __shfl_xor(gs, 1); gs += __shfl_xor(gs, 2); gs += __shfl_xor(gs, 4);
    const int g = lane >> 3; int gr = 0;
#pragma unroll
    for (int k = 0; k < 8; ++k) { const float o = __builtin_bit_cast(float, __builtin_amdgcn_readlane(__builtin_bit_cast(int, gs), 8 * k)); gr += (o > gs || (o == gs && k < g)) ? 1 : 0; }
    const float m = (gr < 4) ? sel : -__builtin_inff();
    int er = 0;
#pragma unroll
    for (int k = 0; k < 64; ++k) { const float o = __builtin_bit_cast(float, __builtin_amdgcn_readlane(__builtin_bit_cast(int, m), k)); er += (o > m || (o == m && k < lane)) ? 1 : 0; }
    const bool chosen = er < 8;
    mask = __ballot(chosen);
    float ws = chosen ? score : 0.f;
#pragma unroll
    for (int o = 1; o < 64; o <<= 1) ws += __shfl_xor(ws, o);
    w = chosen ? score / ws * 2.5f : 0.f;
}
template <int CTRL> __device__ __forceinline__ float dpp_maxf(float x) { return fmaxf(x, __builtin_bit_cast(float, __builtin_amdgcn_update_dpp(__builtin_bit_cast(int, x), __builtin_bit_cast(int, x), CTRL, 0xf, 0xf, false))); }
__device__ __forceinline__ float grp8_max(float x) { x = dpp_maxf<0xB1>(x); x = dpp_maxf<0x4E>(x); return dpp_maxf<0x141>(x); }
template <int CTRL, int ROWMASK> __device__ __forceinline__ float dpp_maxf_rm(float x) { return fmaxf(x, __builtin_bit_cast(float, __builtin_amdgcn_update_dpp(__builtin_bit_cast(int, x), __builtin_bit_cast(int, x), CTRL, ROWMASK, 0xf, false))); }
__device__ __forceinline__ void route_token_fast(const float logit, const float bias, int lane, unsigned long long& mask, float& w) {
    const float score = __builtin_amdgcn_rcpf(1.f + __expf(-logit));
    const float sel = score + bias;
    const float NINF = -__builtin_inff();
    const float m1 = grp8_max(sel);
    const unsigned long long eq1 = __ballot(sel == m1);
    const unsigned gb = (unsigned)(eq1 >> (lane & ~7)) & 0xffu;
    const int first = __builtin_ctz(gb);
    const float m2 = grp8_max(((lane & 7) == first) ? NINF : sel);
    const float gs = m1 + m2;
    const int g = lane >> 3; int gr = 0;
#pragma unroll
    for (int k = 0; k < 8; ++k) { const float o = __builtin_bit_cast(float, __builtin_amdgcn_readlane(__builtin_bit_cast(int, gs), 8 * k)); gr += (o > gs || (o == gs && k < g)) ? 1 : 0; }
    float m = (gr < 4) ? sel : NINF;
    unsigned long long chosen = 0ull; float ws = 0.f;
#pragma unroll
    for (int it = 0; it < 8; ++it) {
        float r = grp8_max(m); r = dpp_maxf<0x140>(r);
        r = dpp_maxf_rm<0x142, 0xA>(r); r = dpp_maxf_rm<0x143, 0xC>(r);
        const float gm = __builtin_bit_cast(float, __builtin_amdgcn_readlane(__builtin_bit_cast(int, r), 63));
        const unsigned long long eq = __ballot(m == gm);
        const int idx = __builtin_amdgcn_readfirstlane((int)__builtin_ctzll(eq));
        chosen |= 1ull << idx;
        ws += __builtin_bit_cast(float, __builtin_amdgcn_readlane(__builtin_bit_cast(int, score), idx));
        m = (lane == idx) ? NINF : m;
    }
    mask = chosen;
    const bool c = (chosen >> lane) & 1ull;
    w = c ? score * (2.5f * __builtin_amdgcn_rcpf(ws)) : 0.f;
}
__device__ __forceinline__ void route_block(int blk, const float* __restrict__ logits, const float* __restrict__ rbias, unsigned long long* __restrict__ tokmask, float* __restrict__ tw, int* __restrict__ hist,
                                            unsigned long long* lds_mask  , int nwaves) {
    const int wave = threadIdx.x >> 6, lane = threadIdx.x & 63;
    const float bias = rbias[lane];
    for (int i = wave; i < 64; i += nwaves) {
        const int t = blk * 64 + i; unsigned long long mask; float w;
        route_token(logits[(size_t)t * 64 + lane], bias, lane, mask, w);
        tw[(size_t)t * 64 + lane] = w;
        if (lane == 0) { tokmask[t] = mask; lds_mask[i] = mask; }
    }
    __syncthreads();
    if (threadIdx.x < 64) { int c = 0; for (int i = 0; i < 64; ++i) c += (int)((lds_mask[i] >> threadIdx.x) & 1ull); hist[blk * 64 + threadIdx.x] = c; }
    __syncthreads();
}
__device__ __forceinline__ void scatter_block(int blk, const int* __restrict__ hist, const unsigned long long* __restrict__ tokmask, const float* __restrict__ tw,
                                              int* __restrict__ stok, float* __restrict__ sw, int* __restrict__ tokpos, int* __restrict__ starts, int* __restrict__ cnts, int* lds_i  ) {
    const int e = threadIdx.x;
    if (e < 64) { int tot = 0, before = 0; for (int b = 0; b < 256; ++b) { const int c = hist[b * 64 + e]; tot += c; if (b < blk) before += c; }
        lds_i[e] = tot; lds_i[64 + e] = before; }
    __syncthreads();
    if (e < 64) { int st = 0; for (int j = 0; j < e; ++j) st += lds_i[j];
        if (blk == 0) { starts[e] = st; cnts[e] = lds_i[e]; }
        int pos = st + lds_i[64 + e];
        for (int i = 0; i < 64; ++i) { const int t = blk * 64 + i; const unsigned long long m = tokmask[t];
            if ((m >> e) & 1ull) { stok[pos] = t; sw[pos] = tw[(size_t)t * 64 + e]; tokpos[t * 8 + __popcll(m & ((1ull << e) - 1ull))] = pos; ++pos; } } }
    __syncthreads();
}
__global__ __launch_bounds__(256) void k_route(const float* logits, const float* rbias, unsigned long long* tokmask, float* tw, int* hist) {
    __shared__ unsigned long long lm[64];
    route_block(blockIdx.x, logits, rbias, tokmask, tw, hist, lm, 4);
}
__global__ __launch_bounds__(256) void k_scatter(const int* hist, const unsigned long long* tokmask, const float* tw, int* stok, float* sw, int* tokpos, int* starts, int* cnts) {
    __shared__ int li[128];
    scatter_block(blockIdx.x, hist, tokmask, tw, stok, sw, tokpos, starts, cnts, li);
}
}
namespace nvh {
constexpr size_t O_MOD = 0;
constexpr size_t O_CS128 = 1 * MiB;
constexpr size_t O_CS64 = 2 * MiB;
constexpr size_t O_KMEAN = 3 * MiB;
constexpr size_t O_HIST = 4 * MiB;
constexpr size_t O_STARTS = 4 * MiB + 128 * 1024;
constexpr size_t O_CNTS = 4 * MiB + 192 * 1024;
constexpr size_t O_TOKMASK = 5 * MiB;
constexpr size_t O_TOKPOS = 6 * MiB;
constexpr size_t O_STOK = 7 * MiB;
constexpr size_t O_SW = 8 * MiB;
constexpr size_t O_TW = 9 * MiB;
constexpr size_t O_LOGITS = 13 * MiB;
constexpr size_t O_SHLIST = 17 * MiB;
constexpr size_t O_R1 = 20 * MiB;
constexpr size_t O_PROJ = 148 * MiB;
constexpr size_t O_CQN = O_R1;
constexpr size_t O_CKVN = O_R1 + 32 * MiB;
constexpr size_t O_QM = 408 * MiB;
constexpr size_t O_KV = 504 * MiB;
constexpr size_t O_GE = O_PROJ + 128 * MiB;
constexpr size_t O_END = 632 * MiB;
struct Hooks { void (*after_mod)(void*, hipStream_t); void (*after_proj)(void*, hipStream_t); void (*after_mla)(void*, hipStream_t); void (*after_attn)(void*, hipStream_t); void* ctx; };

static void run(void* const* d_in, float* out, unsigned char* ws, hipStream_t st, const Hooks* hk = nullptr) {
    const float *x = (const float*)d_in[0], *c = (const float*)d_in[1], *w_ada = (const float*)d_in[2], *b_ada = (const float*)d_in[3], *w_in = (const float*)d_in[4], *g_cq = (const float*)d_in[5],
                *w_uq = (const float*)d_in[6], *g_ckv = (const float*)d_in[7], *w_ukv = (const float*)d_in[8], *w_o = (const float*)d_in[9], *ln1_g = (const float*)d_in[10], *ln1_b = (const float*)d_in[11],
                *w_router = (const float*)d_in[12], *rbias = (const float*)d_in[13], *w_gate = (const float*)d_in[14], *w_up = (const float*)d_in[15], *w_down = (const float*)d_in[16],
                *ws_gate = (const float*)d_in[17], *ws_up = (const float*)d_in[18], *ws_down = (const float*)d_in[19], *ln2_g = (const float*)d_in[20], *ln2_b = (const float*)d_in[21];
    float* mod = (float*)(ws + O_MOD); float2* cs128 = (float2*)(ws + O_CS128); float2* cs64 = (float2*)(ws + O_CS64); float* kmean = (float*)(ws + O_KMEAN);
    int* hist = (int*)(ws + O_HIST); int* starts = (int*)(ws + O_STARTS); int* cnts = (int*)(ws + O_CNTS); unsigned long long* tokmask = (unsigned long long*)(ws + O_TOKMASK);
    int* tokpos = (int*)(ws + O_TOKPOS); int* stok = (int*)(ws + O_STOK); float* sw = (float*)(ws + O_SW); float* tw = (float*)(ws + O_TW); float* logits = (float*)(ws + O_LOGITS);
    int* shlist = (int*)(ws + O_SHLIST); float* shw = (float*)(ws + O_SHLIST + 64 * 1024); int* shstarts = (int*)(ws + O_SHLIST + 128 * 1024); int* shcnts = (int*)(ws + O_SHLIST + 129 * 1024);
    float* r1 = (float*)(ws + O_R1); float* proj = (float*)(ws + O_PROJ); float* x1 = proj; float* cqn = (float*)(ws + O_CQN); float* ckvn = (float*)(ws + O_CKVN);
    float* qm = (float*)(ws + O_QM); float* out2 = qm; float* kv = (float*)(ws + O_KV); float* mix = out; float* Ge = (float*)(ws + O_GE); float* Ue = Ge + (size_t)16384 * 512;
    const int* ni = nullptr; const float* nf = nullptr;
    nv::k_mod<<<dim3(6 * D / 256, Bn), 256, 0, st>>>(c, w_ada, b_ada, mod);
    nv::k_rope_tab<<<S * 64 / 256, 256, 0, st>>>(cs128, cs64);
    if (hk && hk->after_mod) hk->after_mod(hk->ctx, st);
    nv::k_modulate<<<(unsigned)((size_t)T * D / 256), 256, 0, st>>>(x, mod, 0, D, r1);
    nv::k_gemm<0, false><<<dim3(INW / 64, T / 64), 256, 0, st>>>(r1, w_in, proj, T, INW, D, D, INW, INW, ni, nf, ni, ni, 0);
    nv::k_rope_proj<<<T, 256, 0, st>>>(proj, cs128, cs64);
    nv::k_kmean<<<Bn * 8 * 8, 128, 0, st>>>(proj, kmean);
    if (hk && hk->after_proj) hk->after_proj(hk->ctx, st);
    nv::k_rms<<<T / 4, 256, 0, st>>>(proj, 3072, g_cq, cqn);
    nv::k_rms<<<T / 4, 256, 0, st>>>(proj, 3584, g_ckv, ckvn);
    nv::k_gemm<0, false><<<dim3(1536 / 64, T / 64), 256, 0, st>>>(cqn, w_uq, qm, T, 1536, 512, 512, 1536, 1536, ni, nf, ni, ni, 0);
    nv::k_gemm<0, false><<<dim3(2048 / 64, T / 64), 256, 0, st>>>(ckvn, w_ukv, kv, T, 2048, 512, 512, 2048, 2048, ni, nf, ni, ni, 0);
    nv::k_rope_qm<<<T, 256, 0, st>>>(qm, cs64);
    if (hk && hk->after_mla) hk->after_mla(hk->ctx, st);
    nv::k_attn<true><<<T * 8 / 4, 256, 0, st>>>(proj, qm, kv, kmean, mix);
    nv::k_attn<false><<<T * 8 / 4, 256, 0, st>>>(proj, qm, kv, kmean, mix);
    if (hk && hk->after_attn) hk->after_attn(hk->ctx, st);
    nv::k_gemm<0, false><<<dim3(D / 64, T / 64), 256, 0, st>>>(mix, w_o, r1, T, D, D, D, D, D, ni, nf, ni, ni, 0);
    nv::k_ln<<<T / 4, 256, 0, st>>>(x, r1, mod, 2 * D, ln1_g, ln1_b, x1, r1, 3 * D, 4 * D);
    nv::k_gemm<0, false><<<dim3(1, T / 64), 256, 0, st>>>(r1, w_router, logits, T, 64, D, D, 64, 64, ni, nf, ni, ni, 0);
    rt::k_route<<<256, 256, 0, st>>>(logits, rbias, tokmask, tw, hist);
    rt::k_scatter<<<256, 256, 0, st>>>(hist, tokmask, tw, stok, sw, tokpos, starts, cnts);
    nv::k_zero<<<(unsigned)((size_t)T * D / 256), 256, 0, st>>>(out2, (size_t)T * D);
    nv::k_iota<<<T / 256, 256, 0, st>>>(shlist, shw, shstarts, shcnts);
    for (int e = 0; e <= 64; ++e) {
        const float* wg = e < 64 ? w_gate + (size_t)e * D * 512 : ws_gate; const float* wu = e < 64 ? w_up + (size_t)e * D * 512 : ws_up; const float* wd = e < 64 ? w_down + (size_t)e * 512 * D : ws_down;
        const int* lst = e < 64 ? stok : shlist; const float* wt = e < 64 ? sw : shw; const int* stt = e < 64 ? starts : shstarts; const int* cn = e < 64 ? cnts : shcnts; const int ee = e < 64 ? e : 0;
        nv::k_gemm<1, true><<<dim3(512 / 64, 16384 / 64), 256, 0, st>>>(r1, wg, Ge, T, 512, D, D, 512, 512, lst, wt, stt, cn, ee);
        nv::k_gemm<1, true><<<dim3(512 / 64, 16384 / 64), 256, 0, st>>>(r1, wu, Ue, T, 512, D, D, 512, 512, lst, wt, stt, cn, ee);
        nv::k_silu_mul<<<16384 * 512 / 256, 256, 0, st>>>(Ge, Ue, cn, ee);
        nv::k_gemm<2, true><<<dim3(D / 64, 16384 / 64), 256, 0, st>>>(Ge, wd, out2, T, D, 512, 512, D, D, lst, wt, stt, cn, ee);
    }
    nv::k_ln<<<T / 4, 256, 0, st>>>(x1, out2, mod, 5 * D, ln2_g, ln2_b, out, nullptr, 0, 0);
}
}
#ifndef MK_ZERO64
#define MK_ZERO64 1
#endif
#ifndef MK_LDSX
#define MK_LDSX 0
#endif
#define LAS __attribute__((address_space(3)))
#define GAS __attribute__((address_space(1)))
typedef unsigned short bf16_t;
typedef short bf16x8 __attribute__((ext_vector_type(8)));
typedef short s16x4 __attribute__((ext_vector_type(4)));
typedef float f32x4 __attribute__((ext_vector_type(4)));
typedef float f32x16 __attribute__((ext_vector_type(16)));
typedef unsigned u32x4 __attribute__((ext_vector_type(4)));
typedef unsigned u32x2 __attribute__((ext_vector_type(2)));

__device__ __forceinline__ unsigned cvt_pk_bf16(float lo, float hi) { unsigned r; asm volatile("v_cvt_pk_bf16_f32 %0, %1, %2" : "=v"(r) : "v"(lo), "v"(hi)); return r; }
__device__ __forceinline__ unsigned f2bf(float f) { unsigned u = __builtin_bit_cast(unsigned, f); return (u + 0x7fffu + ((u >> 16) & 1u)) >> 16; }
__device__ __forceinline__ float bf2f(unsigned b) { return __builtin_bit_cast(float, b << 16); }
__device__ __forceinline__ unsigned pk2(float lo, float hi) { return f2bf(lo) | (f2bf(hi) << 16); }
#ifndef MK_ST_WT
#define MK_ST_WT 0
#endif
__device__ __forceinline__ void st16_wt(void* p, u32x4 v) { asm volatile("global_store_dwordx4 %0, %1, off sc1\n\ts_nop 1" :: "v"(p), "v"(v) : "memory"); }
#if MK_ST_WT
#define ST16NT(ptr, val) st16_wt((void*)(ptr), (val))
#else
#define ST16NT(ptr, val) (*(u32x4*)(ptr) = (val))
#endif
__device__ __forceinline__ unsigned pk4_fp8(float a, float b, float c, float d) { unsigned w = 0u; w = __builtin_amdgcn_cvt_pk_fp8_f32(a, b, w, false); w = __builtin_amdgcn_cvt_pk_fp8_f32(c, d, w, true); return w; }
__device__ __forceinline__ float siluf(float a) { return a * __builtin_amdgcn_rcpf(1.f + __expf(-a)); }

#define XB_TMO      128
#define XB_XCNT(j)  (256  + 64 * (j))
#define XB_XSUB(j)  (1280 + 64 * (j))
#define XB_XGEN(j)  (2304 + 64 * (j))
#define XB_TOP      3328
#define XB_TOPGEN   3392
#define XCD_BAR_WORDS 3456
#define XB_SPIN_CAP (1u << 18)

__device__ __forceinline__ unsigned xb_ld(unsigned* p)              { return __hip_atomic_load(p, __ATOMIC_RELAXED, __HIP_MEMORY_SCOPE_AGENT); }
__device__ __forceinline__ unsigned xb_add(unsigned* p, unsigned v) { return __hip_atomic_fetch_add(p, v, __ATOMIC_RELAXED, __HIP_MEMORY_SCOPE_AGENT); }
__device__ __forceinline__ unsigned xb_xcc_id() { return (unsigned)__builtin_amdgcn_s_getreg((3 << 11) | 20) & 0xFu; }
#define XB_SPIN(cond, bar) do { unsigned _sp = 0; while (cond) { __builtin_amdgcn_s_sleep(1); \
    if ((++_sp & 255u) == 0u) { if (xb_ld(&(bar)[XB_TMO])) break; if (_sp > XB_SPIN_CAP) { atomicAdd(&(bar)[XB_TMO], 1u); break; } } } } while (0)

struct XcdBarrier {
    unsigned* bar; unsigned x;
    volatile LAS unsigned* st;
};
__device__ __forceinline__ XcdBarrier xcd_barrier_post(unsigned* bar, volatile LAS unsigned* st) {
    XcdBarrier b; b.bar = bar; b.x = xb_xcc_id(); b.st = st;
    if (threadIdx.x == 0) (void)xb_add(&bar[XB_XCNT(b.x)], 1u);
    return b;
}
__device__ __forceinline__ void xcd_barrier_complete(unsigned* bar, unsigned x, unsigned& nloc, unsigned& nx) {
    const unsigned G = gridDim.x * gridDim.y * gridDim.z;
    unsigned sum, cnt, mine, sp = 0u;
    for (;;) {
        sum = 0u; cnt = 0u; mine = 0u;
#pragma unroll
        for (unsigned j = 0; j < 16; ++j) { const unsigned c = xb_ld(&bar[XB_XCNT(j)]); sum += c; cnt += (c > 0u) ? 1u : 0u; mine = (j == x) ? c : mine; }
        if (sum == G) break;
        __builtin_amdgcn_s_sleep(1);
        if ((++sp & 255u) == 0u) { if (xb_ld(&bar[XB_TMO])) break; if (sp > XB_SPIN_CAP) { atomicAdd(&bar[XB_TMO], 1u); break; } }
    }
    nloc = mine > 0u ? mine : 1u; nx = cnt > 0u ? cnt : 1u;
}
__device__ __forceinline__ void xcd_barrier(const XcdBarrier& b) {
    asm volatile("s_waitcnt vmcnt(0)" ::: "memory");
    __syncthreads();
    if (threadIdx.x == 0) {
        unsigned* bar = b.bar;
        __builtin_amdgcn_s_waitcnt(0);
        unsigned nloc = b.st[0], nx = b.st[1];
        if (nloc == 0u) { xcd_barrier_complete(bar, b.x, nloc, nx); b.st[0] = nloc; b.st[1] = nx; }
        const unsigned old = xb_add(&bar[XB_XSUB(b.x)], 1u);
        const unsigned gen = old / nloc;
        if (old + 1u == (gen + 1u) * nloc) {
            __builtin_amdgcn_fence(__ATOMIC_RELEASE, "agent");
            asm volatile("s_waitcnt vmcnt(0)" ::: "memory");
            const unsigned og = xb_add(&bar[XB_TOP], 1u);
            const unsigned tg = og / nx;
            if (og + 1u == (tg + 1u) * nx) xb_add(&bar[XB_TOPGEN], 1u);
            else XB_SPIN(xb_ld(&bar[XB_TOPGEN]) == tg, bar);
            __builtin_amdgcn_fence(__ATOMIC_ACQUIRE, "agent");
            xb_add(&bar[XB_XGEN(b.x)], 1u);
            asm volatile("s_waitcnt vmcnt(0)" ::: "memory");
        } else {
            XB_SPIN(xb_ld(&bar[XB_XGEN(b.x)]) == gen, bar);
            __builtin_amdgcn_fence(__ATOMIC_ACQUIRE, "agent");
            asm volatile("s_waitcnt vmcnt(0)" ::: "memory");
        }
    }
    __syncthreads();
}

namespace pg8 {
constexpr int BM = 256, BK = 64, HALF = 128, HTB = HALF * BK * 2  , STAGE_BYTES = 8 * HTB, NXCD = 8;

__host__ __device__ __forceinline__ int lds_byte(int r, int c) { const int st = (r >> 4) * 2 + (c >> 5), rr = r & 15, cc = c & 31, ob = rr * 64 + cc * 2; return st * 1024 + (ob ^ (((ob >> 9) & 1) << 5)); }
__host__ __device__ __forceinline__ void stage_rc(int b, int& R, int& C) { const int st = b / 1024, sb = b % 1024, swz = sb ^ (((sb >> 9) & 1) << 5); R = (st >> 1) * 16 + swz / 64; C = (st & 1) * 32 + (swz % 64) / 2; }
__host__ __device__ __forceinline__ int perm32(int rho) { const int n = rho >> 4, i = rho & 15; return 8 * (i >> 2) + 4 * n + (i & 3); }

struct Unit { const char* a; const char* b; const int* rows; int nvalid; int pm, pn, kind, aux; };

__host__ __device__ __forceinline__ int xcd_remap(int L, int nwg) { const int q = nwg / NXCD, r = nwg % NXCD, xcd = L % NXCD, off = L / NXCD; return (xcd < r ? xcd * (q + 1) : r * (q + 1) + (xcd - r) * q) + off; }

#ifndef MK_ALIGN
#define MK_ALIGN true
#endif
#ifndef MK_SP2
#define MK_SP2 true
#endif
typedef int v8i __attribute__((ext_vector_type(8)));
typedef int v4i __attribute__((ext_vector_type(4)));
template <class Epi, class Sched, bool GATHER, bool F8 = false, bool ALIGN_EPI = MK_ALIGN, bool SP2 = MK_SP2>
__device__ __forceinline__ void gemm_phase(LAS unsigned char* lds, const int rowbytes, const Sched& S, const Epi& E, const unsigned delay_ticks = 0u, const int sc_w = 0x79797979, const int sc_a = 0x7f7f7f7f) {
    if (delay_ticks) { const unsigned long long t0_ = wall_clock64(); while (wall_clock64() - t0_ < (unsigned long long)delay_ticks) __builtin_amdgcn_s_sleep(8); }
    const int tid = threadIdx.x, wid = __builtin_amdgcn_readfirstlane(tid >> 6), lane = tid & 63, wr = wid >> 2, wc = wid & 3, fr = lane & 15, fq = lane >> 4;
    const int nt = rowbytes / 128;
    unsigned voffB[2];
#pragma unroll
    for (int i = 0; i < 2; ++i) { int R, C; stage_rc(tid * 16 + i * 8192, R, C); const int Rb = Epi::B64 ? ((R >> 5) * 64 + perm32(R & 31)) : Epi::PERM ? ((R & ~31) + perm32(R & 31)) : R;
        voffB[i] = (unsigned)(Rb * rowbytes + C * 2); }
    const size_t kstep = (size_t)(BK * 2);
    const size_t hstep = (size_t)(Epi::B64 ? 32 : HALF) * rowbytes;
    const unsigned ldsw = (unsigned)wid * 1024u;
    const int xs0 = (F8 && MK_LDSX) ? ((fq >> 1) << 4) : 0, xs1 = xs0 ^ 16;
    const int aoff = F8 ? lds_byte(wr * 64 + fr, fq * 16) : lds_byte(wr * 64 + fr, fq * 8), boff = F8 ? lds_byte(wc * 32 + fr, fq * 16) : lds_byte(wc * 32 + fr, fq * 8);
#define PG8_SA(b, h) (((b) * 2 + (h)) * HTB)
#define PG8_SB(b, h) ((4 + (b) * 2 + (h)) * HTB)
#ifndef EXP_MMA_DUP
#define EXP_MMA_DUP 0
#endif
#ifdef EXP_STAGE_DUP
#define PG8_STAGE(bufoff, gbase, voff) do { _Pragma("unroll") for (int _i = 0; _i < 2; ++_i) { \
        __builtin_amdgcn_global_load_lds((const unsigned*)((const char*)(gbase) + (voff)[_i] + EXP_STAGE_DUP), (LAS unsigned*)(lds + (bufoff) + ldsw + _i * 8192), 16, 0, 0); \
        __builtin_amdgcn_global_load_lds((const unsigned*)((const char*)(gbase) + (voff)[_i]), (LAS unsigned*)(lds + (bufoff) + ldsw + _i * 8192), 16, 0, 0); } } while (0)
#else
#define PG8_STAGE(bufoff, gbase, voff) do { _Pragma("unroll") for (int _i = 0; _i < 2; ++_i) \
        __builtin_amdgcn_global_load_lds((const unsigned*)((const char*)(gbase) + (voff)[_i]), (LAS unsigned*)(lds + (bufoff) + ldsw + _i * 8192), 16, 0, 0); } while (0)
#endif
#define PG8_LD32(p) __builtin_shufflevector(*(const LAS v4i*)((p) + xs0), *(const LAS v4i*)((p) + xs1), 0, 1, 2, 3, 4, 5, 6, 7)
#define PG8_LDA(dst, b, h) do { if constexpr (F8) { _Pragma("unroll") for (int m = 0; m < 4; ++m) dst##8[m] = PG8_LD32(lds + PG8_SA(b, h) + aoff + m * 2048); } \
        else { _Pragma("unroll") for (int m = 0; m < 4; ++m) _Pragma("unroll") for (int k = 0; k < 2; ++k) dst[m][k] = *(const LAS bf16x8*)(lds + PG8_SA(b, h) + aoff + m * 2048 + k * 1024); } } while (0)
#define PG8_LDB(dst, b, h) do { if constexpr (F8) { _Pragma("unroll") for (int n = 0; n < 2; ++n) dst##8[n] = PG8_LD32(lds + PG8_SB(b, h) + boff + n * 2048); } \
        else { _Pragma("unroll") for (int n = 0; n < 2; ++n) _Pragma("unroll") for (int k = 0; k < 2; ++k) dst[n][k] = *(const LAS bf16x8*)(lds + PG8_SB(b, h) + boff + n * 2048 + k * 1024); } } while (0)
#define PG8_MMA(ai, bj, At, Bt) do { __builtin_amdgcn_s_setprio(1); if constexpr (F8) { _Pragma("unroll") for (int m = 0; m < 4; ++m) _Pragma("unroll") for (int n = 0; n < 2; ++n) \
        { acc[ai][bj][m][n] = __builtin_amdgcn_mfma_scale_f32_16x16x128_f8f6f4(Bt##8[n], At##8[m], acc[ai][bj][m][n], 0, 0, 0, sc_w - EXP_MMA_DUP * 0x01010101, 0, sc_a); \
          if (EXP_MMA_DUP) acc[ai][bj][m][n] = __builtin_amdgcn_mfma_scale_f32_16x16x128_f8f6f4(Bt##8[n], At##8[m], acc[ai][bj][m][n], 0, 0, 0, sc_w - EXP_MMA_DUP * 0x01010101, 0, sc_a); } } \
        else { _Pragma("unroll") for (int m = 0; m < 4; ++m) _Pragma("unroll") for (int n = 0; n < 2; ++n) _Pragma("unroll") for (int k = 0; k < 2; ++k) \
        acc[ai][bj][m][n] = __builtin_amdgcn_mfma_f32_16x16x32_bf16(Bt[n][k], At[m][k], acc[ai][bj][m][n], 0, 0, 0); } __builtin_amdgcn_s_setprio(0); } while (0)
#ifdef EXP_STAGE_DUP
#define PG8_WAIT_V(n) asm volatile("s_waitcnt vmcnt(%0)" :: "i"(2 * (n)) : "memory")
#else
#define PG8_WAIT_V(n) asm volatile("s_waitcnt vmcnt(" #n ")" ::: "memory")
#endif
#define PG8_WAIT_L(n) asm volatile("s_waitcnt lgkmcnt(" #n ")" ::: "memory")
#define PG8_BAR __builtin_amdgcn_s_barrier()
#define PG8_SCHED __builtin_amdgcn_sched_barrier(0)
#define PG8_STAGE_A(bufoff, ubase, gv, koff, h) PG8_STAGE(bufoff, (ubase) + (koff), gv[h])
#define PG8_GSWITCH() do { if constexpr (GATHER) { if (last && has_next) { _Pragma("unroll") for (int h_ = 0; h_ < 2; ++h_) _Pragma("unroll") for (int i_ = 0; i_ < 2; ++i_) \
        { int R_, C_; stage_rc(tid * 16 + i_ * 8192, R_, C_); gcur[h_][i_] = (unsigned)rnx[h_][i_] * (unsigned)rowbytes + (unsigned)C_ * 2u; } } } } while (0)
    Unit cur, nxt; int ui = 0;
    if (!S.next(0, cur)) return;
    f32x4 acc[2][2][4][2];
#pragma unroll
    for (int a = 0; a < 2; ++a)
#pragma unroll
        for (int b = 0; b < 2; ++b)
#pragma unroll
            for (int m = 0; m < 4; ++m)
#pragma unroll
                for (int n = 0; n < 2; ++n) acc[a][b][m][n] = (f32x4){0.f, 0.f, 0.f, 0.f};
    bf16x8 At[4][2], B0[2][2], B1[2][2]; v8i At8[4], B08[2], B18[2];
    unsigned gcur[2][2]; int rnx[2][2];
#pragma unroll
    for (int h = 0; h < 2; ++h)
#pragma unroll
        for (int i = 0; i < 2; ++i) { int R, C; stage_rc(tid * 16 + i * 8192, R, C); const int r = R + h * HALF; int row = r; if constexpr (GATHER) row = (r < cur.nvalid) ? (cur.rows ? cur.rows[r] : r) : 0;
            gcur[h][i] = (unsigned)row * (unsigned)rowbytes + (unsigned)C * 2u; rnx[h][i] = 0; }
    const char* cA = cur.a; const char* cB = cur.b;
    if constexpr (Epi::PREF) E.prefetch(cur, lds, 0, tid);
    if constexpr (SP2) {
        PG8_STAGE(PG8_SB(0, 0), cB, voffB); PG8_STAGE(PG8_SB(0, 1), cB + hstep, voffB); PG8_STAGE_A(PG8_SA(0, 0), cA, gcur, 0, 0); PG8_STAGE_A(PG8_SA(0, 1), cA, gcur, 0, 1);
        if (wr == 1) PG8_BAR;
        PG8_WAIT_V(2); PG8_BAR;
        PG8_STAGE(PG8_SB(1, 0), cB + kstep, voffB); PG8_STAGE_A(PG8_SA(1, 0), cA, gcur, kstep, 0); PG8_STAGE(PG8_SB(1, 1), cB + hstep + kstep, voffB);
        PG8_WAIT_V(6); PG8_BAR;
    } else {
        PG8_STAGE(PG8_SB(0, 0), cB, voffB); PG8_STAGE_A(PG8_SA(0, 0), cA, gcur, 0, 0); PG8_STAGE(PG8_SB(0, 1), cB + hstep, voffB); PG8_STAGE_A(PG8_SA(0, 1), cA, gcur, 0, 1);
        if (wr == 1) PG8_BAR;
        PG8_WAIT_V(4); PG8_BAR;
        PG8_STAGE(PG8_SB(1, 0), cB + kstep, voffB); PG8_STAGE_A(PG8_SA(1, 0), cA, gcur, kstep, 0); PG8_STAGE(PG8_SB(1, 1), cB + hstep + kstep, voffB);
        PG8_WAIT_V(6); PG8_BAR;
    }
    for (;;) {
        const bool has_next = S.next(ui + 1, nxt);
        const char* nA = has_next ? nxt.a : cA; const char* nB = has_next ? nxt.b : cB;
        if constexpr (GATHER) { if (has_next) {
#pragma unroll
            for (int h = 0; h < 2; ++h)
#pragma unroll
                for (int i = 0; i < 2; ++i) { int R, C; stage_rc(tid * 16 + i * 8192, R, C); const int r = R + h * HALF; rnx[h][i] = (r < nxt.nvalid) ? (nxt.rows ? nxt.rows[r] : r) : 0; } } }
#pragma unroll 1
        for (int t = 0; t < nt; t += 2) {
            const bool last = (t == nt - 2);
            const size_t k1 = (size_t)(t + 1) * kstep;
            const char* a2 = last ? nA : cA; const char* b2 = last ? nB : cB + (size_t)(t + 2) * kstep;
            const size_t k2 = last ? 0 : (size_t)(t + 2) * kstep, k3 = k2 + kstep;
            const char* b3 = b2 + kstep;
            if constexpr (SP2) {
            PG8_LDB(B0, 0, 0); PG8_LDB(B1, 0, 1); PG8_SCHED; PG8_LDA(At, 0, 0); PG8_STAGE_A(PG8_SA(1, 1), cA, gcur, k1, 1); PG8_GSWITCH();
            PG8_WAIT_V(8); PG8_WAIT_L(0); PG8_BAR; PG8_MMA(0, 0, At, B0); PG8_MMA(0, 1, At, B1); PG8_BAR; PG8_SCHED;
            PG8_LDA(At, 0, 1); PG8_STAGE(PG8_SB(0, 0), b2, voffB); PG8_STAGE(PG8_SB(0, 1), b2 + hstep, voffB); PG8_STAGE_A(PG8_SA(0, 0), a2, gcur, k2, 0);
            PG8_WAIT_V(8); PG8_WAIT_L(0); PG8_BAR; PG8_MMA(1, 0, At, B0); PG8_MMA(1, 1, At, B1); PG8_BAR; PG8_SCHED;
            PG8_LDB(B0, 1, 0); PG8_LDB(B1, 1, 1); PG8_SCHED; PG8_LDA(At, 1, 0); PG8_STAGE_A(PG8_SA(0, 1), a2, gcur, k2, 1);
            PG8_WAIT_V(8); PG8_WAIT_L(0); PG8_BAR; PG8_MMA(0, 0, At, B0); PG8_MMA(0, 1, At, B1); PG8_BAR; PG8_SCHED;
            PG8_LDA(At, 1, 1); PG8_STAGE(PG8_SB(1, 0), b3, voffB); PG8_STAGE(PG8_SB(1, 1), b3 + hstep, voffB); PG8_STAGE_A(PG8_SA(1, 0), a2, gcur, k3, 0);
            PG8_WAIT_V(8); PG8_WAIT_L(0); PG8_BAR; PG8_MMA(1, 0, At, B0); PG8_MMA(1, 1, At, B1); PG8_BAR; PG8_SCHED;
            } else {
            PG8_LDB(B0, 0, 0); PG8_SCHED; PG8_LDA(At, 0, 0); PG8_STAGE_A(PG8_SA(1, 1), cA, gcur, k1, 1); PG8_GSWITCH();
            PG8_WAIT_L(8); PG8_BAR; PG8_WAIT_L(0); PG8_MMA(0, 0, At, B0); PG8_BAR; PG8_SCHED;
            PG8_LDB(B1, 0, 1); PG8_STAGE(PG8_SB(0, 0), b2, voffB);
            PG8_BAR; PG8_WAIT_L(0); PG8_MMA(0, 1, At, B1); PG8_BAR;
            PG8_LDA(At, 0, 1); PG8_STAGE_A(PG8_SA(0, 0), a2, gcur, k2, 0);
            PG8_BAR; PG8_WAIT_L(0); PG8_MMA(1, 0, At, B0); PG8_BAR; PG8_SCHED;
            PG8_STAGE(PG8_SB(0, 1), b2 + hstep, voffB);
            PG8_WAIT_V(6); PG8_BAR; PG8_MMA(1, 1, At, B1); PG8_BAR;
            PG8_LDB(B0, 1, 0); PG8_SCHED; PG8_LDA(At, 1, 0); PG8_STAGE_A(PG8_SA(0, 1), a2, gcur, k2, 1);
            PG8_WAIT_L(8); PG8_BAR; PG8_WAIT_L(0); PG8_MMA(0, 0, At, B0); PG8_BAR; PG8_SCHED;
            PG8_LDB(B1, 1, 1); PG8_STAGE(PG8_SB(1, 0), b3, voffB);
            PG8_BAR; PG8_WAIT_L(0); PG8_MMA(0, 1, At, B1); PG8_BAR;
            PG8_LDA(At, 1, 1); PG8_STAGE_A(PG8_SA(1, 0), a2, gcur, k3, 0);
            PG8_BAR; PG8_WAIT_L(0); PG8_MMA(1, 0, At, B0); PG8_BAR; PG8_SCHED;
            PG8_STAGE(PG8_SB(1, 1), b3 + hstep, voffB);
            PG8_WAIT_V(6); PG8_BAR; PG8_MMA(1, 1, At, B1); PG8_BAR;
            }
        }
        if constexpr (ALIGN_EPI) { if (wr == 0) PG8_BAR; }
        if constexpr (Epi::PREF) { if (has_next) E.prefetch(nxt, lds, (ui + 1) & 1, tid); E(acc, cur, wr, wc, fr, fq, (const LAS float*)(lds + 131072 + 10240 + (ui & 1) * 1024)); }
        else E(acc, cur, wr, wc, fr, fq);
#ifdef MK_EXP_EPI2
        if constexpr (Epi::TWICE) { asm volatile("" ::: "memory"); E(acc, cur, wr, wc, fr, fq); }
#endif
        if (!has_next) break;
#pragma unroll
        for (int a = 0; a < 2; ++a)
#pragma unroll
            for (int b = 0; b < 2; ++b)
#pragma unroll
                for (int m = 0; m < 4; ++m)
#pragma unroll
                    for (int n = 0; n < 2; ++n) {
#if MK_ZERO64
                        typedef float f32x2z __attribute__((ext_vector_type(2))); f32x2z zlo, zhi;
                        asm volatile("v_mov_b64 %0, 0" : "=v"(zlo)); asm volatile("v_mov_b64 %0, 0" : "=v"(zhi));
                        acc[a][b][m][n] = __builtin_shufflevector(zlo, zhi, 0, 1, 2, 3);
#else
                        acc[a][b][m][n] = (f32x4){0.f, 0.f, 0.f, 0.f};
#endif
                    }
        cur = nxt; cA = nA; cB = nB; ++ui;
        if constexpr (ALIGN_EPI) { if (wr == 1) PG8_BAR; }
    }
    PG8_WAIT_V(0);
    if constexpr (!ALIGN_EPI) { if (wr == 0) PG8_BAR; }
    PG8_BAR;
#undef PG8_SA
#undef PG8_SB
#undef PG8_STAGE
#undef PG8_STAGE_A
#undef PG8_GSWITCH
#undef PG8_LDA
#undef PG8_LD32
#undef PG8_LDB
#undef PG8_MMA
#undef PG8_WAIT_V
#undef PG8_WAIT_L
#undef PG8_BAR
#undef PG8_SCHED
}
}
constexpr int NWAVES = 8, NTHR = 512;
constexpr int NEXP = 64, NEXP1 = 65;
constexpr int LDS_BYTES = 147456;
constexpr int RING_OFF = 0, RING_BYTES = 131072, LDSCTL_OFF = RING_BYTES, MISC_OFF = LDSCTL_OFF + 320;

struct Lay {
    size_t ctl, mod, cs128, cs64, kmean, ssq, hist, starts, cnts, tokmask, tokpos, stok, sw, tw, logits;
    size_t wd, wgu, win, win8, wuq, wukv, wo, wr;
    size_t h1, qa, ka, va, cq, ckv, kr, qmn, qmr, kn, vm, mix, y, x1, h2, h2f8, h1f8, hb, slot, end;
};
constexpr size_t CTL_BYTES = 64 * 1024;
constexpr Lay make_lay_fast() {
    Lay L{};
    L.ctl = 0; L.mod = 1 * MiB; L.cs128 = 2 * MiB; L.cs64 = 3 * MiB; L.kmean = 3 * MiB + 512 * 1024; L.ssq = 4 * MiB  ; L.hist = 5 * MiB; L.starts = 5 * MiB + 128 * 1024; L.cnts = 5 * MiB + 192 * 1024;
    L.tokmask = 5 * MiB + 256 * 1024; L.tokpos = 6 * MiB; L.stok = 6 * MiB + 512 * 1024  ; L.sw = 7 * MiB + 64 * 1024; L.tw = 8 * MiB; L.logits = 12 * MiB;
    L.wd = 16 * MiB; L.x1 = 146 * MiB; L.hb = 274 * MiB; L.win = 420 * MiB; L.wuq = 438 * MiB; L.wukv = 440 * MiB; L.wo = 442 * MiB; L.wr = 450 * MiB; L.wgu = 452 * MiB;
    L.h1 = 146 * MiB; L.qa = 210 * MiB; L.ka = 242 * MiB; L.va = 274 * MiB; L.cq = 306 * MiB; L.ckv = 322 * MiB; L.kr = 338 * MiB; L.qmn = 340 * MiB; L.qmr = 372 * MiB; L.kn = 388 * MiB;
    L.vm = 712 * MiB; L.mix = 744 * MiB; L.y = 808 * MiB; L.h2 = 936 * MiB; L.h2f8 = 1000 * MiB; L.h1f8 = 808 * MiB  ; L.win8 = 0; L.slot = 548 * MiB; L.end = 1060 * MiB;
    return L;
}
constexpr Lay make_lay_dbg() {
    Lay L{}; const size_t B0 = 632 * MiB;
    L.ctl = B0; L.mod = B0 + 1 * MiB; L.cs128 = B0 + 2 * MiB; L.cs64 = B0 + 3 * MiB; L.kmean = B0 + 3 * MiB + 512 * 1024; L.ssq = B0 + 4 * MiB; L.hist = B0 + 5 * MiB; L.starts = B0 + 5 * MiB + 128 * 1024; L.cnts = B0 + 5 * MiB + 192 * 1024;
    L.tokmask = B0 + 5 * MiB + 256 * 1024; L.tokpos = B0 + 6 * MiB; L.stok = B0 + 6 * MiB + 512 * 1024; L.sw = B0 + 7 * MiB + 64 * 1024; L.tw = 0; L.logits = 0;
    L.win = B0 + 8 * MiB; L.wuq = B0 + 26 * MiB; L.wukv = B0 + 28 * MiB; L.wo = B0 + 30 * MiB; L.wr = B0 + 38 * MiB;
    L.h1 = B0 + 40 * MiB; L.qa = B0 + 104 * MiB; L.ka = B0 + 136 * MiB; L.va = B0 + 168 * MiB; L.cq = B0 + 200 * MiB; L.ckv = B0 + 216 * MiB; L.kr = B0 + 232 * MiB; L.qmn = B0 + 234 * MiB; L.qmr = B0 + 266 * MiB; L.kn = B0 + 282 * MiB;
    L.vm = B0 + 314 * MiB; L.mix = B0 + 346 * MiB; L.end = B0 + 410 * MiB;
    L.wd = 0; L.wgu = 0; L.x1 = 0; L.hb = 0; L.y = 0; L.h2 = 0; L.h2f8 = 0; L.slot = 0; L.h1f8 = B0 + 346 * MiB  ; L.win8 = B0 + 34 * MiB;
    return L;
}
#ifndef MK_LAYOUT_DBG
#define MK_LAYOUT_DBG 0
#endif
constexpr Lay WL = MK_LAYOUT_DBG ? make_lay_dbg() : make_lay_fast();

struct Args { const float* in[22]; float* out; unsigned char* ws; int ph_lo, ph_hi; unsigned flags; int pad; };
struct Frame {
    LAS unsigned char* lds; volatile LAS unsigned* MISC;
    int tid, lane, wave, G, vcu;
    unsigned char* ws;
};
#define LDS_WAIT() asm volatile("s_waitcnt lgkmcnt(0)" ::: "memory")
#define VM_WAIT() asm volatile("s_waitcnt vmcnt(0)" ::: "memory")

__device__ __forceinline__ float wave_sum(float v) {
#pragma unroll
    for (int o = 1; o < 64; o <<= 1) v += __shfl_xor(v, o);
    return v;
}

struct TileOrder {
    int nM, nN, nwg, G, c;
    __device__ __forceinline__ void init(int nM_, int nN_, int G_, int c_) { nM = nM_; nN = nN_; nwg = nM * nN; G = G_; c = c_; }
    __device__ __forceinline__ bool get(int i, int& pm, int& pn) const {
        const long L = (long)i * G + c; if (L >= nwg) return false;
        const int wgid = pg8::xcd_remap((int)L, nwg);
        const int nig = 8 * nN, gid = wgid / nig, fm = gid * 8, gsz = (nM - fm) < 8 ? (nM - fm) : 8;
        pm = fm + ((wgid % nig) % gsz); pn = (wgid % nig) / gsz; return true;
    }
};
#ifndef MK_RD_NT
#define MK_RD_NT 1
#endif
template <class Map>
__device__ __forceinline__ void tr_item(const float* __restrict__ W, int ldw, int k0, int n0, bf16_t* __restrict__ WT, int ldk, const Map& map, const float* __restrict__ kscale, LAS float* scr, int lane) {
    float tv[32];
#pragma unroll
    for (int i = 0; i < 32; ++i) { const int kk = 2 * i + (lane >> 5); tv[i] = __builtin_nontemporal_load(W + (size_t)(k0 + kk) * ldw + n0 + (lane & 31)); }
#pragma unroll
    for (int i = 0; i < 32; ++i) { const int kk = 2 * i + (lane >> 5); float v = tv[i]; if (kscale) v *= kscale[k0 + kk]; scr[kk * 33 + (lane & 31)] = v; }
    LDS_WAIT(); asm volatile("" ::: "memory");
    const int c = lane & 7;
#pragma unroll
    for (int j = 0; j < 4; ++j) { const int n = (lane >> 3) + 8 * j; const LAS float* s = scr + (8 * c) * 33 + n; const int row = map(n0 + n);
        u32x4 o; o.x = pk2(s[0 * 33], s[1 * 33]); o.y = pk2(s[2 * 33], s[3 * 33]); o.z = pk2(s[4 * 33], s[5 * 33]); o.w = pk2(s[6 * 33], s[7 * 33]);
        if (row >= 0) *(u32x4*)(WT + (size_t)row * ldk + k0 + 8 * c) = o; }
    LDS_WAIT(); asm volatile("" ::: "memory");
}
__device__ __forceinline__ void tr_load(const float* __restrict__ W, int ldw, int k0, int n0, int lane, float (&tv)[32]) {
#pragma unroll
    for (int i = 0; i < 32; ++i) { const int kk = 2 * i + (lane >> 5); tv[i] = __builtin_nontemporal_load(W + (size_t)(k0 + kk) * ldw + n0 + (lane & 31)); }
}
template <class Map>
__device__ __forceinline__ void tr_finish8(const float (&tv)[32], int k0, int n0, unsigned char* __restrict__ WT, int ldk, const Map& map, LAS float* scr, int lane, const float* __restrict__ kscale = nullptr) {
#pragma unroll
    for (int i = 0; i < 32; ++i) { const int kk = 2 * i + (lane >> 5); float v = tv[i] * 64.f; if (kscale) v *= kscale[k0 + kk]; scr[kk * 33 + (lane & 31)] = v; }
    LDS_WAIT(); asm volatile("" ::: "memory");
    const int c = lane & 7;
#pragma unroll
    for (int j = 0; j < 4; ++j) { const int n = (lane >> 3) + 8 * j; const LAS float* s = scr + (8 * c) * 33 + n; const int row = map(n0 + n);
        u32x2 o; o.x = pk4_fp8(s[0 * 33], s[1 * 33], s[2 * 33], s[3 * 33]); o.y = pk4_fp8(s[4 * 33], s[5 * 33], s[6 * 33], s[7 * 33]);
        if (row >= 0) *(u32x2*)(WT + (size_t)row * ldk + k0 + 8 * c) = o; }
    LDS_WAIT(); asm volatile("" ::: "memory");
}
template <class Map>
__device__ __forceinline__ void tr_item8(const float* __restrict__ W, int ldw, int k0, int n0, unsigned char* __restrict__ WT, int ldk, const Map& map, LAS float* scr, int lane, const float* __restrict__ kscale = nullptr) {
    float tv[32]; tr_load(W, ldw, k0, n0, lane, tv); tr_finish8(tv, k0, n0, WT, ldk, map, scr, lane, kscale);
}
__device__ __forceinline__ void tx_load(const float* __restrict__ W, int ldw, int k0, int n0, int lane, f32x4 (&tv)[16]) {
    const float* p = W + (size_t)(k0 + 16 * (lane >> 4)) * ldw + n0 + 4 * (lane & 15);
#pragma unroll
    for (int i = 0; i < 16; ++i) tv[i] = __builtin_nontemporal_load((const f32x4*)(p + (size_t)i * ldw));
}
template <class Map>
__device__ __forceinline__ void tx_finish8(const f32x4 (&tv)[16], int k0, int n0, unsigned char* __restrict__ WT, int ldk, const Map& map, int lane) {
    const int kq = lane >> 4, n4 = lane & 15;
#pragma unroll
    for (int j = 0; j < 4; ++j) { u32x4 o;
        o.x = pk4_fp8(tv[0][j] * 64.f, tv[1][j] * 64.f, tv[2][j] * 64.f, tv[3][j] * 64.f); o.y = pk4_fp8(tv[4][j] * 64.f, tv[5][j] * 64.f, tv[6][j] * 64.f, tv[7][j] * 64.f);
        o.z = pk4_fp8(tv[8][j] * 64.f, tv[9][j] * 64.f, tv[10][j] * 64.f, tv[11][j] * 64.f); o.w = pk4_fp8(tv[12][j] * 64.f, tv[13][j] * 64.f, tv[14][j] * 64.f, tv[15][j] * 64.f);
        const int row = map(n0 + 4 * n4 + j);
        *(u32x4*)(WT + (size_t)row * ldk + k0 + 16 * kq) = o; }
}
#ifndef MK_TX_NTST
#define MK_TX_NTST 1
#endif
#ifndef MK_TX_NT
#define MK_TX_NT 1
#endif
__device__ __forceinline__ void tx_load_b(const float* __restrict__ W, int ldw, int k0, int n0, int lane, f32x4 (&tv)[16]) {
    const float* p = W + (size_t)(k0 + 16 * (lane >> 3)) * ldw + n0 + 4 * (lane & 7);
#pragma unroll
    for (int i = 0; i < 16; ++i) tv[i] = MK_TX_NT ? __builtin_nontemporal_load((const f32x4*)(p + (size_t)i * ldw)) : *(const f32x4*)(p + (size_t)i * ldw);
}
template <class Map>
__device__ __forceinline__ void tx_finish8_b(const f32x4 (&tv)[16], int k0, int n0, unsigned char* __restrict__ WT, int ldk, const Map& map, int lane) {
    const int kq = lane >> 3, n4 = lane & 7;
#pragma unroll
    for (int j = 0; j < 4; ++j) { u32x4 o;
        o.x = pk4_fp8(tv[0][j] * 64.f, tv[1][j] * 64.f, tv[2][j] * 64.f, tv[3][j] * 64.f); o.y = pk4_fp8(tv[4][j] * 64.f, tv[5][j] * 64.f, tv[6][j] * 64.f, tv[7][j] * 64.f);
        o.z = pk4_fp8(tv[8][j] * 64.f, tv[9][j] * 64.f, tv[10][j] * 64.f, tv[11][j] * 64.f); o.w = pk4_fp8(tv[12][j] * 64.f, tv[13][j] * 64.f, tv[14][j] * 64.f, tv[15][j] * 64.f);
        const int row = map(n0 + 4 * n4 + j);
        if (MK_TX_NTST) __builtin_nontemporal_store(o, (u32x4*)(WT + (size_t)row * ldk + k0 + 16 * kq)); else *(u32x4*)(WT + (size_t)row * ldk + k0 + 16 * kq) = o; }
}
struct MapId { __device__ __forceinline__ int operator()(int n) const { return n; } };
struct MapWin { __device__ __forceinline__ int operator()(int n) const {
    if (n < 2048) { const int d = n & 127; return (n & ~127) + (d < 64 ? 2 * d : 2 * (d - 64) + 1); }
    if (n < 4096) return n;
    const int d = n - 4096; return 4096 + (d < 32 ? 2 * d : 2 * (d - 32) + 1); } };
struct MapWuq { __device__ __forceinline__ int operator()(int n) const { const int h = n / 192, d = n - 192 * h; if (d < 128) return 128 * h + d; const int r = d - 128; return 1024 + 64 * h + (r < 32 ? 2 * r : 2 * (r - 32) + 1); } };
struct MapGu { int up; __device__ __forceinline__ int operator()(int n) const { return 256 * (n >> 7) + 128 * up + (n & 127); } };

__device__ __forceinline__ void p0_mod(Frame& F, const float* __restrict__ c, const float* __restrict__ w_ada, const float* __restrict__ b_ada, float* __restrict__ mod) {
    LAS float* sc = (LAS float*)(F.lds + RING_OFF); LAS float* red = (LAS float*)(F.lds + RING_OFF + 65536);
    for (int i = F.tid; i < 8 * 2048; i += NTHR) { const float v = c[i]; sc[i] = v / (1.f + __expf(-v)); }
    __syncthreads();
    const int q = F.tid % 12, kg = F.tid / 12;
    for (int item = F.vcu; item < 256; item += F.G) {
        const int col = item * 48 + q * 4;
        if (kg < 40) {
            f32x4 a[8];
#pragma unroll
            for (int b = 0; b < 8; ++b) a[b] = (f32x4){0.f, 0.f, 0.f, 0.f};
            for (int k = kg; k < 2048; k += 40) { const f32x4 w = MK_RD_NT ? __builtin_nontemporal_load((const f32x4*)(w_ada + (size_t)k * 12288 + col)) : *(const f32x4*)(w_ada + (size_t)k * 12288 + col);
#pragma unroll
                for (int b = 0; b < 8; ++b) a[b] += w * sc[b * 2048 + k]; }
#pragma unroll
            for (int b = 0; b < 8; ++b) *(LAS f32x4*)(red + (kg * 8 + b) * 48 + q * 4) = a[b];
        }
        __syncthreads();
        if (F.tid < 384) { const int b = F.tid / 48, cc = F.tid % 48; float s = b_ada[item * 48 + cc];
            for (int g = 0; g < 40; ++g) s += red[(g * 8 + b) * 48 + cc];
            mod[b * 12288 + item * 48 + cc] = s; }
        __syncthreads();
    }
}
__device__ __forceinline__ void p0_rope_tab(Frame& F, float2* __restrict__ cs128, float2* __restrict__ cs64) {
    for (int idx = F.vcu * NTHR + F.tid; idx < S * 64; idx += F.G * NTHR) {
        { const int pos = idx / 64, i = idx % 64; const float inv = (float)(1.0 / pow(10000.0, (double)(2 * i) / 128.0)); const float a = (float)pos * inv; cs128[idx] = make_float2((float)cos((double)a), (float)sin((double)a)); }
        if (idx < S * 32) { const int pos = idx / 32, i = idx % 32; const float inv = (float)(1.0 / pow(10000.0, (double)(2 * i) / 64.0)); const float a = (float)pos * inv; cs64[idx] = make_float2((float)cos((double)a), (float)sin((double)a)); }
    }
}
__device__ __forceinline__ void p0_convert_experts(Frame& F, const Args& A);
__device__ __forceinline__ void p0_convert_experts(Frame& F, const Args& A, int it0, int step, int itEnd, int list);
__device__ __forceinline__ void p0_convert(Frame& F, const Args& A, unsigned flags) {
    LAS float* scr = (LAS float*)(F.lds + RING_OFF + F.wave * 16384);
    const int gw = F.vcu * NWAVES + F.wave, NGW = F.G * NWAVES;
    const float *w_in = A.in[4], *g_cq = A.in[5], *w_uq = A.in[6], *g_ckv = A.in[7], *w_ukv = A.in[8], *w_o = A.in[9], *w_router = A.in[12];
    unsigned char* Win8 = F.ws + WL.win; unsigned char* WuqT = F.ws + WL.wuq; unsigned char* WukvT = F.ws + WL.wukv; unsigned char* WoT = F.ws + WL.wo; bf16_t* WrT = (bf16_t*)(F.ws + WL.wr);
    if (flags & 1u) {
        constexpr int I_IN = 32 * 130, I_UQ = 8 * 48, I_UKV = 8 * 64, I_O = 32 * 64, I_ALL = I_IN + I_UQ + I_UKV + I_O;
        for (int it = gw; it < I_ALL; it += NGW) { int r = it;
            if (r < I_IN) { tr_item8(w_in, INW, 64 * (r / 130), 32 * (r % 130), Win8, 2048, MapWin{}, scr, F.lane); continue; } r -= I_IN;
            if (r < I_UQ) { tr_item8(w_uq, 1536, 64 * (r / 48), 32 * (r % 48), WuqT, 512, MapWuq{}, scr, F.lane, g_cq); continue; } r -= I_UQ;
            if (r < I_UKV) { tr_item8(w_ukv, 2048, 64 * (r / 64), 32 * (r % 64), WukvT, 512, MapId{}, scr, F.lane, g_ckv); continue; } r -= I_UKV;
            tr_item8(w_o, 2048, 64 * (r / 64), 32 * (r % 64), WoT, 2048, MapId{}, scr, F.lane); }
        for (int i = gw * 64 + F.lane; i < 2048 * 64; i += NGW * 64) { const int k = i >> 6, e = i & 63; const float v = w_router[i]; const unsigned hi = f2bf(v); const float lo = v - bf2f(hi);
            WrT[(size_t)e * 2048 + k] = (bf16_t)hi; WrT[(size_t)(64 + e) * 2048 + k] = (bf16_t)f2bf(lo); }
    }
#ifdef MK_CONV_EXP
    if (flags & 2u) { if ((F.vcu >> 2) % MK_CONV_EXP == 0) { const int idx = ((F.vcu >> 2) / MK_CONV_EXP) * 4 + (F.vcu & 3), n = (63 / MK_CONV_EXP + 1) * 4; p0_convert_experts(F, A, idx * NWAVES + F.wave, n * NWAVES, NEXP1 * 768, 2); } }
#else
    if (flags & 2u) p0_convert_experts(F, A);
#endif
}
#ifndef MK_TX128
#define MK_TX128 1
#endif
struct MapExp { int kind; __device__ __forceinline__ int operator()(int n) const { return kind == 2 ? n : 256 * (n >> 7) + 128 * kind + (n & 127); } };
#ifndef MK_POOL_E0
#define MK_POOL_E0 39
#endif
constexpr int CONV_NV0 = NEXP1 * 512 + MK_POOL_E0 * 256, CONV_NV1 = (NEXP1 - MK_POOL_E0) * 256;
__device__ __forceinline__ int conv_remap(int list, int v) {
    if (list == 0) { if (v < NEXP1 * 512) return (v >> 9) * 768 + (v & 511); const int j = v - NEXP1 * 512; return (j >> 8) * 768 + 512 + (j & 255); }
    if (list == 1) return (MK_POOL_E0 + (v >> 8)) * 768 + 512 + (v & 255);
    return v;
}
__device__ __forceinline__ void p0_convert_experts(Frame& F, const Args& A, int it0, int step, int itEnd, int list = 2) {
    const float *w_gate = A.in[14], *w_up = A.in[15], *w_down = A.in[16], *ws_gate = A.in[17], *ws_up = A.in[18], *ws_down = A.in[19];
    unsigned char* WguT = F.ws + WL.wgu; unsigned char* WdT = F.ws + WL.wd;
    constexpr int I_G = 32 * 8, I_D = 8 * 32, I_E = 2 * I_G + I_D;
#if MK_TX128
#define P0_ITEM(it_, Wp_, ldw_, k0_, n0_, Dp_, ldk_, kind_) do { const int e_ = (it_) / I_E; int r_ = (it_) % I_E; \
        if (r_ < I_G) { Wp_ = e_ < NEXP ? w_gate + (size_t)e_ * 2048 * 512 : ws_gate; ldw_ = 512; k0_ = 128 * (r_ / 16); n0_ = 32 * (r_ % 16); Dp_ = WguT + (size_t)e_ * 1024 * 2048; ldk_ = 2048; kind_ = 0; } \
        else if (r_ < 2 * I_G) { r_ -= I_G; Wp_ = e_ < NEXP ? w_up + (size_t)e_ * 2048 * 512 : ws_up; ldw_ = 512; k0_ = 128 * (r_ / 16); n0_ = 32 * (r_ % 16); Dp_ = WguT + (size_t)e_ * 1024 * 2048; ldk_ = 2048; kind_ = 1; } \
        else { r_ -= 2 * I_G; Wp_ = e_ < NEXP ? w_down + (size_t)e_ * 512 * 2048 : ws_down; ldw_ = 2048; k0_ = 128 * (r_ / 64); n0_ = 32 * (r_ % 64); Dp_ = WdT + (size_t)e_ * 2048 * 512; ldk_ = 512; kind_ = 2; } } while (0)
#define TX_LOAD tx_load_b
#define TX_FIN tx_finish8_b
#else
#define P0_ITEM(it_, Wp_, ldw_, k0_, n0_, Dp_, ldk_, kind_) do { const int e_ = (it_) / I_E; int r_ = (it_) % I_E; \
        if (r_ < I_G) { Wp_ = e_ < NEXP ? w_gate + (size_t)e_ * 2048 * 512 : ws_gate; ldw_ = 512; k0_ = 64 * (r_ / 8); n0_ = 64 * (r_ % 8); Dp_ = WguT + (size_t)e_ * 1024 * 2048; ldk_ = 2048; kind_ = 0; } \
        else if (r_ < 2 * I_G) { r_ -= I_G; Wp_ = e_ < NEXP ? w_up + (size_t)e_ * 2048 * 512 : ws_up; ldw_ = 512; k0_ = 64 * (r_ / 8); n0_ = 64 * (r_ % 8); Dp_ = WguT + (size_t)e_ * 1024 * 2048; ldk_ = 2048; kind_ = 1; } \
        else { r_ -= 2 * I_G; Wp_ = e_ < NEXP ? w_down + (size_t)e_ * 512 * 2048 : ws_down; ldw_ = 2048; k0_ = 64 * (r_ / 32); n0_ = 64 * (r_ % 32); Dp_ = WdT + (size_t)e_ * 2048 * 512; ldk_ = 512; kind_ = 2; } } while (0)
#define TX_LOAD tx_load
#define TX_FIN tx_finish8
#endif
#define P0_LOAD(itx_, tv_) do { const int v_ = (itx_); if (v_ < itEnd) { const int i_ = conv_remap(list, v_); const float* W_; int lw_, k_, n_, lk_, kd_; unsigned char* D_; P0_ITEM(i_, W_, lw_, k_, n_, D_, lk_, kd_); (void)D_; (void)lk_; (void)kd_; TX_LOAD(W_, lw_, k_, n_, F.lane, tv_); } } while (0)
#define P0_FIN(itx_, tv_) do { const int v_ = (itx_); if (v_ < itEnd) { const int i_ = conv_remap(list, v_); const float* W_; int lw_, k_, n_, lk_, kd_; unsigned char* D_; P0_ITEM(i_, W_, lw_, k_, n_, D_, lk_, kd_); (void)W_; (void)lw_; TX_FIN(tv_, k_, n_, D_, lk_, MapExp{kd_}, F.lane); } } while (0)
    f32x4 ta[16], tb[16], tc[16];
    P0_LOAD(it0, ta); P0_LOAD(it0 + step, tb);
#pragma unroll 1
    for (int it = it0; it < itEnd; it += 3 * step) {
        P0_LOAD(it + 2 * step, tc); P0_FIN(it, ta);
        P0_LOAD(it + 3 * step, ta); P0_FIN(it + step, tb);
        P0_LOAD(it + 4 * step, tb); P0_FIN(it + 2 * step, tc);
    }
#undef P0_FIN
#undef TX_LOAD
#undef TX_FIN
#undef P0_LOAD
#undef P0_ITEM
}
__device__ __forceinline__ void p0_convert_experts(Frame& F, const Args& A) { p0_convert_experts(F, A, F.vcu * NWAVES + F.wave, F.G * NWAVES, NEXP1 * 768); }
__device__ __forceinline__ void p0_convert_experts_p4(Frame& F, const Args& A) { p0_convert_experts(F, A, F.vcu * NWAVES + F.wave, F.G * NWAVES, CONV_NV0, 0); }
#ifndef MK_CONV_DW
#define MK_CONV_DW 100
#endif
__device__ __forceinline__ int conv_cum(int c) { const int bh = c >> 2, y = c & 3; return bh * 4000 + y * 1000 + (MK_CONV_DW * y * (4 - y)) / 2; }
__device__ __forceinline__ void p0_convert_experts_w(Frame& F, const Args& A) {
    if (F.G != 256) { p0_convert_experts(F, A); return; }
    const int s0 = conv_cum(F.vcu) * 195 / 1000, s1 = conv_cum(F.vcu + 1) * 195 / 1000;
    p0_convert_experts(F, A, s0 + F.wave, NWAVES, s1);
}
__device__ __forceinline__ void p1_h1(Frame& F, const float* __restrict__ x, const float* __restrict__ mod, unsigned char* __restrict__ H1F8) {
    const int gw = F.vcu * NWAVES + F.wave, NGW = F.G * NWAVES;
    for (int t0 = gw; t0 < T; t0 += 2 * NGW) {
        f32x4 v[2][8];
#pragma unroll
        for (int p = 0; p < 2; ++p) { const int t = t0 + p * NGW; if (t < T) { const GAS f32x4* xr = (const GAS f32x4*)(x + (size_t)t * D) + F.lane;
#pragma unroll
            for (int j = 0; j < 8; ++j) v[p][j] = MK_RD_NT ? __builtin_nontemporal_load((const f32x4*)(xr + 64 * j)) : xr[64 * j]; } }
#pragma unroll
        for (int p = 0; p < 2; ++p) { const int t = t0 + p * NGW; if (t < T) { const int b = t >> 11; const float* m = mod + b * 12288;
            GAS unsigned* o8 = (GAS unsigned*)(H1F8 + (size_t)t * D) + F.lane;
#pragma unroll
            for (int j = 0; j < 8; ++j) { const f32x4 sh = *(const f32x4*)(m + 256 * j + 4 * F.lane), sc = *(const f32x4*)(m + 2048 + 256 * j + 4 * F.lane);
                const f32x4 h = v[p][j] * (sc + 1.f) + sh; o8[64 * j] = pk4_fp8(h[0], h[1], h[2], h[3]); } } }
    }
}
#ifndef EXP_EPI_IN2
#define EXP_EPI_IN2 0
#endif
#ifndef EXP_EPI_MLA2
#define EXP_EPI_MLA2 0
#endif
struct SchedIn {
    TileOrder o; const char* A; const char* Bt; int pn0, rowb;
    __device__ __forceinline__ bool next(int i, pg8::Unit& u) const { int pm, pl; if (!o.get(i, pm, pl)) return false; const int pn = pn0 + pl;
        u.pm = pm; u.pn = pn; u.kind = pn < 8 ? 0 : (pn < 12 ? 1 : (pn < 16 ? 2 : 3)); u.aux = 0; u.rows = nullptr; u.nvalid = 256;
        u.a = A + (size_t)pm * 256 * rowb; u.b = Bt + (size_t)pl * 256 * rowb; return true; }
};
__device__ __forceinline__ void rope8(f32x4& v0, f32x4& v1, const f32x4 c0, const f32x4 c1) {
    const f32x4 a = v0, b = v1;
    v0[0] = a[0] * c0[0] - a[1] * c0[1]; v0[1] = a[1] * c0[0] + a[0] * c0[1]; v0[2] = a[2] * c0[2] - a[3] * c0[3]; v0[3] = a[3] * c0[2] + a[2] * c0[3];
    v1[0] = b[0] * c1[0] - b[1] * c1[1]; v1[1] = b[1] * c1[0] + b[0] * c1[1]; v1[2] = b[2] * c1[2] - b[3] * c1[3]; v1[3] = b[3] * c1[2] + b[2] * c1[3];
}
__device__ __forceinline__ u32x4 pack8(const f32x4 v0, const f32x4 v1) { u32x4 w; w.x = cvt_pk_bf16(v0[0], v0[1]); w.y = cvt_pk_bf16(v0[2], v0[3]); w.z = cvt_pk_bf16(v1[0], v1[1]); w.w = cvt_pk_bf16(v1[2], v1[3]); return w; }
template <int KMASK  > struct EpiInT {
    static constexpr bool PERM = true, TWICE = (EXP_EPI_IN2 != 0), B64 = false, PREF = false;
    bf16_t *QA, *KA, *VA; unsigned char *CQ, *CKV; bf16_t* KR; float* SSQ; const float* cs128; const float* cs64;
    __device__ __forceinline__ void operator()(const f32x4 (&acc)[2][2][4][2], const pg8::Unit& u, int wr, int wc, int fr, int fq) const {
        asm volatile("" : "+v"(fr), "+v"(fq));
        int row0 = u.pm * 256 + wr * 64 + fr, cl = wc * 32 + 8 * fq;
        if ((KMASK & 1) && u.kind == 0) {
            bf16_t* dst = (u.pn < 4 ? QA : KA) + (u.pn & 3) * 256 + cl;
#pragma unroll
            for (int ai = 0; ai < 2; ++ai) {
                f32x4 c0[4], c1[4];
#pragma unroll
                for (int m = 0; m < 4; ++m) { const int row = row0 + ai * 128 + m * 16; const float* cp = cs128 + ((size_t)(row & 2047) * 64 + (cl >> 1)) * 2; c0[m] = *(const f32x4*)cp; c1[m] = *(const f32x4*)(cp + 4); }
                asm volatile("" : "+v"(c0[0]), "+v"(c0[1]), "+v"(c0[2]), "+v"(c0[3]), "+v"(c1[0]), "+v"(c1[1]), "+v"(c1[2]), "+v"(c1[3]));
#pragma unroll
                for (int m = 0; m < 4; ++m) { const int row = row0 + ai * 128 + m * 16;
#pragma unroll
                    for (int bj = 0; bj < 2; ++bj) { f32x4 v0 = acc[ai][bj][m][0], v1 = acc[ai][bj][m][1]; rope8(v0, v1, c0[m], c1[m]);
                        ST16NT(dst + (size_t)row * 1024 + bj * 128, pack8(v0, v1)); } } }
        } else if ((KMASK & 2) && u.kind == 1) {
            bf16_t* dst = VA + (u.pn - 8) * 256 + cl;
#pragma unroll
            for (int ai = 0; ai < 2; ++ai)
#pragma unroll
                for (int m = 0; m < 4; ++m) { const int row = row0 + ai * 128 + m * 16;
#pragma unroll
                    for (int bj = 0; bj < 2; ++bj) ST16NT(dst + (size_t)row * 1024 + bj * 128, pack8(acc[ai][bj][m][0], acc[ai][bj][m][1])); }
        } else if ((KMASK & 4) && u.kind == 2) {
            const int which = (u.pn - 12) >> 1, half = (u.pn - 12) & 1;
            unsigned char* dst = (which ? CKV : CQ) + half * 256 + cl; float* sq = SSQ + (size_t)which * T * 8 + half * 4 + wc;
#pragma unroll
            for (int ai = 0; ai < 2; ++ai)
#pragma unroll
                for (int m = 0; m < 4; ++m) { const int row = row0 + ai * 128 + m * 16; float s = 0.f;
#pragma unroll
                    for (int bj = 0; bj < 2; ++bj) { const f32x4 v0 = acc[ai][bj][m][0], v1 = acc[ai][bj][m][1];
                        s += (v0[0] * v0[0] + v0[1] * v0[1]) + (v0[2] * v0[2] + v0[3] * v0[3]) + (v1[0] * v1[0] + v1[1] * v1[1]) + (v1[2] * v1[2] + v1[3] * v1[3]);
                        { u32x2 o; o.x = pk4_fp8(v0[0], v0[1], v0[2], v0[3]); o.y = pk4_fp8(v1[0], v1[1], v1[2], v1[3]); *(u32x2*)(dst + (size_t)row * 512 + bj * 128) = o; } }
                    s += __shfl_xor(s, 16); s += __shfl_xor(s, 32);
                    if (fq == 0) sq[(size_t)row * 8] = s; }
        } else if ((KMASK & 8) && u.kind == 3) {
            if (wc < 2) {
#pragma unroll
                for (int ai = 0; ai < 2; ++ai)
#pragma unroll
                    for (int m = 0; m < 4; ++m) { const int row = row0 + ai * 128 + m * 16; const float* cp = cs64 + ((size_t)(row & 2047) * 32 + (cl >> 1)) * 2;
                        const f32x4 c0 = *(const f32x4*)cp, c1 = *(const f32x4*)(cp + 4);
                        f32x4 v0 = acc[ai][0][m][0], v1 = acc[ai][0][m][1]; rope8(v0, v1, c0, c1);
                        ST16NT(KR + (size_t)row * 64 + cl, pack8(v0, v1)); }
            }
        }
    }
};

__device__ __forceinline__ void p2_kr(Frame& F, const unsigned char* __restrict__ H1F8, const unsigned char* __restrict__ Wkr8  , const float* __restrict__ cs64, bf16_t* __restrict__ KR) {
    for (int blk = F.vcu; blk < 256; blk += F.G) {
        const int fr = F.lane & 15, fq = F.lane >> 4; f32x4 acc[4][4];
#pragma unroll
        for (int mi = 0; mi < 4; ++mi)
#pragma unroll
            for (int ni = 0; ni < 4; ++ni) acc[mi][ni] = (f32x4){0.f, 0.f, 0.f, 0.f};
#pragma unroll
        for (int ks = 0; ks < 2; ++ks) { const int k = F.wave * 256 + ks * 128 + fq * 32; pg8::v8i a[4], bh[4];
#pragma unroll
            for (int mi = 0; mi < 4; ++mi) a[mi] = *(const pg8::v8i*)(H1F8 + (size_t)(blk * 64 + mi * 16 + fr) * D + k);
#pragma unroll
            for (int ni = 0; ni < 4; ++ni) bh[ni] = *(const pg8::v8i*)(Wkr8 + (size_t)(ni * 16 + fr) * D + k);
#pragma unroll
            for (int mi = 0; mi < 4; ++mi)
#pragma unroll
                for (int ni = 0; ni < 4; ++ni) acc[mi][ni] = __builtin_amdgcn_mfma_scale_f32_16x16x128_f8f6f4(a[mi], bh[ni], acc[mi][ni], 0, 0, 0, 0x7f7f7f7f, 0, 0x79797979); }
        LAS float* red = (LAS float*)(F.lds + RING_OFF) + F.wave * 4096;
#pragma unroll
        for (int mi = 0; mi < 4; ++mi)
#pragma unroll
            for (int ni = 0; ni < 4; ++ni)
#pragma unroll
                for (int r = 0; r < 4; ++r) red[(mi * 16 + 4 * fq + r) * 64 + ni * 16 + fr] = acc[mi][ni][r];
        __syncthreads();
#pragma unroll
        for (int q = 0; q < 4; ++q) { const int idx = F.tid + q * NTHR, row = idx >> 5, i = idx & 31; float x1 = 0.f, x2 = 0.f;
#pragma unroll
            for (int w = 0; w < 8; ++w) { x1 += ((LAS float*)(F.lds + RING_OFF))[w * 4096 + row * 64 + 2 * i]; x2 += ((LAS float*)(F.lds + RING_OFF))[w * 4096 + row * 64 + 2 * i + 1]; }
            const int t = blk * 64 + row; const float cs = cs64[((size_t)(t & 2047) * 32 + i) * 2], sn = cs64[((size_t)(t & 2047) * 32 + i) * 2 + 1];
            *(unsigned*)(KR + (size_t)t * 64 + 2 * i) = cvt_pk_bf16(x1 * cs - x2 * sn, x2 * cs + x1 * sn); }
        __syncthreads();
    }
}
__device__ __forceinline__ void p1_h1_kr(Frame& F, const float* __restrict__ x, const float* __restrict__ mod, unsigned char* __restrict__ H1F8, const unsigned char* __restrict__ Wkr8, const float* __restrict__ cs64, bf16_t* __restrict__ KR) {
    LAS unsigned char* img = F.lds + RING_OFF; const int blk = F.vcu;
#pragma unroll 1
    for (int i = 0; i < 8; i += 2) {
        f32x4 v[2][8];
#pragma unroll
        for (int p = 0; p < 2; ++p) { const int t = blk * 64 + F.wave * 8 + i + p; const GAS f32x4* xr = (const GAS f32x4*)(x + (size_t)t * D) + F.lane;
#pragma unroll
            for (int j = 0; j < 8; ++j) v[p][j] = __builtin_nontemporal_load((const f32x4*)(xr + 64 * j)); }
#pragma unroll
        for (int p = 0; p < 2; ++p) { const int r = F.wave * 8 + i + p, t = blk * 64 + r, b = t >> 11; const float* m = mod + b * 12288;
            GAS unsigned* o8 = (GAS unsigned*)(H1F8 + (size_t)t * D) + F.lane; LAS unsigned char* irow = img + r * 2048 + ((F.lane & 7) << 2);
#pragma unroll
            for (int j = 0; j < 8; ++j) { const f32x4 sh = *(const f32x4*)(m + 256 * j + 4 * F.lane), sc = *(const f32x4*)(m + 2048 + 256 * j + 4 * F.lane);
                const f32x4 h = v[p][j] * (sc + 1.f) + sh; const unsigned pk = pk4_fp8(h[0], h[1], h[2], h[3]); o8[64 * j] = pk;
                *(LAS unsigned*)(irow + (((8 * j + (F.lane >> 3)) ^ (r & 15)) << 5)) = pk; } }
    }
    __syncthreads();
    {
        const int fr = F.lane & 15, fq = F.lane >> 4; f32x4 acc[4][4];
#pragma unroll
        for (int mi = 0; mi < 4; ++mi)
#pragma unroll
            for (int ni = 0; ni < 4; ++ni) acc[mi][ni] = (f32x4){0.f, 0.f, 0.f, 0.f};
#pragma unroll
        for (int ks = 0; ks < 2; ++ks) { const int k = F.wave * 256 + ks * 128 + fq * 32, ch = F.wave * 8 + ks * 4 + fq; pg8::v8i a[4], bh[4];
#pragma unroll
            for (int mi = 0; mi < 4; ++mi) { const LAS unsigned char* ap = img + (mi * 16 + fr) * 2048 + ((ch ^ fr) << 5); a[mi] = __builtin_shufflevector(*(const LAS pg8::v4i*)ap, *(const LAS pg8::v4i*)(ap + 16), 0, 1, 2, 3, 4, 5, 6, 7); }
#pragma unroll
            for (int ni = 0; ni < 4; ++ni) bh[ni] = *(const pg8::v8i*)(Wkr8 + (size_t)(ni * 16 + fr) * D + k);
#pragma unroll
            for (int mi = 0; mi < 4; ++mi)
#pragma unroll
                for (int ni = 0; ni < 4; ++ni) acc[mi][ni] = __builtin_amdgcn_mfma_scale_f32_16x16x128_f8f6f4(a[mi], bh[ni], acc[mi][ni], 0, 0, 0, 0x7f7f7f7f, 0, 0x79797979); }
        __syncthreads();
        LAS float* red = (LAS float*)(F.lds + RING_OFF) + F.wave * 4096;
#pragma unroll
        for (int mi = 0; mi < 4; ++mi)
#pragma unroll
            for (int ni = 0; ni < 4; ++ni)
#pragma unroll
                for (int r = 0; r < 4; ++r) red[(mi * 16 + 4 * fq + r) * 64 + ni * 16 + fr] = acc[mi][ni][r];
        __syncthreads();
#pragma unroll
        for (int q = 0; q < 4; ++q) { const int idx = F.tid + q * NTHR, row = idx >> 5, i = idx & 31; float x1 = 0.f, x2 = 0.f;
#pragma unroll
            for (int w = 0; w < 8; ++w) { x1 += ((LAS float*)(F.lds + RING_OFF))[w * 4096 + row * 64 + 2 * i]; x2 += ((LAS float*)(F.lds + RING_OFF))[w * 4096 + row * 64 + 2 * i + 1]; }
            const int t = blk * 64 + row; const float cs = cs64[((size_t)(t & 2047) * 32 + i) * 2], sn = cs64[((size_t)(t & 2047) * 32 + i) * 2 + 1];
            *(unsigned*)(KR + (size_t)t * 64 + 2 * i) = cvt_pk_bf16(x1 * cs - x2 * sn, x2 * cs + x1 * sn); }
        __syncthreads();
    }
}
__device__ __forceinline__ void p3_kmean(Frame& F, const bf16_t* __restrict__ KA, float* __restrict__ KMEAN, int first, int stride) {
    LAS float* red = (LAS float*)(F.lds + RING_OFF);
    const int rg = F.tid >> 4, c8 = (F.tid & 15) * 8;
    for (int item = first; item < 512; item += stride) { const int h = item & 7, blk = (item >> 3) & 7, b = item >> 6;
        float a[8];
#pragma unroll
        for (int j = 0; j < 8; ++j) a[j] = 0.f;
        for (int r = rg; r < 256; r += 32) { const u32x4 w = __builtin_nontemporal_load((const u32x4*)(KA + (size_t)(b * 2048 + blk * 256 + r) * 1024 + h * 128 + c8));
            a[0] += bf2f(w.x & 0xffffu); a[1] += bf2f(w.x >> 16); a[2] += bf2f(w.y & 0xffffu); a[3] += bf2f(w.y >> 16); a[4] += bf2f(w.z & 0xffffu); a[5] += bf2f(w.z >> 16); a[6] += bf2f(w.w & 0xffffu); a[7] += bf2f(w.w >> 16); }
#pragma unroll
        for (int j = 0; j < 8; ++j) red[rg * 128 + c8 + j] = a[j];
        __syncthreads();
        if (F.tid < 128) { float s = 0.f; for (int g = 0; g < 32; ++g) s += red[g * 128 + F.tid]; KMEAN[((b * 8 + h) * 8 + blk) * 128 + F.tid] = s * (1.f / 256.f); }
        __syncthreads();
    }
}
struct SchedMla {
    TileOrder o; const char *CQ, *CKV, *WuqT, *WukvT;
    __device__ __forceinline__ bool next(int i, pg8::Unit& u) const { int pm, pn; if (!o.get(i, pm, pn)) return false;
        u.pm = pm; u.pn = pn; u.rows = nullptr; u.nvalid = 256; u.aux = 0;
        if (pn < 6) { u.kind = pn < 4 ? 0 : 1; u.a = CQ + (size_t)pm * 256 * 512; u.b = WuqT + (size_t)pn * 256 * 512; }
        else { u.kind = 2; u.a = CKV + (size_t)pm * 256 * 512; u.b = WukvT + (size_t)(pn - 6) * 256 * 512; }
        return true; }
};
struct EpiMla {
    static constexpr bool PERM = true, TWICE = (EXP_EPI_MLA2 != 0), B64 = false, PREF = false;
    bf16_t *QMN, *QMR, *KN, *VM; const float* SSQ; const float* cs64;
    __device__ __forceinline__ void operator()(const f32x4 (&acc)[2][2][4][2], const pg8::Unit& u, int wr, int wc, int fr, int fq) const {
        asm volatile("" : "+v"(fr), "+v"(fq));
        int row0 = u.pm * 256 + wr * 64 + fr, cl = wc * 32 + 8 * fq;
        const float* sq = SSQ + (u.kind == 2 ? (size_t)T * 8 : 0);
#pragma unroll
        for (int ai = 0; ai < 2; ++ai) {
            f32x4 p0[4], p1[4], c0[4], c1[4];
#pragma unroll
            for (int m = 0; m < 4; ++m) { const int row = row0 + ai * 128 + m * 16; p0[m] = *(const f32x4*)(sq + (size_t)row * 8); p1[m] = *(const f32x4*)(sq + (size_t)row * 8 + 4);
                if (u.kind == 1) { const float* cp = cs64 + ((size_t)(row & 2047) * 32 + ((cl & 63) >> 1)) * 2; c0[m] = *(const f32x4*)cp; c1[m] = *(const f32x4*)(cp + 4); } else { c0[m] = p0[m]; c1[m] = p1[m]; } }
            asm volatile("" : "+v"(p0[0]), "+v"(p0[1]), "+v"(p0[2]), "+v"(p0[3]), "+v"(p1[0]), "+v"(p1[1]), "+v"(p1[2]), "+v"(p1[3]));
            asm volatile("" : "+v"(c0[0]), "+v"(c0[1]), "+v"(c0[2]), "+v"(c0[3]), "+v"(c1[0]), "+v"(c1[1]), "+v"(c1[2]), "+v"(c1[3]));
#pragma unroll
            for (int m = 0; m < 4; ++m) { const int row = row0 + ai * 128 + m * 16;
                const float rs = 1.f / sqrtf((((p0[m][0] + p0[m][1]) + (p0[m][2] + p0[m][3])) + ((p1[m][0] + p1[m][1]) + (p1[m][2] + p1[m][3]))) * (1.f / 512.f) + 1e-6f);
                if (u.kind == 0) {
#pragma unroll
                    for (int bj = 0; bj < 2; ++bj) ST16NT(QMN + (size_t)row * 1024 + u.pn * 256 + bj * 128 + cl, pack8(acc[ai][bj][m][0] * rs, acc[ai][bj][m][1] * rs));
                } else if (u.kind == 1) {
#pragma unroll
                    for (int bj = 0; bj < 2; ++bj) { f32x4 v0 = acc[ai][bj][m][0] * rs, v1 = acc[ai][bj][m][1] * rs; rope8(v0, v1, c0[m], c1[m]);
                        ST16NT(QMR + (size_t)row * 512 + (u.pn - 4) * 256 + bj * 128 + cl, pack8(v0, v1)); }
                } else {
                    ST16NT(KN + (size_t)row * 1024 + (u.pn - 6) * 128 + cl, pack8(acc[ai][0][m][0] * rs, acc[ai][0][m][1] * rs));
                    ST16NT(VM + (size_t)row * 1024 + (u.pn - 6) * 128 + cl, pack8(acc[ai][1][m][0] * rs, acc[ai][1][m][1] * rs));
                } } }
    }
};
#ifndef MK_ATT_NT
#define MK_ATT_NT 0
#endif
namespace att {
#ifndef EXP_EARLY_WAIT
#define EXP_EARLY_WAIT 0
#endif
constexpr int NW = 8, QBLK = 32, KVBLK = 64, QB = NW * QBLK;
constexpr int SHM_V = KVBLK * 128 * 2, SHM_K = KVBLK * 128 * 2, SHM_KR = KVBLK * 64 * 2;
constexpr int OFF_V = 0, OFF_K = 2 * SHM_V, OFF_KR = OFF_K + 2 * SHM_K, OFF_WS = OFF_KR + 2 * SHM_KR, OFF_QR = OFF_WS + NW * 64 * 4, ATT_LDS = OFF_QR + NW * 4096;
constexpr float THR = 8.f;

#define KSWZ(row, colB) ((row) * 256 + ((colB) ^ (((row) & 7) << 4)))
#define KRSWZ(row, colB) ((row) * 128 + ((colB) ^ (((row) & 7) << 4)))
#define SBAR() __builtin_amdgcn_sched_barrier(0)
__device__ __forceinline__ int v_st(int k, int c) { const int kk = (k & ~0xC) | ((k & 4) << 1) | ((k & 8) >> 1); return ((kk >> 3) * 4 + (c >> 5)) * 512 + ((kk & 7) * 32 + (c & 31)) * 2; }
__device__ __forceinline__ int v_rd_base(int lane) { return ((lane & 3) << 3) | (((lane >> 2) & 3) << 6) | (((lane >> 4) & 1) << 5) | (((lane >> 5) & 1) << 8); }
constexpr int v_rd_off(int d0, int ks, int half) { return d0 * 512 + ks * 4096 + half * 2048; }
__device__ __forceinline__ int crow(int r, int hi) { return (r & 3) + 8 * (r >> 2) + 4 * hi; }
__device__ __forceinline__ bf16x8 load8(const bf16_t* p) { return *reinterpret_cast<const bf16x8*>(p); }

__device__ __forceinline__ void mask_tile(f32x16& p0, f32x16& p1, int dq) {
    const float NEG = -__builtin_inff();
#pragma unroll
    for (int r = 0; r < 16; ++r) {
        const int c = (r & 3) + 8 * (r >> 2);
        if (dq - c < 0) p0[r] = NEG;
        if (dq - c - 32 < 0) p1[r] = NEG;
    }
}
template <bool MLA>
__device__ __forceinline__ void partialSM(f32x16& p0, f32x16& p1, float& m_reg, float& mn, float& alpha, bool keep) {
    constexpr float SCALE = MLA ? 0.07216878364870323f : 0.08838834764831845f;
    float pmax = p0[0]; for (int r = 1; r < 16; ++r) pmax = fmaxf(pmax, p0[r]); for (int r = 0; r < 16; ++r) pmax = fmaxf(pmax, p1[r]);
    if (!MLA) { if (!keep) pmax = -__builtin_inff(); }
    { auto rr = __builtin_amdgcn_permlane32_swap(__float_as_uint(pmax), __float_as_uint(pmax), false, false);
      pmax = fmaxf(__uint_as_float(rr[0]), __uint_as_float(rr[1])); }
    constexpr float C2 = 1.4426950408889634f * SCALE;
    if (__builtin_expect(__all((pmax - m_reg) * SCALE <= THR), 1)) { mn = m_reg; alpha = 1.f; }
    else { mn = fmaxf(m_reg, pmax); alpha = __builtin_amdgcn_exp2f((m_reg - mn) * C2); m_reg = mn; }
    float mnL = -mn * C2;
    if (!MLA) { if (!keep) mnL = -__builtin_inff(); }
    for (int r = 0; r < 16; ++r) p0[r] = fmaf(p0[r], C2, mnL); for (int r = 0; r < 16; ++r) p1[r] = fmaf(p1[r], C2, mnL);
    for (int r = 0; r < 16; ++r) p0[r] = __builtin_amdgcn_exp2f(p0[r]);
}
__device__ __forceinline__ void finishSM(f32x16& p0, f32x16& p1, float alpha, float& l_reg, bf16x8& pa0, bf16x8& pa1, bf16x8& pa2, bf16x8& pa3) {
    for (int r = 0; r < 16; ++r) p1[r] = __builtin_amdgcn_exp2f(p1[r]);
    float ps = 0; for (int r = 0; r < 16; ++r) ps += p0[r]; for (int r = 0; r < 16; ++r) ps += p1[r];
    { auto rr = __builtin_amdgcn_permlane32_swap(__float_as_uint(ps), __float_as_uint(ps), false, false);
      ps = __uint_as_float(rr[0]) + __uint_as_float(rr[1]); }
    l_reg = l_reg * alpha + ps;
#define PK4(P, B_, OUT) do { unsigned a0 = cvt_pk_bf16(P[B_+0], P[B_+1]), a1 = cvt_pk_bf16(P[B_+2], P[B_+3]);                          \
        unsigned b0 = cvt_pk_bf16(P[B_+4], P[B_+5]), b1 = cvt_pk_bf16(P[B_+6], P[B_+7]);                                             \
        auto r0 = __builtin_amdgcn_permlane32_swap(a0, b0, false, false); auto r1 = __builtin_amdgcn_permlane32_swap(a1, b1, false, false); \
        u32x4 w = {r0[0], r1[0], r0[1], r1[1]}; OUT = *reinterpret_cast<bf16x8*>(&w); } while (0)
    PK4(p0, 0, pa0); PK4(p0, 8, pa1); PK4(p1, 0, pa2); PK4(p1, 8, pa3);
#undef PK4
}
template <int KB, bool MLA>
__device__ __forceinline__ void qkt(f32x16& p0, f32x16& p1, const char* lds, int r32, int hi, const bf16x8* qr, const char* qr2l) {
    p0 = f32x16{}; p1 = f32x16{};
    const char* kb[4];
#pragma unroll
    for (int dd = 0; dd < 4; ++dd) kb[dd] = lds + OFF_K + KB * SHM_K + KSWZ(r32, (dd * 16 + hi * 8) * 2);
#pragma unroll
    for (int d0 = 0; d0 < 8; ++d0) { const char* a = kb[d0 & 3] + (d0 >> 2) * 128;
        bf16x8 b0 = *reinterpret_cast<const bf16x8*>(a);
        bf16x8 b1 = *reinterpret_cast<const bf16x8*>(a + 32 * 256);
        p0 = __builtin_amdgcn_mfma_f32_32x32x16_bf16(b0, qr[d0], p0, 0, 0, 0);
        p1 = __builtin_amdgcn_mfma_f32_32x32x16_bf16(b1, qr[d0], p1, 0, 0, 0); }
    if constexpr (MLA) {
#pragma unroll
        for (int d0 = 0; d0 < 4; ++d0) { const char* a = lds + OFF_KR + KB * SHM_KR + KRSWZ(r32, (d0 * 16 + hi * 8) * 2);
            bf16x8 b0 = *reinterpret_cast<const bf16x8*>(a);
            bf16x8 b1 = *reinterpret_cast<const bf16x8*>(a + 32 * 128);
            const bf16x8 q2 = *reinterpret_cast<const bf16x8*>(qr2l + KRSWZ(r32, (d0 * 16 + hi * 8) * 2));
            p0 = __builtin_amdgcn_mfma_f32_32x32x16_bf16(b0, q2, p0, 0, 0, 0);
            p1 = __builtin_amdgcn_mfma_f32_32x32x16_bf16(b1, q2, p1, 0, 0, 0); }
    }
}
template <int VB>
__device__ __forceinline__ void pv_tile(f32x16* o, int vb0, bf16x8 pa0, bf16x8 pa1, bf16x8 pa2, bf16x8 pa3) {
#define TRRD(dst, off) asm volatile("ds_read_b64_tr_b16 %0, %1 offset:%2" : "=&v"(dst) : "v"(vb0), "i"(off) : "memory")
#define PV_D0(d0) do { s16x4 l0, l1, l2, l3, h0, h1, h2, h3; constexpr int b_ = OFF_V + VB * SHM_V + v_rd_off(d0, 0, 0);   \
        TRRD(l0, b_); TRRD(h0, b_ + 2048); TRRD(l1, b_ + 4096); TRRD(h1, b_ + 6144); TRRD(l2, b_ + 8192); TRRD(h2, b_ + 10240); TRRD(l3, b_ + 12288); TRRD(h3, b_ + 14336); \
        asm volatile("s_waitcnt lgkmcnt(0)" ::: "memory"); SBAR();   \
        o[d0] = __builtin_amdgcn_mfma_f32_32x32x16_bf16(pa0, (bf16x8){l0[0], l0[1], l0[2], l0[3], h0[0], h0[1], h0[2], h0[3]}, o[d0], 0, 0, 0);   \
        o[d0] = __builtin_amdgcn_mfma_f32_32x32x16_bf16(pa1, (bf16x8){l1[0], l1[1], l1[2], l1[3], h1[0], h1[1], h1[2], h1[3]}, o[d0], 0, 0, 0);   \
        o[d0] = __builtin_amdgcn_mfma_f32_32x32x16_bf16(pa2, (bf16x8){l2[0], l2[1], l2[2], l2[3], h2[0], h2[1], h2[2], h2[3]}, o[d0], 0, 0, 0);   \
        o[d0] = __builtin_amdgcn_mfma_f32_32x32x16_bf16(pa3, (bf16x8){l3[0], l3[1], l3[2], l3[3], h3[0], h3[1], h3[2], h3[3]}, o[d0], 0, 0, 0); } while (0)
    PV_D0(0); PV_D0(1); PV_D0(2); PV_D0(3);
#undef PV_D0
#undef TRRD
}
struct BlockRef { const bf16_t* Q; const bf16_t* Qr; const bf16_t* K; const bf16_t* Kr; const bf16_t* V; unsigned char* O; const float* kmean; int P0; };
template <bool MLA> struct Seam { bf16x8 qr[8]; bf16x8 st_v0, st_v1, st_k0, st_k1; };

#define ROWK(p, k0, rr) ((p) + (size_t)((k0) + (rr)) * 1024 + sc)
#define VMW() asm volatile("s_waitcnt vmcnt(0)" ::: "memory")
#define VMWN(n) asm volatile("s_waitcnt vmcnt(%0)" :: "i"(n) : "memory")
#define SLOAD_H(Kp, Krp, Vp, k0, bf) do { S.st_v0 = load8(ROWK(Vp, k0, sr)); S.st_v1 = load8(ROWK(Vp, k0, 32 + sr));              \
                           \
                         __builtin_amdgcn_global_load_lds((const unsigned*)((Kp) + (size_t)(k0) * 1024 + kd0), (LAS unsigned*)(ldsl + OFF_K + (bf) * SHM_K + wid * 1024), 16, 0, 0);          \
                         __builtin_amdgcn_global_load_lds((const unsigned*)((Kp) + (size_t)(k0) * 1024 + kd1), (LAS unsigned*)(ldsl + OFF_K + (bf) * SHM_K + 8192 + wid * 1024), 16, 0, 0);   \
                         if constexpr (MLA) __builtin_amdgcn_global_load_lds((const unsigned*)((Krp) + (size_t)(k0) * 64 + kdr), (LAS unsigned*)(ldsl + OFF_KR + (bf) * SHM_KR + wid * 1024), 16, 0, 0); } while (0)
#define SWRITE_HK(bf) do { } while (0)
#define SWRITE_HV(bf) do { *(bf16x8*)(lds + OFF_V + (bf) * SHM_V + vst0) = S.st_v0; *(bf16x8*)(lds + OFF_V + (bf) * SHM_V + vst1) = S.st_v1; } while (0)
#define SWRITE_H(bf) do { SWRITE_HV(bf); SWRITE_HK(bf); } while (0)
#define QLOAD(ref) do { _Pragma("unroll") for (int d0 = 0; d0 < 8; ++d0) S.qr[d0] = MK_ATT_NT ? __builtin_nontemporal_load(reinterpret_cast<const bf16x8*>((ref).Q + (size_t)(wid * QBLK + r32) * 1024 + d0 * 16 + hi * 8)) : load8((ref).Q + (size_t)(wid * QBLK + r32) * 1024 + d0 * 16 + hi * 8); } while (0)

template <bool MLA>
__device__ __forceinline__ void prime(const BlockRef& cur, char* lds, LAS char* ldsl, Seam<MLA>& S) {
    const int tid = threadIdx.x, wid = __builtin_amdgcn_readfirstlane(tid >> 6), lane = tid & 63, r32 = lane & 31, hi = lane >> 5;
    const int sr = tid >> 4, sc = (tid & 15) * 8, kws = KSWZ(sr, sc * 2);
    int kd0, kd1, kdr; { const int g0 = wid * 64 + lane, r0 = g0 >> 4, p0 = g0 & 15; kd0 = r0 * 1024 + ((p0 ^ (r0 & 7)) << 3); const int g1 = 512 + g0, r1 = g1 >> 4, p1 = g1 & 15; kd1 = r1 * 1024 + ((p1 ^ (r1 & 7)) << 3);
        const int rr = g0 >> 3, pr = g0 & 7; kdr = rr * 64 + ((pr ^ (rr & 7)) << 3); }
    QLOAD(cur);
    S.st_v0 = load8(ROWK(cur.V, 0, sr)); S.st_v1 = load8(ROWK(cur.V, 0, 32 + sr));
    __builtin_amdgcn_global_load_lds((const unsigned*)(cur.K + kd0), (LAS unsigned*)(ldsl + OFF_K + wid * 1024), 16, 0, 0);
    __builtin_amdgcn_global_load_lds((const unsigned*)(cur.K + kd1), (LAS unsigned*)(ldsl + OFF_K + 8192 + wid * 1024), 16, 0, 0);
    if constexpr (MLA) __builtin_amdgcn_global_load_lds((const unsigned*)(cur.Kr + kdr), (LAS unsigned*)(ldsl + OFF_KR + wid * 1024), 16, 0, 0);
    VMW(); (void)kws;
    __syncthreads();
}
template <bool MLA>
__device__ __forceinline__ void block(const BlockRef& cur, const BlockRef& nxt, char* lds, LAS char* ldsl, Seam<MLA>& S) {
    const int tid = threadIdx.x, wid = __builtin_amdgcn_readfirstlane(tid >> 6), lane = tid & 63, r32 = lane & 31, hi = lane >> 5;
    const int NT = (cur.P0 + QB) / KVBLK;
    const int qlo = cur.P0 + wid * QBLK, qm = qlo + r32 - 4 * hi;
    float* ws = (float*)(lds + OFF_WS) + wid * 64; float* li_l = ws, * al_l = ws + 32;
    float m_reg = -1e30f, l_reg = 0; f32x16 o[4] = {};
    const int vb0 = (int)(uintptr_t)lds + v_rd_base(lane);
    const bf16_t* Kh = cur.K; const bf16_t* Krh = cur.Kr; const bf16_t* Vh = cur.V;
    const char* qr2l = lds + OFF_QR + wid * 4096;
    if constexpr (MLA) {
        bf16x8 tq[4];
#pragma unroll
        for (int d0 = 0; d0 < 4; ++d0) tq[d0] = load8(cur.Qr + (size_t)(wid * QBLK + r32) * 512 + d0 * 16 + hi * 8);
#pragma unroll
        for (int d0 = 0; d0 < 4; ++d0) *(bf16x8*)(lds + OFF_QR + wid * 4096 + KRSWZ(r32, (d0 * 16 + hi * 8) * 2)) = tq[d0];
        asm volatile("s_waitcnt lgkmcnt(0)" ::: "memory");
    }
#define OPQ_TID() ({ int t_ = threadIdx.x; asm volatile("" : "+v"(t_)); t_; })
#define SLOAD_P(Kp, Krp, Vp, k0, bf) do { const int t_ = OPQ_TID(), w_ = t_ >> 6, l_ = t_ & 63, g0_ = w_ * 64 + l_, r0_ = g0_ >> 4, p0_ = g0_ & 15, g1_ = 512 + g0_, r1_ = g1_ >> 4, p1_ = g1_ & 15; \
        const int kd0 = r0_ * 1024 + ((p0_ ^ (r0_ & 7)) << 3), kd1 = r1_ * 1024 + ((p1_ ^ (r1_ & 7)) << 3), kdr = 0; const int sr = t_ >> 4, sc = (t_ & 15) * 8; (void)kdr; SLOAD_H(Kp, Krp, Vp, k0, bf); } while (0)
#define SWRITE_PV(bf) do { const int t_ = OPQ_TID(), sr_ = t_ >> 4, sc_ = (t_ & 15) * 8; const int vst0 = v_st(sr_, sc_), vst1 = v_st(32 + sr_, sc_); SWRITE_HV(bf); } while (0)
    unsigned selm = 0u; const int own = cur.P0 >> 8;
    if constexpr (!MLA) {
        if (own > 0) {
            f32x16 g = {};
#pragma unroll
            for (int d0 = 0; d0 < 8; ++d0) { bf16x8 ah = {0, 0, 0, 0, 0, 0, 0, 0}, al = {0, 0, 0, 0, 0, 0, 0, 0};
                if (r32 < 8) { const float* kp = cur.kmean + r32 * 128 + d0 * 16 + hi * 8; const f32x4 x0 = *(const f32x4*)kp, x1 = *(const f32x4*)(kp + 4);
                    unsigned hh[4], ll[4];
#pragma unroll
                    for (int j = 0; j < 2; ++j) { const float a0 = x0[2 * j], a1 = x0[2 * j + 1], b0 = x1[2 * j], b1 = x1[2 * j + 1];
                        const unsigned ha0 = f2bf(a0), ha1 = f2bf(a1), hb0 = f2bf(b0), hb1 = f2bf(b1);
                        hh[j] = ha0 | (ha1 << 16); hh[2 + j] = hb0 | (hb1 << 16);
                        ll[j] = f2bf(a0 - bf2f(ha0)) | (f2bf(a1 - bf2f(ha1)) << 16); ll[2 + j] = f2bf(b0 - bf2f(hb0)) | (f2bf(b1 - bf2f(hb1)) << 16); }
                    u32x4 wh = {hh[0], hh[1], hh[2], hh[3]}, wl = {ll[0], ll[1], ll[2], ll[3]}; ah = *reinterpret_cast<bf16x8*>(&wh); al = *reinterpret_cast<bf16x8*>(&wl); }
                g = __builtin_amdgcn_mfma_f32_32x32x16_bf16(ah, S.qr[d0], g, 0, 0, 0);
                g = __builtin_amdgcn_mfma_f32_32x32x16_bf16(al, S.qr[d0], g, 0, 0, 0); }
            float gt[8];
#pragma unroll
            for (int r = 0; r < 4; ++r) { auto rr = __builtin_amdgcn_permlane32_swap(__float_as_uint(g[r]), __float_as_uint(g[r]), false, false); gt[r] = __uint_as_float(rr[0]); gt[r + 4] = __uint_as_float(rr[1]); }
#pragma unroll
            for (int n = 0; n < 8; ++n) { int rank = 0;
#pragma unroll
                for (int j = 0; j < 8; ++j) rank += (j < own && (gt[j] > gt[n] || (gt[j] == gt[n] && j < n))) ? 1 : 0;
                if (n < own && rank < 3) selm |= 1u << n; }
        }
    }
#define RESC(a) do { if (__any((a) < 1.f)) { if (hi == 0) al_l[r32] = (a); asm volatile("s_waitcnt lgkmcnt(0)" ::: "memory");              \
                     for (int d_ = 0; d_ < 4; ++d_) for (int r = 0; r < 16; ++r) o[d_][r] *= al_l[crow(r, hi)]; } } while (0)
#define KBASE(t) ((t) * KVBLK)
#define KEEP(t) (MLA || (KBASE(t) >> 8) >= own || ((selm >> (KBASE(t) >> 8)) & 1u))
#define MASKT(P0_, P1_, t) do { const int kb_ = KBASE(t); if (kb_ + KVBLK - 1 > qlo) mask_tile(P0_, P1_, qm - kb_); } while (0)
    constexpr int NQL = 8;
#define SEAM_K0() do { VMWN(NQL); SWRITE_HK(0); SBAR(); } while (0)
    f32x16 pA0, pA1, pB0, pB1; float mnA, mnB, alA, alB; bf16x8 pa0, pa1, pa2, pa3;
    SWRITE_PV(0); SBAR();
    if (NT > 1) SLOAD_P(Kh, Krh, Vh, KBASE(1), 1);
    SBAR(); qkt<0, MLA>(pA0, pA1, lds, r32, hi, S.qr, qr2l);
    MASKT(pA0, pA1, 0); partialSM<MLA>(pA0, pA1, m_reg, mnA, alA, KEEP(0));
    if (NT > 1) { VMW(); SWRITE_PV(1); }
    __syncthreads();
#define HALF_STEP(PX0, PX1, mnX, alX, PY0, PY1, alY, t, KB, VB, SB) do {                                                      \
        SBAR(); qkt<KB, MLA>(PX0, PX1, lds, r32, hi, S.qr, qr2l);                                                            \
        finishSM(PY0, PY1, alY, l_reg, pa0, pa1, pa2, pa3); SBAR();                                                           \
        if ((t) + 1 < NT) { SLOAD_P(Kh, Krh, Vh, KBASE((t) + 1), SB); SBAR(); }                                                   \
        pv_tile<VB>(o, vb0, pa0, pa1, pa2, pa3); MASKT(PX0, PX1, (t)); partialSM<MLA>(PX0, PX1, m_reg, mnX, alX, KEEP(t));    \
        __syncthreads();                                                                                                      \
        if ((t) + 1 < NT) { VMW(); SWRITE_PV(SB); }                                                                            \
        RESC(alX); __syncthreads(); } while (0)
    for (int t = 1; t + 1 < NT; t += 2) {
        HALF_STEP(pB0, pB1, mnB, alB, pA0, pA1, alA, t, 1, 0, 0);
        HALF_STEP(pA0, pA1, mnA, alA, pB0, pB1, alB, t + 1, 0, 1, 1);
    }
    SBAR(); qkt<1, MLA>(pB0, pB1, lds, r32, hi, S.qr, qr2l); SBAR();
    SLOAD_P(nxt.K, nxt.Kr, nxt.V, 0, 0); SBAR();
    QLOAD(nxt);
    SBAR();
    finishSM(pA0, pA1, alA, l_reg, pa0, pa1, pa2, pa3); SBAR();
    pv_tile<0>(o, vb0, pa0, pa1, pa2, pa3);
    MASKT(pB0, pB1, NT - 1); partialSM<MLA>(pB0, pB1, m_reg, mnB, alB, KEEP(NT - 1)); __syncthreads(); RESC(alB);
    finishSM(pB0, pB1, alB, l_reg, pa0, pa1, pa2, pa3); SBAR(); pv_tile<1>(o, vb0, pa0, pa1, pa2, pa3);
    SBAR(); SEAM_K0();
    if (hi == 0) li_l[r32] = l_reg; asm volatile("s_waitcnt lgkmcnt(0)" ::: "memory");
    float rli[16];
#pragma unroll
    for (int r = 0; r < 16; ++r) rli[r] = __builtin_amdgcn_rcpf(li_l[crow(r, hi)]);
    unsigned char* Ow = cur.O + (size_t)(wid * QBLK) * 2048;
    {
        unsigned char* stg = (unsigned char*)(lds + OFF_QR + wid * 4096);
#pragma unroll
        for (int r = 0; r < 16; ++r) { const int orow = crow(r, hi);
#pragma unroll
            for (int d0 = 0; d0 < 4; ++d0) { const float v = o[d0][r] * rli[r];
                stg[orow * 128 + d0 * 32 + r32] = (unsigned char)(__builtin_amdgcn_cvt_pk_fp8_f32(v * 64.f, 0.f, 0u, false) & 0xffu); } }
        asm volatile("s_waitcnt lgkmcnt(0)" ::: "memory");
#pragma unroll
        for (int i = 0; i < 4; ++i) { const u32x4 w = *(const u32x4*)(stg + i * 1024 + lane * 16); if (MK_ATT_NT) __builtin_nontemporal_store(w, (u32x4*)(Ow + (size_t)(i * 8 + (lane >> 3)) * 2048 + (lane & 7) * 16)); else ST16NT(Ow + (size_t)(i * 8 + (lane >> 3)) * 2048 + (lane & 7) * 16, w); }
    }
    if constexpr (MLA) VMW();
    __syncthreads();
#undef RESC
#undef KBASE
#undef KEEP
#undef MASKT
#undef SEAM_K0
#undef HALF_STEP
#undef SLOAD_P
#undef SWRITE_PV
#undef OPQ_TID
}
template <bool MLA>
__device__ __forceinline__ void block_np(const BlockRef& cur, const BlockRef& nxt, char* lds, LAS char* ldsl, Seam<MLA>& S) {
    const int tid = threadIdx.x, wid = __builtin_amdgcn_readfirstlane(tid >> 6), lane = tid & 63, r32 = lane & 31, hi = lane >> 5;
    const int NT = (cur.P0 + QB) / KVBLK;
    const int qlo = cur.P0 + wid * QBLK, qm = qlo + r32 - 4 * hi;
    float* ws = (float*)(lds + OFF_WS) + wid * 64; float* li_l = ws, * al_l = ws + 32;
    float m_reg = -1e30f, l_reg = 0; f32x16 o[4] = {};
    const int sr = tid >> 4, sc = (tid & 15) * 8, vst0 = v_st(sr, sc), vst1 = v_st(32 + sr, sc), kws = 0; (void)kws;
    int kd0, kd1, kdr; { const int g0 = wid * 64 + lane, r0 = g0 >> 4, p0 = g0 & 15; kd0 = r0 * 1024 + ((p0 ^ (r0 & 7)) << 3); const int g1 = 512 + g0, r1 = g1 >> 4, p1 = g1 & 15; kd1 = r1 * 1024 + ((p1 ^ (r1 & 7)) << 3);
        const int rr = g0 >> 3, pr = g0 & 7; kdr = rr * 64 + ((pr ^ (rr & 7)) << 3); }
    const int vb0 = (int)(uintptr_t)lds + v_rd_base(lane);
    const char* qr2l = lds + OFF_QR + wid * 4096;
#define KV_LOAD(Kp, Krp, Vp, k0, bf) do { S.st_v0 = load8(ROWK(Vp, k0, sr)); S.st_v1 = load8(ROWK(Vp, k0, 32 + sr));                                                                        \
        __builtin_amdgcn_global_load_lds((const unsigned*)((Kp) + (size_t)(k0) * 1024 + kd0), (LAS unsigned*)(ldsl + OFF_K + (bf) * SHM_K + wid * 1024), 16, 0, 0);                       \
        __builtin_amdgcn_global_load_lds((const unsigned*)((Kp) + (size_t)(k0) * 1024 + kd1), (LAS unsigned*)(ldsl + OFF_K + (bf) * SHM_K + 8192 + wid * 1024), 16, 0, 0);                \
        if constexpr (MLA) __builtin_amdgcn_global_load_lds((const unsigned*)((Krp) + (size_t)(k0) * 64 + kdr), (LAS unsigned*)(ldsl + OFF_KR + (bf) * SHM_KR + wid * 1024), 16, 0, 0); } while (0)
    if constexpr (MLA) {
        bf16x8 tq[4];
#pragma unroll
        for (int d0 = 0; d0 < 4; ++d0) tq[d0] = load8(cur.Qr + (size_t)(wid * QBLK + r32) * 512 + d0 * 16 + hi * 8);
#pragma unroll
        for (int d0 = 0; d0 < 4; ++d0) *(bf16x8*)(lds + OFF_QR + wid * 4096 + KRSWZ(r32, (d0 * 16 + hi * 8) * 2)) = tq[d0];
    }
    unsigned selm = 0u; const int own = cur.P0 >> 8;
    if constexpr (!MLA) {
        if (own > 0) {
            f32x16 g = {};
#pragma unroll
            for (int d0 = 0; d0 < 8; ++d0) { bf16x8 ah = {0, 0, 0, 0, 0, 0, 0, 0}, al = {0, 0, 0, 0, 0, 0, 0, 0};
                if (r32 < 8) { const float* kp = cur.kmean + r32 * 128 + d0 * 16 + hi * 8; const f32x4 x0 = *(const f32x4*)kp, x1 = *(const f32x4*)(kp + 4);
                    unsigned hh[4], ll[4];
#pragma unroll
                    for (int j = 0; j < 2; ++j) { const float a0 = x0[2 * j], a1 = x0[2 * j + 1], b0 = x1[2 * j], b1 = x1[2 * j + 1];
                        const unsigned ha0 = f2bf(a0), ha1 = f2bf(a1), hb0 = f2bf(b0), hb1 = f2bf(b1);
                        hh[j] = ha0 | (ha1 << 16); hh[2 + j] = hb0 | (hb1 << 16);
                        ll[j] = f2bf(a0 - bf2f(ha0)) | (f2bf(a1 - bf2f(ha1)) << 16); ll[2 + j] = f2bf(b0 - bf2f(hb0)) | (f2bf(b1 - bf2f(hb1)) << 16); }
                    u32x4 wh = {hh[0], hh[1], hh[2], hh[3]}, wl = {ll[0], ll[1], ll[2], ll[3]}; ah = *reinterpret_cast<bf16x8*>(&wh); al = *reinterpret_cast<bf16x8*>(&wl); }
                g = __builtin_amdgcn_mfma_f32_32x32x16_bf16(ah, S.qr[d0], g, 0, 0, 0);
                g = __builtin_amdgcn_mfma_f32_32x32x16_bf16(al, S.qr[d0], g, 0, 0, 0); }
            float gt[8];
#pragma unroll
            for (int r = 0; r < 4; ++r) { auto rr = __builtin_amdgcn_permlane32_swap(__float_as_uint(g[r]), __float_as_uint(g[r]), false, false); gt[r] = __uint_as_float(rr[0]); gt[r + 4] = __uint_as_float(rr[1]); }
#pragma unroll
            for (int n = 0; n < 8; ++n) { int rank = 0;
#pragma unroll
                for (int j = 0; j < 8; ++j) rank += (j < own && (gt[j] > gt[n] || (gt[j] == gt[n] && j < n))) ? 1 : 0;
                if (n < own && rank < 3) selm |= 1u << n; }
        }
    }
    SWRITE_HV(0);
    asm volatile("s_waitcnt lgkmcnt(0)" ::: "memory");
    __syncthreads();
    f32x16 p0, p1; float mn, al; bf16x8 pa0, pa1, pa2, pa3;
#define RESC(a) do { if (__any((a) < 1.f)) { if (hi == 0) al_l[r32] = (a); asm volatile("s_waitcnt lgkmcnt(0)" ::: "memory");              \
                     for (int d_ = 0; d_ < 4; ++d_) for (int r = 0; r < 16; ++r) o[d_][r] *= al_l[crow(r, hi)]; } } while (0)
#define MSTEP(t, BUF, NB) do {                                                                                               \
        const bool lastt = ((t) + 1 >= NT);                                                                                  \
        { const bf16_t* Kp_ = lastt ? nxt.K : cur.K; const bf16_t* Krp_ = lastt ? nxt.Kr : cur.Kr; const bf16_t* Vp_ = lastt ? nxt.V : cur.V; const int k0_ = lastt ? 0 : ((t) + 1) * KVBLK; \
          KV_LOAD(Kp_, Krp_, Vp_, k0_, NB); }                                                                                  \
        SBAR(); qkt<BUF, MLA>(p0, p1, lds, r32, hi, S.qr, qr2l); SBAR();                                                      \
        if (lastt) { QLOAD(nxt); SBAR(); }                                                                                   \
        { const int kb_ = (t) * KVBLK; if (kb_ + KVBLK - 1 > qlo) mask_tile(p0, p1, qm - kb_); }                              \
        partialSM<MLA>(p0, p1, m_reg, mn, al, MLA || (((t) * KVBLK) >> 8) >= own || ((selm >> (((t) * KVBLK) >> 8)) & 1u)); finishSM(p0, p1, al, l_reg, pa0, pa1, pa2, pa3); RESC(al); SBAR(); \
        if (EXP_EARLY_WAIT) VMW();                                                                                           \
        pv_tile<BUF>(o, vb0, pa0, pa1, pa2, pa3);                                                                            \
        if (!lastt) { VMW(); SWRITE_HV(NB); asm volatile("s_waitcnt lgkmcnt(0)" ::: "memory"); __syncthreads(); } } while (0)
    for (int t = 0; t < NT; t += 2) { MSTEP(t, 0, 1); MSTEP(t + 1, 1, 0); }
#undef MSTEP
#undef KV_LOAD
    if (hi == 0) li_l[r32] = l_reg; asm volatile("s_waitcnt lgkmcnt(0)" ::: "memory");
    float rli[16];
#pragma unroll
    for (int r = 0; r < 16; ++r) rli[r] = __builtin_amdgcn_rcpf(li_l[crow(r, hi)]);
    unsigned char* Ow = cur.O + (size_t)(wid * QBLK) * 2048;
    {
        unsigned char* stg = (unsigned char*)(lds + OFF_QR + wid * 4096);
#pragma unroll
        for (int r = 0; r < 16; ++r) { const int orow = crow(r, hi);
#pragma unroll
            for (int d0 = 0; d0 < 4; ++d0) { const float v = o[d0][r] * rli[r];
                stg[orow * 128 + d0 * 32 + r32] = (unsigned char)(__builtin_amdgcn_cvt_pk_fp8_f32(v * 64.f, 0.f, 0u, false) & 0xffu); } }
        asm volatile("s_waitcnt lgkmcnt(0)" ::: "memory");
#pragma unroll
        for (int i = 0; i < 4; ++i) { const u32x4 w = *(const u32x4*)(stg + i * 1024 + lane * 16); if (MK_ATT_NT) __builtin_nontemporal_store(w, (u32x4*)(Ow + (size_t)(i * 8 + (lane >> 3)) * 2048 + (lane & 7) * 16)); else ST16NT(Ow + (size_t)(i * 8 + (lane >> 3)) * 2048 + (lane & 7) * 16, w); }
    }
    VMW();
    __syncthreads();
#undef RESC
}
#undef ROWK
#undef VMW
#undef VMWN
#undef SLOAD_H
#undef SWRITE_HK
#undef SWRITE_HV
#undef SWRITE_H
#undef QLOAD

#ifndef MK_MLA_PIPE
#define MK_MLA_PIPE 0
#endif
#ifndef MK_ATT_BAL
#define MK_ATT_BAL 0
#endif
struct Tensors { const bf16_t *QA, *KA, *VA, *QMN, *QMR, *KN, *KR, *VM; unsigned char* MIX; const float* KMEAN; };
template <bool MLA>
__device__ __forceinline__ BlockRef make_ref(const Tensors& Tn, int item, int pass) {
    const int bh = item >> 2, y = item & 3, b = bh >> 3, h = bh & 7;
    const int qb = MLA && MK_ATT_BAL ? (pass ? (0x6457 >> (4 * y)) & 7 : (y + 1) & 3) : (pass ? 7 - y : y);
    BlockRef r; const size_t t0 = (size_t)b * 2048, tq = t0 + (size_t)qb * 256;
    if (MLA) { r.Q = Tn.QMN + tq * 1024 + h * 128; r.Qr = Tn.QMR + tq * 512 + h * 64; r.K = Tn.KN + t0 * 1024 + h * 128; r.Kr = Tn.KR + t0 * 64; r.V = Tn.VM + t0 * 1024 + h * 128; r.O = Tn.MIX + tq * 2048 + 1024 + h * 128; r.kmean = nullptr; }
    else { r.Q = Tn.QA + tq * 1024 + h * 128; r.Qr = nullptr; r.K = Tn.KA + t0 * 1024 + h * 128; r.Kr = nullptr; r.V = Tn.VA + t0 * 1024 + h * 128; r.O = Tn.MIX + tq * 2048 + h * 128; r.kmean = Tn.KMEAN + (size_t)bh * 8 * 128; }
    r.P0 = qb * 256; return r;
}
template <bool MLA>
__device__ __forceinline__ void phase(char* lds, LAS char* ldsl, const Tensors& Tn, int vcu, int G, int p_lo = 0, int p_hi = 2, int rev = 0) {
    constexpr int total = 256;
    int L = vcu; if (L >= total) return;
    int pass = p_lo;
    BlockRef cur = make_ref<MLA>(Tn, L, pass ^ rev);
    Seam<MLA> S;
    prime<MLA>(cur, lds, ldsl, S);
    for (;;) {
        const bool more_pass = pass + 1 < p_hi, more_item = L + G < total, last = !more_pass && !more_item;
        int passn = pass + 1, Ln = L;
        if (!more_pass) { passn = p_lo; Ln = more_item ? L + G : L; }
        const BlockRef nxt = last ? cur : make_ref<MLA>(Tn, Ln, passn ^ rev);
        if constexpr (MLA && !MK_MLA_PIPE) block_np<MLA>(cur, nxt, lds, ldsl, S); else block<MLA>(cur, nxt, lds, ldsl, S);
        if (last) break;
        cur = nxt; pass = passn; L = Ln;
    }
}
}
#ifndef MK_WFOLD
#define MK_WFOLD 1
#endif
#ifndef EXP_EPI_DOWN2
#define EXP_EPI_DOWN2 0
#endif
#ifndef EXP_EPI_GU2
#define EXP_EPI_GU2 0
#endif
#ifndef MK_ROUTE_FAST
#define MK_ROUTE_FAST 1
#endif
#if MK_ROUTE_FAST
#define RT_ROUTE rt::route_token_fast
#else
#define RT_ROUTE rt::route_token
#endif
#ifndef EXP_ROUTE_REP
#define EXP_ROUTE_REP 1
#endif
#ifndef MK_RD_NT
#define MK_RD_NT 1
#endif
#ifndef MK_OUT_NT
#define MK_OUT_NT 0
#endif
#ifndef MK_X1_NT
#define MK_X1_NT 0
#endif
struct SchedOut {
    TileOrder o; const char* A; const char* Bt;
    __device__ __forceinline__ bool next(int i, pg8::Unit& u) const { int pm, pn; if (!o.get(i, pm, pn)) return false;
        u.pm = pm; u.pn = pn; u.kind = 0; u.aux = 0; u.rows = nullptr; u.nvalid = 256; u.a = A + (size_t)pm * 256 * 2048; u.b = Bt + (size_t)pn * 256 * 2048; return true; }
};
struct EpiOut {
    static constexpr bool PERM = true, TWICE = false, B64 = false, PREF = false;
    const float* mod; bf16_t* Y;
    __device__ __forceinline__ void operator()(const f32x4 (&acc)[2][2][4][2], const pg8::Unit& u, int wr, int wc, int fr, int fq) const {
        int row0 = u.pm * 256 + wr * 64 + fr, col0 = u.pn * 256 + wc * 32 + 8 * fq;
        const float* g1 = mod + (size_t)(u.pm >> 3) * 12288 + 2 * 2048;
        f32x4 gv[2][2];
#pragma unroll
        for (int bj = 0; bj < 2; ++bj)
#pragma unroll
            for (int n = 0; n < 2; ++n) gv[bj][n] = *(const f32x4*)(g1 + col0 + bj * 128 + n * 4) + 1.f;
#pragma unroll
        for (int ai = 0; ai < 2; ++ai)
#pragma unroll
            for (int m = 0; m < 4; ++m) { const size_t off = (size_t)(row0 + ai * 128 + m * 16) * 2048 + col0;
#pragma unroll
                for (int bj = 0; bj < 2; ++bj) ST16NT(Y + off + bj * 128, pack8(gv[bj][0] * acc[ai][bj][m][0], gv[bj][1] * acc[ai][bj][m][1])); }
    }
};

#ifndef EXP_RT_REP
#define EXP_RT_REP 1
#endif
#ifndef EXP_LN_REP
#define EXP_LN_REP 1
#endif
#ifndef MK_P6_DESYNC
#define MK_P6_DESYNC 0
#endif
__device__ __forceinline__ void p6_ln_route_lds(Frame& F, const float* __restrict__ x, const bf16_t* __restrict__ Y, const float* __restrict__ mod, const float* __restrict__ lg, const float* __restrict__ lb, bf16_t* __restrict__ X1, unsigned char* __restrict__ H2F8,
                                                const bf16_t* __restrict__ WrT, const float* __restrict__ rbias, float* __restrict__ logits, unsigned long long* __restrict__ tokmask, float* __restrict__ tw, int* __restrict__ hist) {
    LAS unsigned char* img = F.lds + RING_OFF;
    LAS float* lgl = (LAS float*)(F.lds + RING_OFF + 65536);
    LAS unsigned long long* lm = (LAS unsigned long long*)(F.lds + LDSCTL_OFF + 2048);
    for (int blk = F.vcu; blk < 256; blk += F.G) {
        const int odd = MK_P6_DESYNC ? (F.vcu & 1) : 0, nch = odd ? 3 : 2;
#pragma unroll 1
        for (int ch = 0; ch < nch; ++ch) {
            int tid_ = F.tid; asm volatile("" : "+v"(tid_));
            const int nrows = odd ? (ch == 1 ? 32 : 16) : 32, row0 = odd ? (ch == 0 ? 0 : ch == 1 ? 16 : 48) : ch * 32, rpw = nrows >> 3; const bool two = nrows > 16;
#pragma unroll 1
            for (int i = 0; i < rpw; ++i) { const int r = F.wave * rpw + i, t = blk * 64 + row0 + r, b = t >> 11; const float* m = mod + b * 12288;
                const GAS f32x4* xr = (const GAS f32x4*)(x + (size_t)t * D) + F.lane; const GAS u32x2* yr = (const GAS u32x2*)(Y + (size_t)t * D) + F.lane; f32x4 v[8]; u32x2 yv[8]; float s = 0.f;
#pragma unroll
                for (int j = 0; j < 8; ++j) { v[j] = MK_RD_NT ? __builtin_nontemporal_load((const f32x4*)(xr + 64 * j)) : xr[64 * j]; yv[j] = MK_RD_NT ? __builtin_nontemporal_load((const u32x2*)(yr + 64 * j)) : yr[64 * j]; }
#pragma unroll
                for (int j = 0; j < 8; ++j) { v[j] = v[j] * ALPHA + (f32x4){bf2f(yv[j].x & 0xffffu), bf2f(yv[j].x >> 16), bf2f(yv[j].y & 0xffffu), bf2f(yv[j].y >> 16)}; s += (v[j][0] + v[j][1]) + (v[j][2] + v[j][3]); }
                const float mean = wave_sum(s) * (1.f / D); float s2 = 0.f;
#pragma unroll
                for (int j = 0; j < 8; ++j) { v[j] = v[j] - mean; s2 += (v[j][0] * v[j][0] + v[j][1] * v[j][1]) + (v[j][2] * v[j][2] + v[j][3] * v[j][3]); }
                const float rstd = 1.f / sqrtf(wave_sum(s2) * (1.f / D) + 1e-5f);
                GAS u32x2* xo = (GAS u32x2*)(X1 + (size_t)t * D) + F.lane; GAS unsigned* h8 = (GAS unsigned*)(H2F8 + (size_t)t * D) + F.lane;
                LAS unsigned char* irow = img + r * 4096 + ((F.lane & 1) << 3);
#pragma unroll
                for (int j = 0; j < 8; ++j) { const int d = 256 * j + 4 * F.lane; const f32x4 o = v[j] * rstd * *(const f32x4*)(lg + d) + *(const f32x4*)(lb + d);
                    u32x2 w1; w1.x = cvt_pk_bf16(o[0], o[1]); w1.y = cvt_pk_bf16(o[2], o[3]); if (MK_X1_NT) __builtin_nontemporal_store(w1, (u32x2*)(xo + 64 * j)); else xo[64 * j] = w1;
                    const f32x4 h = o * (*(const f32x4*)(m + 4 * 2048 + d) + 1.f) + *(const f32x4*)(m + 3 * 2048 + d); u32x2 w; w.x = cvt_pk_bf16(h[0], h[1]); w.y = cvt_pk_bf16(h[2], h[3]);
                    *(LAS u32x2*)(irow + (((32 * j + (F.lane >> 1)) ^ (r & 15)) << 4)) = w; h8[64 * j] = pk4_fp8(h[0], h[1], h[2], h[3]); } }
            { int fr = tid_ & 15, fq = (tid_ >> 4) & 3;
              f32x4 acc[2][4];
#pragma unroll
                for (int mi = 0; mi < 2; ++mi)
#pragma unroll
                    for (int ni = 0; ni < 4; ++ni) acc[mi][ni] = (f32x4){0.f, 0.f, 0.f, 0.f};
                bf16x8 a[2], bq[3][8];
#define RT_LDB(slot_, ks_) do { const int k_ = F.wave * 256 + (ks_) * 32 + fq * 8; _Pragma("unroll") for (int ni = 0; ni < 4; ++ni) { bq[slot_][ni] = *(const bf16x8*)(WrT + (size_t)(ni * 16 + fr) * D + k_); bq[slot_][4 + ni] = *(const bf16x8*)(WrT + (size_t)(64 + ni * 16 + fr) * D + k_); } } while (0)
#define RT_LDA(ks_) do { const int c_ = F.wave * 32 + (ks_) * 4 + fq; _Pragma("unroll") for (int mi = 0; mi < 2; ++mi) a[mi] = *(const LAS bf16x8*)(img + (mi * 16 + fr) * 4096 + ((c_ ^ fr) << 4)); } while (0)
#define RT_MMA(slot_) do { _Pragma("unroll") for (int mi = 0; mi < 2; ++mi) if (mi == 0 || two) _Pragma("unroll") for (int ni = 0; ni < 4; ++ni) { acc[mi][ni] = __builtin_amdgcn_mfma_f32_16x16x32_bf16(a[mi], bq[slot_][ni], acc[mi][ni], 0, 0, 0); acc[mi][ni] = __builtin_amdgcn_mfma_f32_16x16x32_bf16(a[mi], bq[slot_][4 + ni], acc[mi][ni], 0, 0, 0); } } while (0)
                RT_LDB(0, 0); RT_LDB(1, 1);
                __syncthreads();
                RT_LDB(2, 2);
                RT_LDA(0); RT_MMA(0); RT_LDB(0, 3);
                RT_LDA(1); RT_MMA(1); RT_LDB(1, 4);
                RT_LDA(2); RT_MMA(2); RT_LDB(2, 5);
                RT_LDA(3); RT_MMA(0); RT_LDB(0, 6);
                RT_LDA(4); RT_MMA(1); RT_LDB(1, 7);
                RT_LDA(5); RT_MMA(2);
                RT_LDA(6); RT_MMA(0);
                RT_LDA(7); RT_MMA(1);
#undef RT_LDB
#undef RT_LDA
#undef RT_MMA
                __syncthreads();
                LAS float* red = (LAS float*)img + F.wave * 2048;
#pragma unroll
                for (int mi = 0; mi < 2; ++mi)
#pragma unroll
                    for (int ni = 0; ni < 4; ++ni)
#pragma unroll
                        for (int r = 0; r < 4; ++r) red[(mi * 16 + 4 * fq + r) * 64 + ni * 16 + fr] = acc[mi][ni][r];
                __syncthreads();
#pragma unroll
                for (int q = 0; q < 4; ++q) { const int i = tid_ + q * NTHR; float s = 0.f;
#pragma unroll
                    for (int w = 0; w < 8; ++w) s += ((LAS float*)img)[w * 2048 + i];
                    if (i < nrows * 64) { logits[(size_t)(blk * 64 + row0) * 64 + i] = s; lgl[i] = s; } }
                __syncthreads();
            }
            const float bias = rbias[F.lane];
            _Pragma("unroll 1") for (int rr_ = 0; rr_ < EXP_ROUTE_REP; ++rr_)
            for (int i = F.wave; i < nrows; i += NWAVES) { const int t = blk * 64 + row0 + i; unsigned long long mask; float w;
                RT_ROUTE(lgl[i * 64 + F.lane], bias, F.lane, mask, w);
                tw[(size_t)t * 64 + F.lane] = w; if (F.lane == 0) { tokmask[t] = mask; lm[row0 + i] = mask; } }
            __syncthreads();
        }
        if (F.tid < 64) { int c = 0; for (int i = 0; i < 64; ++i) c += (int)((lm[i] >> F.tid) & 1ull); hist[blk * 64 + F.tid] = c; }
        __syncthreads();
    }
}
__device__ __forceinline__ void p6_ln_route(Frame& F, const float* __restrict__ x, const bf16_t* __restrict__ Y, const float* __restrict__ mod, const float* __restrict__ lg, const float* __restrict__ lb, bf16_t* __restrict__ X1, bf16_t* __restrict__ H2, unsigned char* __restrict__ H2F8,
                                            const bf16_t* __restrict__ WrT, const float* __restrict__ rbias, float* __restrict__ logits, unsigned long long* __restrict__ tokmask, float* __restrict__ tw, int* __restrict__ hist) {
    for (int blk = F.vcu; blk < 256; blk += F.G) {
        for (int rep_ = 0; rep_ < EXP_LN_REP; ++rep_)
        for (int i = F.wave; i < 64; i += NWAVES) { const int t = blk * 64 + i, b = t >> 11; const float* m = mod + b * 12288;
            const GAS f32x4* xr = (const GAS f32x4*)(x + (size_t)t * D) + F.lane; const GAS u32x2* yr = (const GAS u32x2*)(Y + (size_t)t * D) + F.lane; f32x4 v[8]; u32x2 yv[8]; float s = 0.f;
#pragma unroll
            for (int j = 0; j < 8; ++j) { v[j] = MK_RD_NT ? __builtin_nontemporal_load((const f32x4*)(xr + 64 * j)) : xr[64 * j]; yv[j] = MK_RD_NT ? __builtin_nontemporal_load((const u32x2*)(yr + 64 * j)) : yr[64 * j]; }
#pragma unroll
            for (int j = 0; j < 8; ++j) { v[j] = v[j] * ALPHA + (f32x4){bf2f(yv[j].x & 0xffffu), bf2f(yv[j].x >> 16), bf2f(yv[j].y & 0xffffu), bf2f(yv[j].y >> 16)}; s += (v[j][0] + v[j][1]) + (v[j][2] + v[j][3]); }
            const float mean = wave_sum(s) * (1.f / D); float s2 = 0.f;
#pragma unroll
            for (int j = 0; j < 8; ++j) { v[j] = v[j] - mean; s2 += (v[j][0] * v[j][0] + v[j][1] * v[j][1]) + (v[j][2] * v[j][2] + v[j][3] * v[j][3]); }
            const float rstd = 1.f / sqrtf(wave_sum(s2) * (1.f / D) + 1e-5f);
            GAS u32x2* xo = (GAS u32x2*)(X1 + (size_t)t * D) + F.lane; GAS u32x2* ho = (GAS u32x2*)(H2 + (size_t)t * D) + F.lane; GAS unsigned* h8 = (GAS unsigned*)(H2F8 + (size_t)t * D) + F.lane;
#pragma unroll
            for (int j = 0; j < 8; ++j) { const int d = 256 * j + 4 * F.lane; const f32x4 o = v[j] * rstd * *(const f32x4*)(lg + d) + *(const f32x4*)(lb + d);
                u32x2 w1; w1.x = cvt_pk_bf16(o[0], o[1]); w1.y = cvt_pk_bf16(o[2], o[3]); xo[64 * j] = w1;
                const f32x4 h = o * (*(const f32x4*)(m + 4 * 2048 + d) + 1.f) + *(const f32x4*)(m + 3 * 2048 + d); u32x2 w; w.x = cvt_pk_bf16(h[0], h[1]); w.y = cvt_pk_bf16(h[2], h[3]); ho[64 * j] = w; h8[64 * j] = pk4_fp8(h[0], h[1], h[2], h[3]); } }
        VM_WAIT(); __syncthreads();
        _Pragma("unroll 1") for (int rrep_ = 0; rrep_ < EXP_RT_REP; ++rrep_) {
        { const int fr = F.lane & 15, fq = F.lane >> 4; f32x4 acc[4][4];
#pragma unroll
            for (int mi = 0; mi < 4; ++mi)
#pragma unroll
                for (int ni = 0; ni < 4; ++ni) acc[mi][ni] = (f32x4){0.f, 0.f, 0.f, 0.f};
            bf16x8 a[4], bh[4], bl[4], an[4], bhn[4], bln[4];
#define RT_LOAD(A_, BH_, BL_, ks_) do { const int k_ = F.wave * 256 + (ks_) * 32 + fq * 8; _Pragma("unroll") for (int mi = 0; mi < 4; ++mi) A_[mi] = *(const bf16x8*)(H2 + (size_t)(blk * 64 + mi * 16 + fr) * D + k_); \
                _Pragma("unroll") for (int ni = 0; ni < 4; ++ni) { BH_[ni] = *(const bf16x8*)(WrT + (size_t)(ni * 16 + fr) * D + k_); BL_[ni] = *(const bf16x8*)(WrT + (size_t)(64 + ni * 16 + fr) * D + k_); } } while (0)
            RT_LOAD(a, bh, bl, 0);
#pragma unroll 1
            for (int ks = 0; ks < 8; ks += 2) {
                RT_LOAD(an, bhn, bln, ks + 1);
#pragma unroll
                for (int mi = 0; mi < 4; ++mi)
#pragma unroll
                    for (int ni = 0; ni < 4; ++ni) { acc[mi][ni] = __builtin_amdgcn_mfma_f32_16x16x32_bf16(a[mi], bh[ni], acc[mi][ni], 0, 0, 0); acc[mi][ni] = __builtin_amdgcn_mfma_f32_16x16x32_bf16(a[mi], bl[ni], acc[mi][ni], 0, 0, 0); }
                if (ks + 2 < 8) RT_LOAD(a, bh, bl, ks + 2);
#pragma unroll
                for (int mi = 0; mi < 4; ++mi)
#pragma unroll
                    for (int ni = 0; ni < 4; ++ni) { acc[mi][ni] = __builtin_amdgcn_mfma_f32_16x16x32_bf16(an[mi], bhn[ni], acc[mi][ni], 0, 0, 0); acc[mi][ni] = __builtin_amdgcn_mfma_f32_16x16x32_bf16(an[mi], bln[ni], acc[mi][ni], 0, 0, 0); }
            }
#undef RT_LOAD
            LAS float* red = (LAS float*)(F.lds + RING_OFF) + F.wave * 4096;
#pragma unroll
            for (int mi = 0; mi < 4; ++mi)
#pragma unroll
                for (int ni = 0; ni < 4; ++ni)
#pragma unroll
                    for (int r = 0; r < 4; ++r) red[(mi * 16 + 4 * fq + r) * 64 + ni * 16 + fr] = acc[mi][ni][r];
            __syncthreads();
            float sums[8];
#pragma unroll
            for (int q = 0; q < 8; ++q) { const int i = F.tid + q * NTHR; float s = 0.f;
#pragma unroll
                for (int w = 0; w < 8; ++w) s += ((LAS float*)(F.lds + RING_OFF))[w * 4096 + i];
                sums[q] = s; }
            __syncthreads();
#pragma unroll
            for (int q = 0; q < 8; ++q) { const int i = F.tid + q * NTHR; logits[(size_t)blk * 4096 + i] = sums[q]; ((LAS float*)(F.lds + RING_OFF))[i] = sums[q]; }
            __syncthreads();
        }
        { LAS float* lg_l = (LAS float*)(F.lds + RING_OFF); LAS unsigned long long* lm = (LAS unsigned long long*)(F.lds + RING_OFF + 16384);
            const float bias = rbias[F.lane];
            for (int i = F.wave; i < 64; i += NWAVES) { const int t = blk * 64 + i; unsigned long long mask; float w;
                RT_ROUTE(lg_l[i * 64 + F.lane], bias, F.lane, mask, w);
                tw[(size_t)t * 64 + F.lane] = w; if (F.lane == 0) { tokmask[t] = mask; lm[i] = mask; } }
            __syncthreads();
            if (F.tid < 64) { int c = 0; for (int i = 0; i < 64; ++i) c += (int)((lm[i] >> F.tid) & 1ull); hist[blk * 64 + F.tid] = c; }
            __syncthreads();
        }
        }
    }
}
__device__ __forceinline__ void p7_scatter(Frame& F, const int* hist, const unsigned long long* tokmask, const float* tw, int* stok, float* sw, int* tokpos, int* starts, int* cnts, LAS int* tstart = nullptr, LAS int* ttab = nullptr) {
    LAS int* li = (LAS int*)(F.lds + RING_OFF);
    LAS unsigned long long* lm = (LAS unsigned long long*)(F.lds + RING_OFF + 8192);
    LAS float* ltw = (LAS float*)(F.lds + RING_OFF + 16384);
    for (int blk = F.vcu; blk < 256; blk += F.G) {
        { const int e = F.tid & 63, part = F.tid >> 6; int tot = 0, before = 0;
#pragma unroll 8
            for (int b = part * 32; b < part * 32 + 32; ++b) { const int c = hist[b * 64 + e]; tot += c; before += (b < blk) ? c : 0; }
            li[part * 64 + e] = tot; li[512 + part * 64 + e] = before; }
        if (F.tid < 64) lm[F.tid] = tokmask[blk * 64 + F.tid];
        for (int i = F.tid; i < 4096; i += NTHR) ltw[i] = tw[(size_t)blk * 4096 + i];
        __syncthreads();
        if (F.tid < 64) { int tot = 0, before = 0;
#pragma unroll
            for (int p = 0; p < 8; ++p) { tot += li[p * 64 + F.tid]; before += li[512 + p * 64 + F.tid]; }
            li[1024 + F.tid] = tot; li[1088 + F.tid] = before; }
        __syncthreads();
        if (tstart) {
            if (F.tid == 0) { int acc = 0, st = 0; for (int e = 0; e < 64; ++e) { tstart[e] = acc; tstart[128 + e] = st; const int c = li[1024 + e]; acc += (c + 255) >> 8; st += c; } tstart[64] = acc; tstart[128 + 64] = 131072; acc += T / 256; tstart[65] = acc; }
            __syncthreads();
            if (F.tid < 65) { const int e = F.tid, cnt = e < 64 ? li[1024 + e] : T, st = tstart[128 + e], t0 = tstart[e], nt = tstart[e + 1] - t0;
                for (int mt = 0; mt < nt; ++mt) { ttab[3 * (t0 + mt)] = e; ttab[3 * (t0 + mt) + 1] = st + mt * 256; ttab[3 * (t0 + mt) + 2] = (cnt - mt * 256) < 256 ? (cnt - mt * 256) : 256; } }
        }
        { const int e = F.tid & 63, g = F.tid >> 6; int c = 0;
#pragma unroll
            for (int i = 0; i < 8; ++i) c += (int)((lm[g * 8 + i] >> e) & 1ull);
            li[1152 + g * 64 + e] = c; }
        __syncthreads();
        { const int e = F.tid & 63, g = F.tid >> 6; int st = 0; for (int j = 0; j < e; ++j) st += li[1024 + j];
            if (blk == 0 && g == 0) { starts[e] = st; cnts[e] = li[1024 + e]; }
            int pos = st + li[1088 + e];
            for (int gg = 0; gg < g; ++gg) pos += li[1152 + gg * 64 + e];
#pragma unroll
            for (int i = 0; i < 8; ++i) { const int ti = g * 8 + i, t = blk * 64 + ti; const unsigned long long m = lm[ti];
                if ((m >> e) & 1ull) { stok[pos] = t; sw[pos] = ltw[ti * 64 + e]; tokpos[t * 8 + __popcll(m & ((1ull << e) - 1ull))] = pos; ++pos; } } }
        __syncthreads();
    }
}
struct SchedMoe {
    const LAS int* ttab; int ntiles, nN, G, c; int K;
    const char* A; const char* Bt; size_t bstride; const int* stok; bool gather;
    __device__ __forceinline__ bool next(int i, pg8::Unit& u) const {
        const long L = (long)i * G + c; const int nwg = ntiles * nN; if (L >= nwg) return false;
        const int wgid = pg8::xcd_remap((int)L, nwg);
        const int nig = 8 * nN, gid = wgid / nig, fm = gid * 8, gsz = (ntiles - fm) < 8 ? (ntiles - fm) : 8;
        const int rt_ = fm + ((wgid % nig) % gsz), pn = (wgid % nig) / gsz;
        const int e = __builtin_amdgcn_readfirstlane(ttab[3 * rt_]), row0 = __builtin_amdgcn_readfirstlane(ttab[3 * rt_ + 1]), nv = __builtin_amdgcn_readfirstlane(ttab[3 * rt_ + 2]);
        u.pm = row0; u.pn = pn; u.kind = e < 64 ? 0 : 1; u.aux = e; u.nvalid = nv;
        if (gather) { u.rows = e < 64 ? stok + row0 : nullptr; u.a = e < 64 ? A : A + (size_t)(row0 - 131072) * K; }
        else { u.rows = nullptr; u.a = A + (size_t)row0 * K; }
        u.b = Bt + (size_t)e * bstride + (size_t)pn * 256 * K;
        return true; }
};
__device__ __forceinline__ int build_tiles(Frame& F, const int* cnts, const int* starts, LAS int* tstart, LAS int* ttab) {
    if (F.tid == 0) { int acc = 0; for (int e = 0; e < 64; ++e) { tstart[e] = acc; acc += (cnts[e] + 255) >> 8; } tstart[64] = acc; acc += T / 256; tstart[65] = acc; }
    __syncthreads();
    if (F.tid < 65) { const int e = F.tid, cnt = e < 64 ? cnts[e] : T, st = e < 64 ? starts[e] : 131072, t0 = tstart[e], nt = tstart[e + 1] - t0;
        for (int mt = 0; mt < nt; ++mt) { ttab[3 * (t0 + mt)] = e; ttab[3 * (t0 + mt) + 1] = st + mt * 256; ttab[3 * (t0 + mt) + 2] = (cnt - mt * 256) < 256 ? (cnt - mt * 256) : 256; } }
    __syncthreads();
    return tstart[65];
}
struct EpiGu {
    static constexpr bool PERM = true, TWICE = (EXP_EPI_GU2 != 0), B64 = false, PREF = false;
    unsigned char* HB; const float* sw;
    __device__ __forceinline__ void operator()(const f32x4 (&acc)[2][2][4][2], const pg8::Unit& u, int wr, int wc, int fr, int fq) const {
        asm volatile("" : "+v"(fr), "+v"(fq));
        int r0 = wr * 64 + fr, cl = wc * 32 + 8 * fq;
        const int cw = u.pn * 128 + wc * 32 + 16 * (fq >> 1);
        float wv[2][4];
        if (MK_WFOLD) {
#pragma unroll
            for (int ai = 0; ai < 2; ++ai)
#pragma unroll
                for (int m = 0; m < 4; ++m) { const int r = r0 + ai * 128 + m * 16; const int idx = (u.kind == 0) ? u.pm + min(r, u.nvalid - 1) : 0; wv[ai][m] = sw[idx]; }
#pragma unroll
            for (int ai = 0; ai < 2; ++ai)
#pragma unroll
                for (int m = 0; m < 4; ++m) wv[ai][m] = (u.kind == 0) ? 4.f * wv[ai][m] : 4.f;
            asm volatile("" : "+v"(wv[0][0]), "+v"(wv[0][1]), "+v"(wv[0][2]), "+v"(wv[0][3]), "+v"(wv[1][0]), "+v"(wv[1][1]), "+v"(wv[1][2]), "+v"(wv[1][3]));
        }
#pragma unroll
        for (int ai = 0; ai < 2; ++ai)
#pragma unroll
            for (int mp = 0; mp < 2; ++mp) { unsigned x[2][2];
#pragma unroll
                for (int q = 0; q < 2; ++q) { const int m = 2 * mp + q; f32x4 h0, h1;
#pragma unroll
                    for (int j = 0; j < 4; ++j) { h0[j] = siluf(acc[ai][0][m][0][j]) * acc[ai][1][m][0][j]; h1[j] = siluf(acc[ai][0][m][1][j]) * acc[ai][1][m][1][j]; }
                    if (MK_WFOLD) { h0 = h0 * wv[ai][m]; h1 = h1 * wv[ai][m]; }
                    x[q][0] = pk4_fp8(h0[0], h0[1], h0[2], h0[3]); x[q][1] = pk4_fp8(h1[0], h1[1], h1[2], h1[3]); }
                const auto s0 = __builtin_amdgcn_permlane16_swap(x[0][0], x[1][0], false, false), s1 = __builtin_amdgcn_permlane16_swap(x[0][1], x[1][1], false, false);
                const int r = r0 + ai * 128 + (2 * mp + (fq & 1)) * 16;
                if (r < u.nvalid) ST16NT(HB + (size_t)(u.pm + r) * 512 + cw, ((u32x4){s0[0], s1[0], s0[1], s1[1]})); }
    }
};
#ifndef MK_B64
#define MK_B64 true
#endif
#ifndef MK_SLOT_NT
#define MK_SLOT_NT 0
#endif
#ifndef MK_SWPREF
#define MK_SWPREF false
#endif
constexpr int SWSTASH_OFF = LDSCTL_OFF + 10240;
struct EpiDown {
    static constexpr bool PERM = true, TWICE = (EXP_EPI_DOWN2 != 0), B64 = MK_B64, PREF = MK_SWPREF;
    unsigned char* SLOT; const float* sw;
    __device__ __forceinline__ void prefetch(const pg8::Unit& u, LAS unsigned char* lds, int par, int tid) const {
        const int wid = __builtin_amdgcn_readfirstlane(tid >> 6), lane = tid & 63;
        if (wid < 4 && u.kind == 0) { const int r = wid * 64 + lane; const float* src = sw + u.pm + min(r, u.nvalid - 1);
            __builtin_amdgcn_global_load_lds((const unsigned*)src, (LAS unsigned*)(lds + SWSTASH_OFF + par * 1024 + wid * 256), 4, 0, 0); }
    }
    __device__ __forceinline__ void operator()(const f32x4 (&acc)[2][2][4][2], const pg8::Unit& u, int wr, int wc, int fr, int fq, const LAS float* stash = nullptr) const {
        asm volatile("" : "+v"(fr), "+v"(fq));
        int r0 = wr * 64 + fr, cl = wc * 32 + 8 * fq;
        float wv[2][4];
#pragma unroll
        for (int ai = 0; ai < 2; ++ai)
#pragma unroll
            for (int m = 0; m < 4; ++m) { const int r = r0 + ai * 128 + m * 16;
                if constexpr (PREF) wv[ai][m] = stash[r];
                else if (MK_WFOLD) wv[ai][m] = 1.f;
                else { const int idx = (u.kind == 0) ? u.pm + min(r, u.nvalid - 1) : 0;
                    wv[ai][m] = sw[idx]; } }
#pragma unroll
        for (int ai = 0; ai < 2; ++ai)
#pragma unroll
            for (int m = 0; m < 4; ++m) wv[ai][m] = MK_WFOLD ? 1.f : (u.kind == 0) ? 64.f * wv[ai][m] : 64.f;
        if (!MK_WFOLD) asm volatile("" : "+v"(wv[0][0]), "+v"(wv[0][1]), "+v"(wv[0][2]), "+v"(wv[0][3]), "+v"(wv[1][0]), "+v"(wv[1][1]), "+v"(wv[1][2]), "+v"(wv[1][3]));
        const int cw = B64 ? wc * 64 + (fq & 1) * 32 + 16 * (fq >> 1) : (fq & 1) * 128 + wc * 32 + 16 * (fq >> 1);
#pragma unroll
        for (int ai = 0; ai < 2; ++ai)
#pragma unroll
            for (int m = 0; m < 4; ++m) { const int r = r0 + ai * 128 + m * 16; const float w = wv[ai][m];
                const f32x4 a0 = MK_WFOLD ? acc[ai][0][m][0] : acc[ai][0][m][0] * w, a1 = MK_WFOLD ? acc[ai][0][m][1] : acc[ai][0][m][1] * w, b0 = MK_WFOLD ? acc[ai][1][m][0] : acc[ai][1][m][0] * w, b1 = MK_WFOLD ? acc[ai][1][m][1] : acc[ai][1][m][1] * w;
                const unsigned x0 = pk4_fp8(a0[0], a0[1], a0[2], a0[3]), x1 = pk4_fp8(a1[0], a1[1], a1[2], a1[3]), y0 = pk4_fp8(b0[0], b0[1], b0[2], b0[3]), y1 = pk4_fp8(b1[0], b1[1], b1[2], b1[3]);
                const auto s0 = __builtin_amdgcn_permlane16_swap(x0, y0, false, false), s1 = __builtin_amdgcn_permlane16_swap(x1, y1, false, false);
                if (r < u.nvalid) { const u32x4 ov = {s0[0], s1[0], s0[1], s1[1]}; if (MK_SLOT_NT) __builtin_nontemporal_store(ov, (u32x4*)(SLOT + (size_t)(u.pm + r) * 2048 + u.pn * 256 + cw)); else ST16NT(SLOT + (size_t)(u.pm + r) * 2048 + u.pn * 256 + cw, ov); } }
    }
};
__device__ __forceinline__ void p10_final(Frame& F, const bf16_t* __restrict__ Z, const unsigned char* __restrict__ SLOT, const int* __restrict__ tokpos, const float* __restrict__ mod, const float* __restrict__ lg, const float* __restrict__ lb, float* __restrict__ out) {
    const int gw = F.vcu * NWAVES + F.wave, NGW = F.G * NWAVES;
    int pv = (gw < T) ? tokpos[gw * 8 + (F.lane & 7)] : 0;
    for (int t = gw; t < T; t += NGW) { const int b = t >> 11; const float* g2 = mod + b * 12288 + 5 * 2048;
        int pos[9];
#pragma unroll
        for (int j = 0; j < 8; ++j) pos[j] = __builtin_amdgcn_readlane(pv, j);
        pos[8] = 131072 + t;
        { const int tn = t + NGW; pv = (tn < T) ? tokpos[tn * 8 + (F.lane & 7)] : 0; }
        f32x4 v[4][2]; float s = 0.f;
#pragma unroll
        for (int q = 0; q < 4; ++q) { const int d = 512 * q + 8 * F.lane; f32x4 a0 = {0.f, 0.f, 0.f, 0.f}, a1 = {0.f, 0.f, 0.f, 0.f};
#pragma unroll
            for (int j = 0; j < 9; ++j) { const u32x2 w = MK_RD_NT ? __builtin_nontemporal_load((const u32x2*)(SLOT + (size_t)pos[j] * 2048 + d)) : *(const u32x2*)(SLOT + (size_t)pos[j] * 2048 + d);
                const auto p0 = __builtin_amdgcn_cvt_pk_f32_fp8(w.x, false), p1 = __builtin_amdgcn_cvt_pk_f32_fp8(w.x, true), p2 = __builtin_amdgcn_cvt_pk_f32_fp8(w.y, false), p3 = __builtin_amdgcn_cvt_pk_f32_fp8(w.y, true);
                a0[0] += p0[0]; a0[1] += p0[1]; a0[2] += p1[0]; a0[3] += p1[1]; a1[0] += p2[0]; a1[1] += p2[1]; a1[2] += p3[0]; a1[3] += p3[1]; }
            a0 = a0 * (1.f / 64.f); a1 = a1 * (1.f / 64.f);
            const u32x4 zw = MK_RD_NT ? __builtin_nontemporal_load((const u32x4*)(Z + (size_t)t * D + d)) : *(const u32x4*)(Z + (size_t)t * D + d); const f32x4 z0 = {bf2f(zw.x & 0xffffu), bf2f(zw.x >> 16), bf2f(zw.y & 0xffffu), bf2f(zw.y >> 16)}, z1 = {bf2f(zw.z & 0xffffu), bf2f(zw.z >> 16), bf2f(zw.w & 0xffffu), bf2f(zw.w >> 16)};
            v[q][0] = z0 * ALPHA + (*(const f32x4*)(g2 + d) + 1.f) * a0; v[q][1] = z1 * ALPHA + (*(const f32x4*)(g2 + d + 4) + 1.f) * a1;
            s += ((v[q][0][0] + v[q][0][1]) + (v[q][0][2] + v[q][0][3])) + ((v[q][1][0] + v[q][1][1]) + (v[q][1][2] + v[q][1][3]));
            if (q & 1) asm volatile("" : "+v"(v[q][0]), "+v"(v[q][1]), "+v"(v[q - 1][0]), "+v"(v[q - 1][1]) :: "memory"); }
        const float mean = wave_sum(s) * (1.f / D); float s2 = 0.f;
#pragma unroll
        for (int q = 0; q < 4; ++q)
#pragma unroll
            for (int k = 0; k < 2; ++k) { v[q][k] = v[q][k] - mean; s2 += (v[q][k][0] * v[q][k][0] + v[q][k][1] * v[q][k][1]) + (v[q][k][2] * v[q][k][2] + v[q][k][3] * v[q][k][3]); }
        const float rstd = 1.f / sqrtf(wave_sum(s2) * (1.f / D) + 1e-5f);
#pragma unroll
        for (int q = 0; q < 4; ++q)
#pragma unroll
            for (int k = 0; k < 2; ++k) { const int d = 512 * q + 8 * F.lane + 4 * k; const f32x4 ov = v[q][k] * rstd * *(const f32x4*)(lg + d) + *(const f32x4*)(lb + d); if (MK_OUT_NT) __builtin_nontemporal_store(ov, (f32x4*)(out + (size_t)t * D + d)); else *(f32x4*)(out + (size_t)t * D + d) = ov; }
    }
}
constexpr int N_PHASES = 11;
__global__ void __launch_bounds__(NTHR, 2) mk_fwd(Args args) {
    extern __shared__ __attribute__((aligned(16))) unsigned char lds[];
    Frame F;
    F.lds = (LAS unsigned char*)lds; F.MISC = (volatile LAS unsigned*)(F.lds + MISC_OFF);
    F.tid = threadIdx.x; F.lane = F.tid & 63; F.wave = __builtin_amdgcn_readfirstlane(F.tid >> 6);
    F.G = gridDim.x; { const int bx = blockIdx.x; F.vcu = (F.G % 8 == 0) ? (bx % 8) * (F.G / 8) + bx / 8 : bx; }
    F.ws = args.ws;
    unsigned char* ws = args.ws;
    for (int u = F.tid; u < (LDS_BYTES - LDSCTL_OFF) / 4; u += NTHR) ((LAS unsigned*)(F.lds + LDSCTL_OFF))[u] = 0u;
    __syncthreads();
    const int lo = args.ph_lo, hi = args.ph_hi;
    XcdBarrier bar; bar.bar = (unsigned*)(ws + WL.ctl) + 1024; bar.x = 0; bar.st = nullptr;
    if (hi - lo > 1) bar = xcd_barrier_post((unsigned*)(ws + WL.ctl) + 1024, F.MISC + 8);
#ifndef MK_PHASE_MASK
#define MK_PHASE_MASK 0x7ffu
#endif
#define IN(k) ((((MK_PHASE_MASK) >> (k)) & 1u) && lo <= (k) && (k) < hi)
#define SEAM(k) do { if (IN(k) && IN((k) + 1)) { xcd_barrier(bar); for (int sb_ = 1; sb_ < EXP_BAR_REP; ++sb_) xcd_barrier(bar); } } while (0)
#ifdef MK_PROBE
    unsigned long long* stamps = (unsigned long long*)(ws + WL.ctl + 48 * 1024);
#define STAMP(k) do { if (blockIdx.x == 0 && F.tid == 0) stamps[k] = wall_clock64(); } while (0)
#else
#define STAMP(k) do { } while (0)
#endif
#ifndef EXP_P0_REP
#define EXP_P0_REP 1
#endif
#ifndef MK_P6_LDS
#define MK_P6_LDS 1
#endif
#ifndef EXP_P6_REP
#define EXP_P6_REP 1
#endif
#ifndef MK_CONV_FN1
#define MK_CONV_FN1 p0_convert_experts
#endif
#ifndef MK_P1_KR
#define MK_P1_KR 1
#endif
#ifndef MK_P7_TILES
#define MK_P7_TILES 0
#endif
#ifndef EXP_BT_REP
#define EXP_BT_REP 1
#endif
#ifndef EXP_KR_REP
#define EXP_KR_REP 1
#endif
#ifndef EXP_P7_REP
#define EXP_P7_REP 1
#endif
#ifndef EXP_P10_REP
#define EXP_P10_REP 1
#endif
#ifndef EXP_P1_REP
#define EXP_P1_REP 1
#endif
#ifndef EXP_CONV_REP
#define EXP_CONV_REP 1
#endif
#define MK_CONV_FN(F_, a_) do { _Pragma("unroll 1") for (int cr_ = 0; cr_ < EXP_CONV_REP; ++cr_) MK_CONV_FN1(F_, a_); } while (0)
#ifndef MK_POOL
#define MK_POOL 0
#endif
#ifndef MK_CONV_NG
#define MK_CONV_NG 3
#endif
#ifndef MK_CONV_W4
#define MK_CONV_W4 0
#endif
#ifndef MK_ATT_REV
#define MK_ATT_REV 0
#endif
#ifndef EXP_P9_REP
#define EXP_P9_REP 1
#endif
#ifndef EXP_P8_REP
#define EXP_P8_REP 1
#endif
#ifndef EXP_BAR_REP
#define EXP_BAR_REP 1
#endif
#ifndef MK_P3_SPLIT
#define MK_P3_SPLIT 1
#endif
#ifndef MK_CONV_G4
#define MK_CONV_G4 0
#endif
#ifndef MK_CONV_P4
#define MK_CONV_P4 1
#endif
#ifndef MK_DESYNC_TICKS
#define MK_DESYNC_TICKS 0
#endif
    const unsigned dly = (unsigned)(blockIdx.x >> 3 & 7) * MK_DESYNC_TICKS;
    const float* x = args.in[0]; const float* mod = (const float*)(ws + WL.mod);
    const float* cs128 = (const float*)(ws + WL.cs128); const float* cs64 = (const float*)(ws + WL.cs64);

    STAMP(0);
    if (IN(0)) _Pragma("unroll 1") for (int p0rep_ = 0; p0rep_ < EXP_P0_REP; ++p0rep_) { p0_mod(F, args.in[1], args.in[2], args.in[3], (float*)(ws + WL.mod)); p0_rope_tab(F, (float2*)(ws + WL.cs128), (float2*)(ws + WL.cs64)); p0_convert(F, args, MK_CONV_P4 ? (args.flags & 1u) : args.flags); }
    SEAM(0);
    STAMP(1);
    const bool p1kr = MK_P1_KR && F.G == 256;
    if (IN(1)) { if (p1kr) p1_h1_kr(F, x, mod, ws + WL.h1, ws + WL.win + (size_t)4096 * 2048, cs64, (bf16_t*)(ws + WL.kr)); else p1_h1(F, x, mod, ws + WL.h1); }
    SEAM(1);
    STAMP(2);
    if (IN(2)) {
        if (!p1kr) p2_kr(F, ws + WL.h1, ws + WL.win + (size_t)4096 * 2048, cs64, (bf16_t*)(ws + WL.kr));
        typedef EpiInT<7> EpiIn;
        EpiIn E{(bf16_t*)(ws + WL.qa), (bf16_t*)(ws + WL.ka), (bf16_t*)(ws + WL.va), ws + WL.cq, ws + WL.ckv, (bf16_t*)(ws + WL.kr), (float*)(ws + WL.ssq), cs128, cs64};
        SchedIn Sx; Sx.o.init(64, 16, F.G, (int)blockIdx.x); Sx.A = (const char*)(ws + WL.h1); Sx.Bt = (const char*)(ws + WL.win); Sx.pn0 = 0; Sx.rowb = 2048;
        pg8::gemm_phase<EpiIn, SchedIn, true, true>(F.lds + RING_OFF, 2048, Sx, E, dly);
    }
    SEAM(2);
    STAMP(3);
    if (IN(3)) {
        const bool p3_split = MK_P3_SPLIT && F.G == 256;
        if (!p3_split) p3_kmean(F, (const bf16_t*)(ws + WL.ka), (float*)(ws + WL.kmean), F.vcu, F.G);
        SchedMla Sx; Sx.o.init(64, 14, F.G, (int)blockIdx.x); Sx.CQ = (const char*)(ws + WL.cq); Sx.CKV = (const char*)(ws + WL.ckv); Sx.WuqT = (const char*)(ws + WL.wuq); Sx.WukvT = (const char*)(ws + WL.wukv);
        EpiMla E{(bf16_t*)(ws + WL.qmn), (bf16_t*)(ws + WL.qmr), (bf16_t*)(ws + WL.kn), (bf16_t*)(ws + WL.vm), (const float*)(ws + WL.ssq), cs64};
        pg8::gemm_phase<EpiMla, SchedMla, true, true>(F.lds + RING_OFF, 512, Sx, E, dly);
        if (p3_split && blockIdx.x >= 128) p3_kmean(F, (const bf16_t*)(ws + WL.ka), (float*)(ws + WL.kmean), (int)blockIdx.x - 128, 128);
    }
    SEAM(3);
    STAMP(4);
    if (IN(4)) {
        att::Tensors Tn{(const bf16_t*)(ws + WL.qa), (const bf16_t*)(ws + WL.ka), (const bf16_t*)(ws + WL.va), (const bf16_t*)(ws + WL.qmn), (const bf16_t*)(ws + WL.qmr), (const bf16_t*)(ws + WL.kn), (const bf16_t*)(ws + WL.kr),
                        (const bf16_t*)(ws + WL.vm), ws + WL.mix, (const float*)(ws + WL.kmean)};
#if MK_CONV_W4
        const int cgrp = (MK_CONV_P4 && (args.flags & 2u)) ? (F.vcu >> 2) & 3 : -1;
        if (cgrp == 0) MK_CONV_FN(F, args);
        if (cgrp == 2) {
            att::phase<true>((char*)lds + RING_OFF, (LAS char*)(F.lds + RING_OFF), Tn, F.vcu, F.G, 0, 2, MK_ATT_REV);
            MK_CONV_FN(F, args);
            att::phase<false>((char*)lds + RING_OFF, (LAS char*)(F.lds + RING_OFF), Tn, F.vcu, F.G, 0, 2, MK_ATT_REV);
        } else {
            att::phase<false>((char*)lds + RING_OFF, (LAS char*)(F.lds + RING_OFF), Tn, F.vcu, F.G, 0, 2, MK_ATT_REV);
            if (cgrp == 1) MK_CONV_FN(F, args);
            att::phase<true>((char*)lds + RING_OFF, (LAS char*)(F.lds + RING_OFF), Tn, F.vcu, F.G, 0, 2, MK_ATT_REV);
        }
        if (cgrp == 3) MK_CONV_FN(F, args);
#else
        const int cy = F.vcu & 3, cgrp = (MK_CONV_P4 && (args.flags & 2u)) ? (MK_CONV_G4 && cy == 3 ? 3 : MK_CONV_NG == 2 ? 2 * ((F.vcu >> 2) & 1) : (F.vcu >> 2) % 3) : -1;
        if (cgrp == 0) MK_CONV_FN(F, args);
        att::phase<false>((char*)lds + RING_OFF, (LAS char*)(F.lds + RING_OFF), Tn, F.vcu, F.G, 0, 2, MK_ATT_REV);
        if (cgrp == 1) MK_CONV_FN(F, args);
        { const int nseg = cgrp == 3 ? 2 : 1;
#pragma unroll 1
            for (int seg = 0; seg < nseg; ++seg) {
                att::phase<true>((char*)lds + RING_OFF, (LAS char*)(F.lds + RING_OFF), Tn, F.vcu, F.G, seg, cgrp == 3 ? seg + 1 : 2, cgrp == 3 ? 1 : MK_ATT_REV);
                if (cgrp == 3 && seg == 0) MK_CONV_FN(F, args); } }
        if (cgrp == 2) MK_CONV_FN(F, args);
#endif
    }
    SEAM(4);
    STAMP(5);
    if (IN(5)) {
        SchedOut Sx; Sx.o.init(64, 8, F.G, (int)blockIdx.x); Sx.A = (const char*)(ws + WL.mix); Sx.Bt = (const char*)(ws + WL.wo);
        EpiOut E{mod, (bf16_t*)(ws + WL.y)};
        pg8::gemm_phase<EpiOut, SchedOut, true, true>(F.lds + RING_OFF, 2048, Sx, E, dly, 0x79797979, 0x79797979);
    }
    SEAM(5);
    STAMP(6);
    if (IN(6)) {
#if MK_P6_LDS
        p6_ln_route_lds(F, x, (const bf16_t*)(ws + WL.y), mod, args.in[10], args.in[11], (bf16_t*)(ws + WL.x1), ws + WL.h2f8, (const bf16_t*)(ws + WL.wr), args.in[13], (float*)(ws + WL.logits),
                        (unsigned long long*)(ws + WL.tokmask), (float*)(ws + WL.tw), (int*)(ws + WL.hist));
#else
        _Pragma("unroll 1") for (int p6rep_ = 0; p6rep_ < EXP_P6_REP; ++p6rep_) p6_ln_route(F, x, (const bf16_t*)(ws + WL.y), mod, args.in[10], args.in[11], (bf16_t*)(ws + WL.x1), (bf16_t*)(ws + WL.h2), ws + WL.h2f8, (const bf16_t*)(ws + WL.wr), args.in[13], (float*)(ws + WL.logits),
                             (unsigned long long*)(ws + WL.tokmask), (float*)(ws + WL.tw), (int*)(ws + WL.hist));
#endif
    }
    SEAM(6);
    LAS int* tstart = (LAS int*)(F.lds + LDSCTL_OFF + 1024); LAS int* ttab = (LAS int*)(F.lds + LDSCTL_OFF + 2048);
    STAMP(7);
    if (IN(7)) _Pragma("unroll 1") for (int p7rep_ = 0; p7rep_ < EXP_P7_REP; ++p7rep_) { p7_scatter(F, (const int*)(ws + WL.hist), (const unsigned long long*)(ws + WL.tokmask), (const float*)(ws + WL.tw), (int*)(ws + WL.stok), (float*)(ws + WL.sw), (int*)(ws + WL.tokpos), (int*)(ws + WL.starts), (int*)(ws + WL.cnts), MK_P7_TILES ? tstart : nullptr, ttab); }
    SEAM(7);
#ifndef MK_ALIGN9
#define MK_ALIGN9 true
#endif
    STAMP(8);
    if (IN(8)) {
        const int ntiles = (MK_P7_TILES && IN(7)) ? tstart[65] : build_tiles(F, (const int*)(ws + WL.cnts), (const int*)(ws + WL.starts), tstart, ttab);
        SchedMoe Sx; Sx.ttab = ttab; Sx.ntiles = ntiles; Sx.nN = 4; Sx.G = F.G; Sx.c = (int)blockIdx.x; Sx.K = 2048;
        Sx.A = (const char*)(ws + WL.h2f8); Sx.Bt = (const char*)(ws + WL.wgu); Sx.bstride = (size_t)1024 * 2048; Sx.stok = (const int*)(ws + WL.stok); Sx.gather = true;
        EpiGu E{ws + WL.hb, (const float*)(ws + WL.sw)};
        pg8::gemm_phase<EpiGu, SchedMoe, true, true>(F.lds + RING_OFF, 2048, Sx, E, dly);
        if (MK_POOL && MK_CONV_P4 && (args.flags & 2u)) {
            const int U = ntiles * 4, G = F.G, c = (int)blockIdx.x, N = (U + G - 1) / G, c0 = U - (N - 1) * G, nidle = G - c0;
            if (nidle >= 64) { if (c >= c0) p0_convert_experts(F, args, (c - c0) * NWAVES + F.wave, nidle * NWAVES, CONV_NV1, 1); }
            else p0_convert_experts(F, args, c * NWAVES + F.wave, G * NWAVES, CONV_NV1, 1);
        }
#if EXP_P8_REP > 1
        asm volatile("" ::: "memory"); pg8::gemm_phase<EpiGu, SchedMoe, true, true>(F.lds + RING_OFF, 2048, Sx, E, dly);
#endif
    }
    SEAM(8);
    STAMP(9);
    if (IN(9)) {
        const int ntiles = (MK_P7_TILES && IN(7)) ? tstart[65] : build_tiles(F, (const int*)(ws + WL.cnts), (const int*)(ws + WL.starts), tstart, ttab);
        SchedMoe Sx; Sx.ttab = ttab; Sx.ntiles = ntiles; Sx.nN = 8; Sx.G = F.G; Sx.c = (int)blockIdx.x; Sx.K = 512;
        Sx.A = (const char*)(ws + WL.hb); Sx.Bt = (const char*)(ws + WL.wd); Sx.bstride = (size_t)2048 * 512; Sx.stok = nullptr; Sx.gather = false;
        EpiDown E{ws + WL.slot, (const float*)(ws + WL.sw)};
        pg8::gemm_phase<EpiDown, SchedMoe, true, true, MK_ALIGN9>(F.lds + RING_OFF, 512, Sx, E, dly, MK_WFOLD ? 0x7f7f7f7f : 0x79797979, MK_WFOLD ? 0x7d7d7d7d : 0x7f7f7f7f);
#if EXP_P9_REP > 1
        asm volatile("" ::: "memory"); pg8::gemm_phase<EpiDown, SchedMoe, true, true, MK_ALIGN9>(F.lds + RING_OFF, 512, Sx, E, dly);
#endif
    }
    SEAM(9);
    STAMP(10);
    if (IN(10)) _Pragma("unroll 1") for (int p10rep_ = 0; p10rep_ < EXP_P10_REP; ++p10rep_) { p10_final(F, (const bf16_t*)(ws + WL.x1), ws + WL.slot, (const int*)(ws + WL.tokpos), mod, args.in[20], args.in[21], args.out); }
#ifdef MK_PROBE
    xcd_barrier(bar);
    STAMP(11);
    xcd_barrier(bar);
    {
        const double tA = 20.0 * rint((double)(stamps[MK_PROBE_A1 + 1] - stamps[MK_PROBE_A0]) * 0.01 * 0.05), tB = 20.0 * rint((double)(stamps[MK_PROBE_B1 + 1] - stamps[MK_PROBE_B0]) * 0.01 * 0.05);
        const float f = 1.f + (float)sqrt(tA * 1e-5);
#ifdef MK_PROBE_RAW
        for (size_t i = (size_t)blockIdx.x * NTHR + F.tid; i < (size_t)T * D; i += (size_t)F.G * NTHR) args.out[i] = (i == 0) ? 20.f * rintf((float)tB * 0.05f) : 0.f;
        (void)f;
#else
        for (size_t i = (size_t)blockIdx.x * NTHR + F.tid; i < (size_t)T * D; i += (size_t)F.G * NTHR) { float v = args.out[i] * f; if (i == 0) v += 2.f + (float)(tB * 0.1); args.out[i] = v; }
#endif
    }
#endif
#undef IN
#undef SEAM
}

namespace fh {
static int g_grid = 0;
static void setup() {
    if (g_grid) return;
    int dev = 0, cus = 0; hipGetDevice(&dev); hipDeviceGetAttribute(&cus, hipDeviceAttributeMultiprocessorCount, dev);
    hipFuncSetAttribute((const void*)mk_fwd, hipFuncAttributeMaxDynamicSharedMemorySize, LDS_BYTES);
    int per_cu = 0; hipOccupancyMaxActiveBlocksPerMultiprocessor(&per_cu, (const void*)mk_fwd, NTHR, LDS_BYTES); (void)hipGetLastError();
    g_grid = cus > 0 ? cus : 256; if (per_cu < 1) fprintf(stderr, "mk_fwd: occupancy query reports %d blocks/CU\n", per_cu);
}
static void launch(void* const* d_in, float* out, unsigned char* ws, int lo, int hi, unsigned flags, hipStream_t st) {
    setup();
    Args a{}; for (int i = 0; i < 22; ++i) a.in[i] = (const float*)d_in[i];
    a.out = out; a.ws = ws; a.ph_lo = lo; a.ph_hi = hi; a.flags = flags; a.pad = 0;
    hipLaunchKernelGGL(mk_fwd, dim3(g_grid), dim3(NTHR), LDS_BYTES, st, a);
}
}
#ifndef MK_N_LAUNCHES
#define MK_N_LAUNCHES 1
#endif
extern "C" void kernel_launch(void* const* d_in, const int* in_sizes, int n_in, void* d_out, int out_size, void* d_ws, size_t ws_size, hipStream_t stream) {
    (void)in_sizes; (void)n_in; (void)out_size;
    unsigned char* ws = (unsigned char*)d_ws; float* out = (float*)d_out;
    if (ws_size < WL.end) { nvh::run(d_in, out, ws, stream); return; }
    hipMemsetAsync(ws + WL.ctl, 0, CTL_BYTES, stream);
    if (MK_N_LAUNCHES == 1) fh::launch(d_in, out, ws, 0, N_PHASES, 3u, stream);
    else for (int ph = 0; ph < N_PHASES; ++ph) fh::launch(d_in, out, ws, ph, ph + 1, 3u, stream);
}
```

```cpp
#define MK_N_LAUNCHES 1
#include <hip/hip_runtime.h>
#include <stdint.h>
#include <stdio.h>

constexpr int Bn = 8, S = 2048, D = 2048, T = Bn * S;
constexpr int INW = 4160;
constexpr float ALPHA = 1.189207115002721f;
constexpr size_t MiB = 1u << 20;
namespace nv {

__device__ __forceinline__ float wsum(float v) {
#pragma unroll
    for (int o = 1; o < 64; o <<= 1) v += __shfl_xor(v, o);
    return v;
}
__device__ __forceinline__ float wmax(float v) {
#pragma unroll
    for (int o = 1; o < 64; o <<= 1) v = fmaxf(v, __shfl_xor(v, o));
    return v;
}

__global__ __launch_bounds__(256) void k_mod(const float* __restrict__ c, const float* __restrict__ w_ada, const float* __restrict__ b_ada, float* __restrict__ mod) {
    const int col = blockIdx.x * 256 + threadIdx.x, b = blockIdx.y;
    float acc = b_ada[col];
    for (int k = 0; k < D; ++k) { const float v = c[b * D + k]; const float s = v / (1.f + expf(-v)); acc += s * w_ada[(size_t)k * 6 * D + col]; }
    mod[b * 6 * D + col] = acc;
}
__global__ void k_rope_tab(float2* cs128, float2* cs64) {
    const int idx = blockIdx.x * 256 + threadIdx.x;
    if (idx < S * 64) { const int pos = idx / 64, i = idx % 64; const float inv = (float)(1.0 / pow(10000.0, (double)(2 * i) / 128.0)); const float a = (float)pos * inv; cs128[idx] = make_float2((float)cos((double)a), (float)sin((double)a)); }
    if (idx < S * 32) { const int pos = idx / 32, i = idx % 32; const float inv = (float)(1.0 / pow(10000.0, (double)(2 * i) / 64.0)); const float a = (float)pos * inv; cs64[idx] = make_float2((float)cos((double)a), (float)sin((double)a)); }
}
__global__ __launch_bounds__(256) void k_modulate(const float* __restrict__ x, const float* __restrict__ mod, int sh_off, int sc_off, float* __restrict__ h) {
    const size_t i = (size_t)blockIdx.x * 256 + threadIdx.x; const int d = (int)(i % D); const int b = (int)(i / ((size_t)S * D));
    h[i] = x[i] * (1.f + mod[b * 6 * D + sc_off + d]) + mod[b * 6 * D + sh_off + d];
}

template <int MODE, bool REL>
__global__ __launch_bounds__(256) void k_gemm(const float* __restrict__ A, const float* __restrict__ Bm, float* __restrict__ C, int M, int N, int K, int lda, int ldb, int ldc,
                                              const int* __restrict__ list, const float* __restrict__ wts, const int* __restrict__ starts, const int* __restrict__ cnts, int e) {
    int m_total = M, off = 0;
    if (MODE) { off = starts[e]; m_total = cnts[e]; }
    const int m0 = blockIdx.y * 64, n0 = blockIdx.x * 64;
    if (m0 >= m_total) return;
    __shared__ float As[16][65];
    __shared__ float Bs[16][64];
    const int tid = threadIdx.x, tx = tid & 15, ty = tid >> 4;
    const int ar = tid >> 2, ak = (tid & 3) * 4;
    const int bk = tid >> 4, bn = (tid & 15) * 4;
    const int r = m0 + ar; const bool av = r < m_total;
    size_t arow = 0;
    if (av) { if (MODE == 1) arow = (size_t)list[off + r]; else if (MODE == 2) arow = (size_t)(REL ? r : off + r); else arow = (size_t)r; }
    const float* ap = A + arow * lda + ak;
    const float* bp = Bm + (size_t)bk * ldb + n0 + bn;
    float acc[4][4];
#pragma unroll
    for (int i = 0; i < 4; ++i)
#pragma unroll
        for (int j = 0; j < 4; ++j) acc[i][j] = 0.f;
    for (int k0 = 0; k0 < K; k0 += 16) {
        float4 a4 = av ? *(const float4*)(ap + k0) : make_float4(0.f, 0.f, 0.f, 0.f);
        float4 b4 = *(const float4*)(bp + (size_t)k0 * ldb);
        __syncthreads();
        As[ak + 0][ar] = a4.x; As[ak + 1][ar] = a4.y; As[ak + 2][ar] = a4.z; As[ak + 3][ar] = a4.w;
        *(float4*)&Bs[bk][bn] = b4;
        __syncthreads();
#pragma unroll
        for (int kk = 0; kk < 16; ++kk) {
            float a[4], b[4];
#pragma unroll
            for (int i = 0; i < 4; ++i) a[i] = As[kk][ty * 4 + i];
#pragma unroll
            for (int j = 0; j < 4; ++j) b[j] = Bs[kk][tx * 4 + j];
#pragma unroll
            for (int i = 0; i < 4; ++i)
#pragma unroll
                for (int j = 0; j < 4; ++j) acc[i][j] = fmaf(a[i], b[j], acc[i][j]);
        }
    }
#pragma unroll
    for (int i = 0; i < 4; ++i) {
        const int rr = m0 + ty * 4 + i; if (rr >= m_total) continue;
        if (MODE == 2) { const int tok = list[off + rr]; const float w = wts[off + rr]; float* cp = C + (size_t)tok * ldc + n0 + tx * 4;
#pragma unroll
            for (int j = 0; j < 4; ++j) cp[j] += w * acc[i][j]; }
        else { float* cp = C + (size_t)((MODE == 1 && !REL) ? off + rr : rr) * ldc + n0 + tx * 4; *(float4*)cp = make_float4(acc[i][0], acc[i][1], acc[i][2], acc[i][3]); }
    }
}

__global__ __launch_bounds__(256) void k_rope_proj(float* __restrict__ proj, const float2* __restrict__ cs128, const float2* __restrict__ cs64) {
    const int t = blockIdx.x, pos = t % S; float* row = proj + (size_t)t * INW;
    for (int idx = threadIdx.x; idx < 2 * 8 * 64 + 32; idx += 256) {
        if (idx < 1024) { const int which = idx >> 9, h = (idx >> 6) & 7, i = idx & 63; float* p = row + which * 1024 + h * 128; const float2 c = cs128[pos * 64 + i];
            const float x1 = p[i], x2 = p[i + 64]; p[i] = x1 * c.x - x2 * c.y; p[i + 64] = x2 * c.x + x1 * c.y; }
        else { const int i = idx - 1024; float* p = row + 4096; const float2 c = cs64[pos * 32 + i];
            const float x1 = p[i], x2 = p[i + 32]; p[i] = x1 * c.x - x2 * c.y; p[i + 32] = x2 * c.x + x1 * c.y; }
    }
}
__global__ __launch_bounds__(256) void k_rope_qm(float* __restrict__ qm, const float2* __restrict__ cs64) {
    const int t = blockIdx.x, pos = t % S; const int h = threadIdx.x >> 5, i = threadIdx.x & 31;
    float* p = qm + (size_t)t * 1536 + h * 192 + 128; const float2 c = cs64[pos * 32 + i];
    const float x1 = p[i], x2 = p[i + 32]; p[i] = x1 * c.x - x2 * c.y; p[i + 32] = x2 * c.x + x1 * c.y;
}
__global__ __launch_bounds__(128) void k_kmean(const float* __restrict__ proj, float* __restrict__ kmean) {
    const int n = blockIdx.x & 7, h = (blockIdx.x >> 3) & 7, b = blockIdx.x >> 6, d = threadIdx.x;
    float s = 0.f;
    for (int j = 0; j < 256; ++j) s += proj[(size_t)(b * S + n * 256 + j) * INW + 1024 + h * 128 + d];
    kmean[((b * 8 + h) * 8 + n) * 128 + d] = s * (1.f / 256.f);
}
__global__ __launch_bounds__(256) void k_rms(const float* __restrict__ proj, int col0, const float* __restrict__ g, float* __restrict__ dst) {
    const int wave = threadIdx.x >> 6, lane = threadIdx.x & 63; const int t = blockIdx.x * 4 + wave;
    const float* p = proj + (size_t)t * INW + col0; float v[8]; float ss = 0.f;
#pragma unroll
    for (int j = 0; j < 8; ++j) { v[j] = p[lane + 64 * j]; ss += v[j] * v[j]; }
    ss = wsum(ss); const float r = 1.f / sqrtf(ss * (1.f / 512.f) + 1e-6f);
#pragma unroll
    for (int j = 0; j < 8; ++j) dst[(size_t)t * 512 + lane + 64 * j] = v[j] * r * g[lane + 64 * j];
}

template <bool MOBA>
__global__ __launch_bounds__(256) void k_attn(const float* __restrict__ proj, const float* __restrict__ qm, const float* __restrict__ kv, const float* __restrict__ kmean, float* __restrict__ mix) {
    constexpr int DK = MOBA ? 128 : 192, MAXK = MOBA ? 1024 : 2048;
    __shared__ float qs[4][192];
    __shared__ float sc[4][MAXK];
    const int wave = threadIdx.x >> 6, lane = threadIdx.x & 63;
    const int gid = blockIdx.x * 4 + wave; const int h = gid & 7, t = gid >> 3, b = t / S, s = t % S;
    const float* qrow = MOBA ? proj + (size_t)t * INW + h * 128 : qm + (size_t)t * 1536 + h * 192;
    for (int d = lane; d < DK; d += 64) qs[wave][d] = qrow[d];
    __syncthreads();
    const float* q = qs[wave];
    const int own = s >> 8;
    int nkeys = 0;
    unsigned att = 0;
    if (MOBA) {
        float g[8];
#pragma unroll
        for (int n = 0; n < 8; ++n) { const float* km = kmean + ((b * 8 + h) * 8 + n) * 128; float p = q[lane] * km[lane] + q[lane + 64] * km[lane + 64]; g[n] = wsum(p); }
#pragma unroll
        for (int n = 0; n < 8; ++n) { if (n < own) { int rank = 0;
#pragma unroll
                for (int j = 0; j < 8; ++j) if (j < own && (g[j] > g[n] || (g[j] == g[n] && j < n))) ++rank;
                if (rank < 3) att |= 1u << n; } }
    }
    const float scale = MOBA ? 0.08838834764831845f : 0.07216878364870323f;
    float mx = -__builtin_inff();
    if (MOBA) {
        for (int n = 0; n <= own; ++n) {
            if (n < own && !((att >> n) & 1u)) continue;
            const int cnt = (n < own) ? 256 : (s - own * 256 + 1);
            for (int j = lane; j < cnt; j += 64) { const float* kr = proj + (size_t)(b * S + n * 256 + j) * INW + 1024 + h * 128; float a = 0.f;
                for (int d = 0; d < 128; d += 4) { const float4 kk = *(const float4*)(kr + d); a += q[d] * kk.x + q[d + 1] * kk.y + q[d + 2] * kk.z + q[d + 3] * kk.w; }
                a *= scale; sc[wave][nkeys + j] = a; mx = fmaxf(mx, a); }
            nkeys += cnt;
        }
    } else {
        nkeys = s + 1;
        for (int j = lane; j < nkeys; j += 64) { const float* kn = kv + (size_t)(b * S + j) * 2048 + h * 256; const float* kr = proj + (size_t)(b * S + j) * INW + 4096; float a = 0.f;
            for (int d = 0; d < 128; d += 4) { const float4 kk = *(const float4*)(kn + d); a += q[d] * kk.x + q[d + 1] * kk.y + q[d + 2] * kk.z + q[d + 3] * kk.w; }
            for (int d = 0; d < 64; d += 4) { const float4 kk = *(const float4*)(kr + d); a += q[128 + d] * kk.x + q[129 + d] * kk.y + q[130 + d] * kk.z + q[131 + d] * kk.w; }
            a *= scale; sc[wave][j] = a; mx = fmaxf(mx, a); }
    }
    mx = wmax(mx);
    float sum = 0.f;
    for (int j = lane; j < nkeys; j += 64) { const float p = expf(sc[wave][j] - mx); sc[wave][j] = p; sum += p; }
    sum = wsum(sum);
    __syncthreads();
    const float inv = 1.f / sum;
    float o0 = 0.f, o1 = 0.f;
    if (MOBA) {
        int e = 0;
        for (int n = 0; n <= own; ++n) {
            if (n < own && !((att >> n) & 1u)) continue;
            const int cnt = (n < own) ? 256 : (s - own * 256 + 1);
            for (int j = 0; j < cnt; ++j) { const float p = sc[wave][e + j]; const float* vr = proj + (size_t)(b * S + n * 256 + j) * INW + 2048 + h * 128; o0 += p * vr[lane]; o1 += p * vr[lane + 64]; }
            e += cnt;
        }
        float* orow = mix + (size_t)t * 2048 + h * 128; orow[lane] = o0 * inv; orow[lane + 64] = o1 * inv;
    } else {
        for (int j = 0; j < nkeys; ++j) { const float p = sc[wave][j]; const float* vr = kv + (size_t)(b * S + j) * 2048 + h * 256 + 128; o0 += p * vr[lane]; o1 += p * vr[lane + 64]; }
        float* orow = mix + (size_t)t * 2048 + 1024 + h * 128; orow[lane] = o0 * inv; orow[lane + 64] = o1 * inv;
    }
}

__global__ __launch_bounds__(256) void k_ln(const float* __restrict__ xres, const float* __restrict__ f, const float* __restrict__ mod, int gate_off, const float* __restrict__ lg, const float* __restrict__ lb,
                                            float* __restrict__ xo, float* __restrict__ h, int sh_off, int sc_off) {
    const int wave = threadIdx.x >> 6, lane = threadIdx.x & 63; const int t = blockIdx.x * 4 + wave, b = t / S;
    const float* m = mod + b * 6 * D;
    float v[32]; float s1 = 0.f;
#pragma unroll
    for (int j = 0; j < 32; ++j) { const int d = lane + 64 * j; v[j] = ALPHA * xres[(size_t)t * D + d] + (1.f + m[gate_off + d]) * f[(size_t)t * D + d]; s1 += v[j]; }
    const float mu = wsum(s1) * (1.f / D); float s2 = 0.f;
#pragma unroll
    for (int j = 0; j < 32; ++j) { v[j] -= mu; s2 += v[j] * v[j]; }
    const float r = 1.f / sqrtf(wsum(s2) * (1.f / D) + 1e-5f);
#pragma unroll
    for (int j = 0; j < 32; ++j) { const int d = lane + 64 * j; const float o = v[j] * r * lg[d] + lb[d]; xo[(size_t)t * D + d] = o; if (h) h[(size_t)t * D + d] = o * (1.f + m[sc_off + d]) + m[sh_off + d]; }
}
__global__ __launch_bounds__(256) void k_silu_mul(float* __restrict__ g, const float* __restrict__ u, const int* __restrict__ cnts, int e) {
    const size_t i = (size_t)blockIdx.x * 256 + threadIdx.x; const int row = (int)(i / 512);
    if (row >= cnts[e]) return;
    const float a = g[i]; g[i] = a / (1.f + expf(-a)) * u[i];
}
__global__ __launch_bounds__(256) void k_zero(float* p, size_t n) { const size_t i = (size_t)blockIdx.x * 256 + threadIdx.x; if (i < n) p[i] = 0.f; }
__global__ __launch_bounds__(256) void k_iota(int* list, float* w, int* starts, int* cnts) { const int i = blockIdx.x * 256 + threadIdx.x; if (i < T) { list[i] = i; w[i] = 1.f; } if (i == 0) { starts[0] = 0; cnts[0] = T; } }

}
namespace rt {
__device__ __forceinline__ void route_token(const float logit, const float bias, int lane, unsigned long long& mask, float& w) {
    const float score = 1.f / (1.f + expf(-logit));
    const float sel = score + bias;
    const int gbase = lane & ~7;
    int r = 0;
#pragma unroll
    for (int k = 0; k < 8; ++k) { const float o = __shfl(sel, gbase + k); const int j = gbase + k; r += (o > sel || (o == sel && j < lane)) ? 1 : 0; }
    float gs = (r < 2) ? sel : 0.f;
    gs += __shfl_xor(gs, 1); gs += __shfl_xor(gs, 2); gs += __shfl_xor(gs, 4);
    const int g = lane >> 3; int gr = 0;
#pragma unroll
    for (int k = 0; k < 8; ++k) { const float o = __builtin_bit_cast(float, __builtin_amdgcn_readlane(__builtin_bit_cast(int, gs), 8 * k)); gr += (o > gs || (o == gs && k < g)) ? 1 : 0; }
    const float m = (gr < 4) ? sel : -__builtin_inff();
    int er = 0;
#pragma unroll
    for (int k = 0; k < 64; ++k) { const float o = __builtin_bit_cast(float, __builtin_amdgcn_readlane(__builtin_bit_cast(int, m), k)); er += (o > m || (o == m && k < lane)) ? 1 : 0; }
    const bool chosen = er < 8;
    mask = __ballot(chosen);
    float ws = chosen ? score : 0.f;
#pragma unroll
    for (int o = 1; o < 64; o <<= 1) ws += __shfl_xor(ws, o);
    w = chosen ? score / ws * 2.5f : 0.f;
}
template <int CTRL> __device__ __forceinline__ float dpp_maxf(float x) { return fmaxf(x, __builtin_bit_cast(float, __builtin_amdgcn_update_dpp(__builtin_bit_cast(int, x), __builtin_bit_cast(int, x), CTRL, 0xf, 0xf, false))); }
__device__ __forceinline__ float grp8_max(float x) { x = dpp_maxf<0xB1>(x); x = dpp_maxf<0x4E>(x); return dpp_maxf<0x141>(x); }
template <int CTRL, int ROWMASK> __device__ __forceinline__ float dpp_maxf_rm(float x) { return fmaxf(x, __builtin_bit_cast(float, __builtin_amdgcn_update_dpp(__builtin_bit_cast(int, x), __builtin_bit_cast(int, x), CTRL, ROWMASK, 0xf, false))); }
__device__ __forceinline__ void route_token_fast(const float logit, const float bias, int lane, unsigned long long& mask, float& w) {
    const float score = __builtin_amdgcn_rcpf(1.f + __expf(-logit));
    const float sel = score + bias;
    const float NINF = -__builtin_inff();
    const float m1 = grp8_max(sel);
    const unsigned long long eq1 = __ballot(sel == m1);
    const unsigned gb = (unsigned)(eq1 >> (lane & ~7)) & 0xffu;
    const int first = __builtin_ctz(gb);
    const float m2 = grp8_max(((lane & 7) == first) ? NINF : sel);
    const float gs = m1 + m2;
    const int g = lane >> 3; int gr = 0;
#pragma unroll
    for (int k = 0; k < 8; ++k) { const float o = __builtin_bit_cast(float, __builtin_amdgcn_readlane(__builtin_bit_cast(int, gs), 8 * k)); gr += (o > gs || (o == gs && k < g)) ? 1 : 0; }
    float m = (gr < 4) ? sel : NINF;
    unsigned long long chosen = 0ull; float ws = 0.f;
#pragma unroll
    for (int it = 0; it < 8; ++it) {
        float r = grp8_max(m); r = dpp_maxf<0x140>(r);
        r = dpp_maxf_rm<0x142, 0xA>(r); r = dpp_maxf_rm<0x143, 0xC>(r);
        const float gm = __builtin_bit_cast(float, __builtin_amdgcn_readlane(__builtin_bit_cast(int, r), 63));
        const unsigned long long eq = __ballot(m == gm);
        const int idx = __builtin_amdgcn_readfirstlane((int)__builtin_ctzll(eq));
        chosen |= 1ull << idx;
        ws += __builtin_bit_cast(float, __builtin_amdgcn_readlane(__builtin_bit_cast(int, score), idx));
        m = (lane == idx) ? NINF : m;
    }
    mask = chosen;
    const bool c = (chosen >> lane) & 1ull;
    w = c ? score * (2.5f * __builtin_amdgcn_rcpf(ws)) : 0.f;
}
__device__ __forceinline__ void route_block(int blk, const float* __restrict__ logits, const float* __restrict__ rbias, unsigned long long* __restrict__ tokmask, float* __restrict__ tw, int* __restrict__ hist,
                                            unsigned long long* lds_mask  , int nwaves) {
    const int wave = threadIdx.x >> 6, lane = threadIdx.x & 63;
    const float bias = rbias[lane];
    for (int i = wave; i < 64; i += nwaves) {
        const int t = blk * 64 + i; unsigned long long mask; float w;
        route_token(logits[(size_t)t * 64 + lane], bias, lane, mask, w);
        tw[(size_t)t * 64 + lane] = w;
        if (lane == 0) { tokmask[t] = mask; lds_mask[i] = mask; }
    }
    __syncthreads();
    if (threadIdx.x < 64) { int c = 0; for (int i = 0; i < 64; ++i) c += (int)((lds_mask[i] >> threadIdx.x) & 1ull); hist[blk * 64 + threadIdx.x] = c; }
    __syncthreads();
}
__device__ __forceinline__ void scatter_block(int blk, const int* __restrict__ hist, const unsigned long long* __restrict__ tokmask, const float* __restrict__ tw,
                                              int* __restrict__ stok, float* __restrict__ sw, int* __restrict__ tokpos, int* __restrict__ starts, int* __restrict__ cnts, int* lds_i  ) {
    const int e = threadIdx.x;
    if (e < 64) { int tot = 0, before = 0; for (int b = 0; b < 256; ++b) { const int c = hist[b * 64 + e]; tot += c; if (b < blk) before += c; }
        lds_i[e] = tot; lds_i[64 + e] = before; }
    __syncthreads();
    if (e < 64) { int st = 0; for (int j = 0; j < e; ++j) st += lds_i[j];
        if (blk == 0) { starts[e] = st; cnts[e] = lds_i[e]; }
        int pos = st + lds_i[64 + e];
        for (int i = 0; i < 64; ++i) { const int t = blk * 64 + i; const unsigned long long m = tokmask[t];
            if ((m >> e) & 1ull) { stok[pos] = t; sw[pos] = tw[(size_t)t * 64 + e]; tokpos[t * 8 + __popcll(m & ((1ull << e) - 1ull))] = pos; ++pos; } } }
    __syncthreads();
}
__global__ __launch_bounds__(256) void k_route(const float* logits, const float* rbias, unsigned long long* tokmask, float* tw, int* hist) {
    __shared__ unsigned long long lm[64];
    route_block(blockIdx.x, logits, rbias, tokmask, tw, hist, lm, 4);
}
__global__ __launch_bounds__(256) void k_scatter(const int* hist, const unsigned long long* tokmask, const float* tw, int* stok, float* sw, int* tokpos, int* starts, int* cnts) {
    __shared__ int li[128];
    scatter_block(blockIdx.x, hist, tokmask, tw, stok, sw, tokpos, starts, cnts, li);
}
}
namespace nvh {
constexpr size_t O_MOD = 0;
constexpr size_t O_CS128 = 1 * MiB;
constexpr size_t O_CS64 = 2 * MiB;
constexpr size_t O_KMEAN = 3 * MiB;
constexpr size_t O_HIST = 4 * MiB;
constexpr size_t O_STARTS = 4 * MiB + 128 * 1024;
constexpr size_t O_CNTS = 4 * MiB + 192 * 1024;
constexpr size_t O_TOKMASK = 5 * MiB;
constexpr size_t O_TOKPOS = 6 * MiB;
constexpr size_t O_STOK = 7 * MiB;
constexpr size_t O_SW = 8 * MiB;
constexpr size_t O_TW = 9 * MiB;
constexpr size_t O_LOGITS = 13 * MiB;
constexpr size_t O_SHLIST = 17 * MiB;
constexpr size_t O_R1 = 20 * MiB;
constexpr size_t O_PROJ = 148 * MiB;
constexpr size_t O_CQN = O_R1;
constexpr size_t O_CKVN = O_R1 + 32 * MiB;
constexpr size_t O_QM = 408 * MiB;
constexpr size_t O_KV = 504 * MiB;
constexpr size_t O_GE = O_PROJ + 128 * MiB;
constexpr size_t O_END = 632 * MiB;
struct Hooks { void (*after_mod)(void*, hipStream_t); void (*after_proj)(void*, hipStream_t); void (*after_mla)(void*, hipStream_t); void (*after_attn)(void*, hipStream_t); void* ctx; };

static void run(void* const* d_in, float* out, unsigned char* ws, hipStream_t st, const Hooks* hk = nullptr) {
    const float *x = (const float*)d_in[0], *c = (const float*)d_in[1], *w_ada = (const float*)d_in[2], *b_ada = (const float*)d_in[3], *w_in = (const float*)d_in[4], *g_cq = (const float*)d_in[5],
                *w_uq = (const float*)d_in[6], *g_ckv = (const float*)d_in[7], *w_ukv = (const float*)d_in[8], *w_o = (const float*)d_in[9], *ln1_g = (const float*)d_in[10], *ln1_b = (const float*)d_in[11],
                *w_router = (const float*)d_in[12], *rbias = (const float*)d_in[13], *w_gate = (const float*)d_in[14], *w_up = (const float*)d_in[15], *w_down = (const float*)d_in[16],
                *ws_gate = (const float*)d_in[17], *ws_up = (const float*)d_in[18], *ws_down = (const float*)d_in[19], *ln2_g = (const float*)d_in[20], *ln2_b = (const float*)d_in[21];
    float* mod = (float*)(ws + O_MOD); float2* cs128 = (float2*)(ws + O_CS128); float2* cs64 = (float2*)(ws + O_CS64); float* kmean = (float*)(ws + O_KMEAN);
    int* hist = (int*)(ws + O_HIST); int* starts = (int*)(ws + O_STARTS); int* cnts = (int*)(ws + O_CNTS); unsigned long long* tokmask = (unsigned long long*)(ws + O_TOKMASK);
    int* tokpos = (int*)(ws + O_TOKPOS); int* stok = (int*)(ws + O_STOK); float* sw = (float*)(ws + O_SW); float* tw = (float*)(ws + O_TW); float* logits = (float*)(ws + O_LOGITS);
    int* shlist = (int*)(ws + O_SHLIST); float* shw = (float*)(ws + O_SHLIST + 64 * 1024); int* shstarts = (int*)(ws + O_SHLIST + 128 * 1024); int* shcnts = (int*)(ws + O_SHLIST + 129 * 1024);
    float* r1 = (float*)(ws + O_R1); float* proj = (float*)(ws + O_PROJ); float* x1 = proj; float* cqn = (float*)(ws + O_CQN); float* ckvn = (float*)(ws + O_CKVN);
    float* qm = (float*)(ws + O_QM); float* out2 = qm; float* kv = (float*)(ws + O_KV); float* mix = out; float* Ge = (float*)(ws + O_GE); float* Ue = Ge + (size_t)16384 * 512;
    const int* ni = nullptr; const float* nf = nullptr;
    nv::k_mod<<<dim3(6 * D / 256, Bn), 256, 0, st>>>(c, w_ada, b_ada, mod);
    nv::k_rope_tab<<<S * 64 / 256, 256, 0, st>>>(cs128, cs64);
    if (hk && hk->after_mod) hk->after_mod(hk->ctx, st);
    nv::k_modulate<<<(unsigned)((size_t)T * D / 256), 256, 0, st>>>(x, mod, 0, D, r1);
    nv::k_gemm<0, false><<<dim3(INW / 64, T / 64), 256, 0, st>>>(r1, w_in, proj, T, INW, D, D, INW, INW, ni, nf, ni, ni, 0);
    nv::k_rope_proj<<<T, 256, 0, st>>>(proj, cs128, cs64);
    nv::k_kmean<<<Bn * 8 * 8, 128, 0, st>>>(proj, kmean);
    if (hk && hk->after_proj) hk->after_proj(hk->ctx, st);
    nv::k_rms<<<T / 4, 256, 0, st>>>(proj, 3072, g_cq, cqn);
    nv::k_rms<<<T / 4, 256, 0, st>>>(proj, 3584, g_ckv, ckvn);
    nv::k_gemm<0, false><<<dim3(1536 / 64, T / 64), 256, 0, st>>>(cqn, w_uq, qm, T, 1536, 512, 512, 1536, 1536, ni, nf, ni, ni, 0);
    nv::k_gemm<0, false><<<dim3(2048 / 64, T / 64), 256, 0, st>>>(ckvn, w_ukv, kv, T, 2048, 512, 512, 2048, 2048, ni, nf, ni, ni, 0);
    nv::k_rope_qm<<<T, 256, 0, st>>>(qm, cs64);
    if (hk && hk->after_mla) hk->after_mla(hk->ctx, st);
    nv::k_attn<true><<<T * 8 / 4, 256, 0, st>>>(proj, qm, kv, kmean, mix);
    nv::k_attn<false><<<T * 8 / 4, 256, 0, st>>>(proj, qm, kv, kmean, mix);
    if (hk && hk->after_attn) hk->after_attn(hk->ctx, st);
    nv::k_gemm<0, false><<<dim3(D / 64, T / 64), 256, 0, st>>>(mix, w_o, r1, T, D, D, D, D, D, ni, nf, ni, ni, 0);
    nv::k_ln<<<T / 4, 256, 0, st>>>(x, r1, mod, 2 * D, ln1_g, ln1_b, x1, r1, 3 * D, 4 * D);
    nv::k_gemm<0, false><<<dim3(1, T / 64), 256, 0, st>>>(r1, w_router, logits, T, 64, D, D, 64, 64, ni, nf, ni, ni, 0);
    rt::k_route<<<256, 256, 0, st>>>(logits, rbias, tokmask, tw, hist);
    rt::k_scatter<<<256, 256, 0, st>>>(hist, tokmask, tw, stok, sw, tokpos, starts, cnts);
    nv::k_zero<<<(unsigned)((size_t)T * D / 256), 256, 0, st>>>(out2, (size_t)T * D);
    nv::k_iota<<<T / 256, 256, 0, st>>>(shlist, shw, shstarts, shcnts);
    for (int e = 0; e <= 64; ++e) {
        const float* wg = e < 64 ? w_gate + (size_t)e * D * 512 : ws_gate; const float* wu = e < 64 ? w_up + (size_t)e * D * 512 : ws_up; const float* wd = e < 64 ? w_down + (size_t)e * 512 * D : ws_down;
        const int* lst = e < 64 ? stok : shlist; const float* wt = e < 64 ? sw : shw; const int* stt = e < 64 ? starts : shstarts; const int* cn = e < 64 ? cnts : shcnts; const int ee = e < 64 ? e : 0;
        nv::k_gemm<1, true><<<dim3(512 / 64, 16384 / 64), 256, 0, st>>>(r1, wg, Ge, T, 512, D, D, 512, 512, lst, wt, stt, cn, ee);
        nv::k_gemm<1, true><<<dim3(512 / 64, 16384 / 64), 256, 0, st>>>(r1, wu, Ue, T, 512, D, D, 512, 512, lst, wt, stt, cn, ee);
        nv::k_silu_mul<<<16384 * 512 / 256, 256, 0, st>>>(Ge, Ue, cn, ee);
        nv::k_gemm<2, true><<<dim3(D / 64, 16384 / 64), 256, 0, st>>>(Ge, wd, out2, T, D, 512, 512, D, D, lst, wt, stt, cn, ee);
    }
    nv::k_ln<<<T / 4, 256, 0, st>>>(x1, out2, mod, 5 * D, ln2_g, ln2_b, out, nullptr, 0, 0);
}
}
#ifndef MK_WT_LAST
#define MK_WT_LAST 0
#endif
#ifndef MK_ZERO64
#define MK_ZERO64 1
#endif
#ifndef MK_LDSX
#define MK_LDSX 0
#endif
#define LAS __attribute__((address_space(3)))
#define GAS __attribute__((address_space(1)))
typedef unsigned short bf16_t;
typedef short bf16x8 __attribute__((ext_vector_type(8)));
typedef short s16x4 __attribute__((ext_vector_type(4)));
typedef float f32x4 __attribute__((ext_vector_type(4)));
typedef float f32x16 __attribute__((ext_vector_type(16)));
typedef unsigned u32x4 __attribute__((ext_vector_type(4)));
typedef unsigned u32x2 __attribute__((ext_vector_type(2)));

__device__ __forceinline__ unsigned cvt_pk_bf16(float lo, float hi) { unsigned r; asm volatile("v_cvt_pk_bf16_f32 %0, %1, %2" : "=v"(r) : "v"(lo), "v"(hi)); return r; }
__device__ __forceinline__ unsigned f2bf(float f) { unsigned u = __builtin_bit_cast(unsigned, f); return (u + 0x7fffu + ((u >> 16) & 1u)) >> 16; }
__device__ __forceinline__ float bf2f(unsigned b) { return __builtin_bit_cast(float, b << 16); }
__device__ __forceinline__ unsigned pk2(float lo, float hi) { return f2bf(lo) | (f2bf(hi) << 16); }
#ifndef MK_ST_WT
#define MK_ST_WT 0
#endif
__device__ __forceinline__ void st16_wt(void* p, u32x4 v) { asm volatile("global_store_dwordx4 %0, %1, off sc1\n\ts_nop 1" :: "v"(p), "v"(v) : "memory"); }
#if MK_ST_WT
#define ST16NT(ptr, val) st16_wt((void*)(ptr), (val))
#else
#define ST16NT(ptr, val) (*(u32x4*)(ptr) = (val))
#endif
__device__ __forceinline__ unsigned pk4_fp8(float a, float b, float c, float d) { unsigned w = 0u; w = __builtin_amdgcn_cvt_pk_fp8_f32(a, b, w, false); w = __builtin_amdgcn_cvt_pk_fp8_f32(c, d, w, true); return w; }
__device__ __forceinline__ float siluf(float a) { return a * __builtin_amdgcn_rcpf(1.f + __expf(-a)); }

#define XB_TMO      128
#define XB_XCNT(j)  (256  + 64 * (j))
#define XB_XSUB(j)  (1280 + 64 * (j))
#define XB_XGEN(j)  (2304 + 64 * (j))
#define XB_TOP      3328
#define XB_TOPGEN   3392
#define XCD_BAR_WORDS 3456
#define XB_SPIN_CAP (1u << 18)

__device__ __forceinline__ unsigned xb_ld(unsigned* p)              { return __hip_atomic_load(p, __ATOMIC_RELAXED, __HIP_MEMORY_SCOPE_AGENT); }
__device__ __forceinline__ unsigned xb_add(unsigned* p, unsigned v) { return __hip_atomic_fetch_add(p, v, __ATOMIC_RELAXED, __HIP_MEMORY_SCOPE_AGENT); }
__device__ __forceinline__ unsigned xb_xcc_id() { return (unsigned)__builtin_amdgcn_s_getreg((3 << 11) | 20) & 0xFu; }
#define XB_SPIN(cond, bar) do { unsigned _sp = 0; while (cond) { __builtin_amdgcn_s_sleep(1); \
    if ((++_sp & 255u) == 0u) { if (xb_ld(&(bar)[XB_TMO])) break; if (_sp > XB_SPIN_CAP) { atomicAdd(&(bar)[XB_TMO], 1u); break; } } } } while (0)

struct XcdBarrier {
    unsigned* bar; unsigned x;
    volatile LAS unsigned* st;
};
__device__ __forceinline__ XcdBarrier xcd_barrier_post(unsigned* bar, volatile LAS unsigned* st) {
    XcdBarrier b; b.bar = bar; b.x = xb_xcc_id(); b.st = st;
    if (threadIdx.x == 0) (void)xb_add(&bar[XB_XCNT(b.x)], 1u);
    return b;
}
__device__ __forceinline__ void xcd_barrier_complete(unsigned* bar, unsigned x, unsigned& nloc, unsigned& nx) {
    const unsigned G = gridDim.x * gridDim.y * gridDim.z;
    unsigned sum, cnt, mine, sp = 0u;
    for (;;) {
        sum = 0u; cnt = 0u; mine = 0u;
#pragma unroll
        for (unsigned j = 0; j < 16; ++j) { const unsigned c = xb_ld(&bar[XB_XCNT(j)]); sum += c; cnt += (c > 0u) ? 1u : 0u; mine = (j == x) ? c : mine; }
        if (sum == G) break;
        __builtin_amdgcn_s_sleep(1);
        if ((++sp & 255u) == 0u) { if (xb_ld(&bar[XB_TMO])) break; if (sp > XB_SPIN_CAP) { atomicAdd(&bar[XB_TMO], 1u); break; } }
    }
    nloc = mine > 0u ? mine : 1u; nx = cnt > 0u ? cnt : 1u;
}
__device__ __forceinline__ void xcd_barrier(const XcdBarrier& b) {
    asm volatile("s_waitcnt vmcnt(0)" ::: "memory");
    __syncthreads();
    if (threadIdx.x == 0) {
        unsigned* bar = b.bar;
        __builtin_amdgcn_s_waitcnt(0);
        unsigned nloc = b.st[0], nx = b.st[1];
        if (nloc == 0u) { xcd_barrier_complete(bar, b.x, nloc, nx); b.st[0] = nloc; b.st[1] = nx; }
        const unsigned old = xb_add(&bar[XB_XSUB(b.x)], 1u);
        const unsigned gen = old / nloc;
        if (old + 1u == (gen + 1u) * nloc) {
            __builtin_amdgcn_fence(__ATOMIC_RELEASE, "agent");
            asm volatile("s_waitcnt vmcnt(0)" ::: "memory");
            const unsigned og = xb_add(&bar[XB_TOP], 1u);
            const unsigned tg = og / nx;
            if (og + 1u == (tg + 1u) * nx) xb_add(&bar[XB_TOPGEN], 1u);
            else XB_SPIN(xb_ld(&bar[XB_TOPGEN]) == tg, bar);
            __builtin_amdgcn_fence(__ATOMIC_ACQUIRE, "agent");
            xb_add(&bar[XB_XGEN(b.x)], 1u);
            asm volatile("s_waitcnt vmcnt(0)" ::: "memory");
        } else {
            XB_SPIN(xb_ld(&bar[XB_XGEN(b.x)]) == gen, bar);
            __builtin_amdgcn_fence(__ATOMIC_ACQUIRE, "agent");
            asm volatile("s_waitcnt vmcnt(0)" ::: "memory");
        }
    }
    __syncthreads();
}

namespace pg8 {
constexpr int BM = 256, BK = 64, HALF = 128, HTB = HALF * BK * 2  , STAGE_BYTES = 8 * HTB, NXCD = 8;

__host__ __device__ __forceinline__ int lds_byte(int r, int c) { const int st = (r >> 4) * 2 + (c >> 5), rr = r & 15, cc = c & 31, ob = rr * 64 + cc * 2; return st * 1024 + (ob ^ (((ob >> 9) & 1) << 5)); }
__host__ __device__ __forceinline__ void stage_rc(int b, int& R, int& C) { const int st = b / 1024, sb = b % 1024, swz = sb ^ (((sb >> 9) & 1) << 5); R = (st >> 1) * 16 + swz / 64; C = (st & 1) * 32 + (swz % 64) / 2; }
__host__ __device__ __forceinline__ int perm32(int rho) { const int n = rho >> 4, i = rho & 15; return 8 * (i >> 2) + 4 * n + (i & 3); }

struct Unit { const char* a; const char* b; const int* rows; int nvalid; int pm, pn, kind, aux; int wt; };

__host__ __device__ __forceinline__ int xcd_remap(int L, int nwg) { const int q = nwg / NXCD, r = nwg % NXCD, xcd = L % NXCD, off = L / NXCD; return (xcd < r ? xcd * (q + 1) : r * (q + 1) + (xcd - r) * q) + off; }

#ifndef MK_ALIGN
#define MK_ALIGN true
#endif
#ifndef MK_SP2
#define MK_SP2 true
#endif
typedef int v8i __attribute__((ext_vector_type(8)));
typedef int v4i __attribute__((ext_vector_type(4)));
template <class Epi, class Sched, bool GATHER, bool F8 = false, bool ALIGN_EPI = MK_ALIGN, bool SP2 = MK_SP2>
__device__ __forceinline__ void gemm_phase(LAS unsigned char* lds, const int rowbytes, const Sched& S, const Epi& E, const unsigned delay_ticks = 0u, const int sc_w = 0x79797979, const int sc_a = 0x7f7f7f7f) {
    if (delay_ticks) { const unsigned long long t0_ = wall_clock64(); while (wall_clock64() - t0_ < (unsigned long long)delay_ticks) __builtin_amdgcn_s_sleep(8); }
    const int tid = threadIdx.x, wid = __builtin_amdgcn_readfirstlane(tid >> 6), lane = tid & 63, wr = wid >> 2, wc = wid & 3, fr = lane & 15, fq = lane >> 4;
    const int nt = rowbytes / 128;
    unsigned voffB[2];
#pragma unroll
    for (int i = 0; i < 2; ++i) { int R, C; stage_rc(tid * 16 + i * 8192, R, C); const int Rb = Epi::B64 ? ((R >> 5) * 64 + perm32(R & 31)) : Epi::PERM ? ((R & ~31) + perm32(R & 31)) : R;
        voffB[i] = (unsigned)(Rb * rowbytes + C * 2); }
    const size_t kstep = (size_t)(BK * 2);
    const size_t hstep = (size_t)(Epi::B64 ? 32 : HALF) * rowbytes;
    const unsigned ldsw = (unsigned)wid * 1024u;
    const int xs0 = (F8 && MK_LDSX) ? ((fq >> 1) << 4) : 0, xs1 = xs0 ^ 16;
    const int aoff = F8 ? lds_byte(wr * 64 + fr, fq * 16) : lds_byte(wr * 64 + fr, fq * 8), boff = F8 ? lds_byte(wc * 32 + fr, fq * 16) : lds_byte(wc * 32 + fr, fq * 8);
#define PG8_SA(b, h) (((b) * 2 + (h)) * HTB)
#define PG8_SB(b, h) ((4 + (b) * 2 + (h)) * HTB)
#ifndef EXP_MMA_DUP
#define EXP_MMA_DUP 0
#endif
#ifdef EXP_STAGE_DUP
#define PG8_STAGE(bufoff, gbase, voff) do { _Pragma("unroll") for (int _i = 0; _i < 2; ++_i) { \
        __builtin_amdgcn_global_load_lds((const unsigned*)((const char*)(gbase) + (voff)[_i] + EXP_STAGE_DUP), (LAS unsigned*)(lds + (bufoff) + ldsw + _i * 8192), 16, 0, 0); \
        __builtin_amdgcn_global_load_lds((const unsigned*)((const char*)(gbase) + (voff)[_i]), (LAS unsigned*)(lds + (bufoff) + ldsw + _i * 8192), 16, 0, 0); } } while (0)
#else
#define PG8_STAGE(bufoff, gbase, voff) do { _Pragma("unroll") for (int _i = 0; _i < 2; ++_i) \
        __builtin_amdgcn_global_load_lds((const unsigned*)((const char*)(gbase) + (voff)[_i]), (LAS unsigned*)(lds + (bufoff) + ldsw + _i * 8192), 16, 0, 0); } while (0)
#endif
#define PG8_LD32(p) __builtin_shufflevector(*(const LAS v4i*)((p) + xs0), *(const LAS v4i*)((p) + xs1), 0, 1, 2, 3, 4, 5, 6, 7)
#define PG8_LDA(dst, b, h) do { if constexpr (F8) { _Pragma("unroll") for (int m = 0; m < 4; ++m) dst##8[m] = PG8_LD32(lds + PG8_SA(b, h) + aoff + m * 2048); } \
        else { _Pragma("unroll") for (int m = 0; m < 4; ++m) _Pragma("unroll") for (int k = 0; k < 2; ++k) dst[m][k] = *(const LAS bf16x8*)(lds + PG8_SA(b, h) + aoff + m * 2048 + k * 1024); } } while (0)
#define PG8_LDB(dst, b, h) do { if constexpr (F8) { _Pragma("unroll") for (int n = 0; n < 2; ++n) dst##8[n] = PG8_LD32(lds + PG8_SB(b, h) + boff + n * 2048); } \
        else { _Pragma("unroll") for (int n = 0; n < 2; ++n) _Pragma("unroll") for (int k = 0; k < 2; ++k) dst[n][k] = *(const LAS bf16x8*)(lds + PG8_SB(b, h) + boff + n * 2048 + k * 1024); } } while (0)
#define PG8_MMA(ai, bj, At, Bt) do { __builtin_amdgcn_s_setprio(1); if constexpr (F8) { _Pragma("unroll") for (int m = 0; m < 4; ++m) _Pragma("unroll") for (int n = 0; n < 2; ++n) \
        { acc[ai][bj][m][n] = __builtin_amdgcn_mfma_scale_f32_16x16x128_f8f6f4(Bt##8[n], At##8[m], acc[ai][bj][m][n], 0, 0, 0, sc_w - EXP_MMA_DUP * 0x01010101, 0, sc_a); \
          if (EXP_MMA_DUP) acc[ai][bj][m][n] = __builtin_amdgcn_mfma_scale_f32_16x16x128_f8f6f4(Bt##8[n], At##8[m], acc[ai][bj][m][n], 0, 0, 0, sc_w - EXP_MMA_DUP * 0x01010101, 0, sc_a); } } \
        else { _Pragma("unroll") for (int m = 0; m < 4; ++m) _Pragma("unroll") for (int n = 0; n < 2; ++n) _Pragma("unroll") for (int k = 0; k < 2; ++k) \
        acc[ai][bj][m][n] = __builtin_amdgcn_mfma_f32_16x16x32_bf16(Bt[n][k], At[m][k], acc[ai][bj][m][n], 0, 0, 0); } __builtin_amdgcn_s_setprio(0); } while (0)
#ifdef EXP_STAGE_DUP
#define PG8_WAIT_V(n) asm volatile("s_waitcnt vmcnt(%0)" :: "i"(2 * (n)) : "memory")
#else
#define PG8_WAIT_V(n) asm volatile("s_waitcnt vmcnt(" #n ")" ::: "memory")
#endif
#define PG8_WAIT_L(n) asm volatile("s_waitcnt lgkmcnt(" #n ")" ::: "memory")
#define PG8_BAR __builtin_amdgcn_s_barrier()
#define PG8_SCHED __builtin_amdgcn_sched_barrier(0)
#define PG8_STAGE_A(bufoff, ubase, gv, koff, h) PG8_STAGE(bufoff, (ubase) + (koff), gv[h])
#define PG8_GSWITCH() do { if constexpr (GATHER) { if (last && has_next) { _Pragma("unroll") for (int h_ = 0; h_ < 2; ++h_) _Pragma("unroll") for (int i_ = 0; i_ < 2; ++i_) \
        { int R_, C_; stage_rc(tid * 16 + i_ * 8192, R_, C_); gcur[h_][i_] = (unsigned)rnx[h_][i_] * (unsigned)rowbytes + (unsigned)C_ * 2u; } } } } while (0)
    Unit cur, nxt; int ui = 0;
    if (!S.next(0, cur)) return;
    f32x4 acc[2][2][4][2];
#pragma unroll
    for (int a = 0; a < 2; ++a)
#pragma unroll
        for (int b = 0; b < 2; ++b)
#pragma unroll
            for (int m = 0; m < 4; ++m)
#pragma unroll
                for (int n = 0; n < 2; ++n) acc[a][b][m][n] = (f32x4){0.f, 0.f, 0.f, 0.f};
    bf16x8 At[4][2], B0[2][2], B1[2][2]; v8i At8[4], B08[2], B18[2];
    unsigned gcur[2][2]; int rnx[2][2];
#pragma unroll
    for (int h = 0; h < 2; ++h)
#pragma unroll
        for (int i = 0; i < 2; ++i) { int R, C; stage_rc(tid * 16 + i * 8192, R, C); const int r = R + h * HALF; int row = r; if constexpr (GATHER) row = (r < cur.nvalid) ? (cur.rows ? cur.rows[r] : r) : 0;
            gcur[h][i] = (unsigned)row * (unsigned)rowbytes + (unsigned)C * 2u; rnx[h][i] = 0; }
    const char* cA = cur.a; const char* cB = cur.b;
    if constexpr (Epi::PREF) E.prefetch(cur, lds, 0, tid);
    if constexpr (SP2) {
        PG8_STAGE(PG8_SB(0, 0), cB, voffB); PG8_STAGE(PG8_SB(0, 1), cB + hstep, voffB); PG8_STAGE_A(PG8_SA(0, 0), cA, gcur, 0, 0); PG8_STAGE_A(PG8_SA(0, 1), cA, gcur, 0, 1);
        if (wr == 1) PG8_BAR;
        PG8_WAIT_V(2); PG8_BAR;
        PG8_STAGE(PG8_SB(1, 0), cB + kstep, voffB); PG8_STAGE_A(PG8_SA(1, 0), cA, gcur, kstep, 0); PG8_STAGE(PG8_SB(1, 1), cB + hstep + kstep, voffB);
        PG8_WAIT_V(6); PG8_BAR;
    } else {
        PG8_STAGE(PG8_SB(0, 0), cB, voffB); PG8_STAGE_A(PG8_SA(0, 0), cA, gcur, 0, 0); PG8_STAGE(PG8_SB(0, 1), cB + hstep, voffB); PG8_STAGE_A(PG8_SA(0, 1), cA, gcur, 0, 1);
        if (wr == 1) PG8_BAR;
        PG8_WAIT_V(4); PG8_BAR;
        PG8_STAGE(PG8_SB(1, 0), cB + kstep, voffB); PG8_STAGE_A(PG8_SA(1, 0), cA, gcur, kstep, 0); PG8_STAGE(PG8_SB(1, 1), cB + hstep + kstep, voffB);
        PG8_WAIT_V(6); PG8_BAR;
    }
    for (;;) {
        const bool has_next = S.next(ui + 1, nxt);
        const char* nA = has_next ? nxt.a : cA; const char* nB = has_next ? nxt.b : cB;
        if constexpr (GATHER) { if (has_next) {
#pragma unroll
            for (int h = 0; h < 2; ++h)
#pragma unroll
                for (int i = 0; i < 2; ++i) { int R, C; stage_rc(tid * 16 + i * 8192, R, C); const int r = R + h * HALF; rnx[h][i] = (r < nxt.nvalid) ? (nxt.rows ? nxt.rows[r] : r) : 0; } } }
#pragma unroll 1
        for (int t = 0; t < nt; t += 2) {
            const bool last = (t == nt - 2);
            const size_t k1 = (size_t)(t + 1) * kstep;
            const char* a2 = last ? nA : cA; const char* b2 = last ? nB : cB + (size_t)(t + 2) * kstep;
            const size_t k2 = last ? 0 : (size_t)(t + 2) * kstep, k3 = k2 + kstep;
            const char* b3 = b2 + kstep;
            if constexpr (SP2) {
            PG8_LDB(B0, 0, 0); PG8_LDB(B1, 0, 1); PG8_SCHED; PG8_LDA(At, 0, 0); PG8_STAGE_A(PG8_SA(1, 1), cA, gcur, k1, 1); PG8_GSWITCH();
            PG8_WAIT_V(8); PG8_WAIT_L(0); PG8_BAR; PG8_MMA(0, 0, At, B0); PG8_MMA(0, 1, At, B1); PG8_BAR; PG8_SCHED;
            PG8_LDA(At, 0, 1); PG8_STAGE(PG8_SB(0, 0), b2, voffB); PG8_STAGE(PG8_SB(0, 1), b2 + hstep, voffB); PG8_STAGE_A(PG8_SA(0, 0), a2, gcur, k2, 0);
            PG8_WAIT_V(8); PG8_WAIT_L(0); PG8_BAR; PG8_MMA(1, 0, At, B0); PG8_MMA(1, 1, At, B1); PG8_BAR; PG8_SCHED;
            PG8_LDB(B0, 1, 0); PG8_LDB(B1, 1, 1); PG8_SCHED; PG8_LDA(At, 1, 0); PG8_STAGE_A(PG8_SA(0, 1), a2, gcur, k2, 1);
            PG8_WAIT_V(8); PG8_WAIT_L(0); PG8_BAR; PG8_MMA(0, 0, At, B0); PG8_MMA(0, 1, At, B1); PG8_BAR; PG8_SCHED;
            PG8_LDA(At, 1, 1); PG8_STAGE(PG8_SB(1, 0), b3, voffB); PG8_STAGE(PG8_SB(1, 1), b3 + hstep, voffB); PG8_STAGE_A(PG8_SA(1, 0), a2, gcur, k3, 0);
            PG8_WAIT_V(8); PG8_WAIT_L(0); PG8_BAR; PG8_MMA(1, 0, At, B0); PG8_MMA(1, 1, At, B1); PG8_BAR; PG8_SCHED;
            } else {
            PG8_LDB(B0, 0, 0); PG8_SCHED; PG8_LDA(At, 0, 0); PG8_STAGE_A(PG8_SA(1, 1), cA, gcur, k1, 1); PG8_GSWITCH();
            PG8_WAIT_L(8); PG8_BAR; PG8_WAIT_L(0); PG8_MMA(0, 0, At, B0); PG8_BAR; PG8_SCHED;
            PG8_LDB(B1, 0, 1); PG8_STAGE(PG8_SB(0, 0), b2, voffB);
            PG8_BAR; PG8_WAIT_L(0); PG8_MMA(0, 1, At, B1); PG8_BAR;
            PG8_LDA(At, 0, 1); PG8_STAGE_A(PG8_SA(0, 0), a2, gcur, k2, 0);
            PG8_BAR; PG8_WAIT_L(0); PG8_MMA(1, 0, At, B0); PG8_BAR; PG8_SCHED;
            PG8_STAGE(PG8_SB(0, 1), b2 + hstep, voffB);
            PG8_WAIT_V(6); PG8_BAR; PG8_MMA(1, 1, At, B1); PG8_BAR;
            PG8_LDB(B0, 1, 0); PG8_SCHED; PG8_LDA(At, 1, 0); PG8_STAGE_A(PG8_SA(0, 1), a2, gcur, k2, 1);
            PG8_WAIT_L(8); PG8_BAR; PG8_WAIT_L(0); PG8_MMA(0, 0, At, B0); PG8_BAR; PG8_SCHED;
            PG8_LDB(B1, 1, 1); PG8_STAGE(PG8_SB(1, 0), b3, voffB);
            PG8_BAR; PG8_WAIT_L(0); PG8_MMA(0, 1, At, B1); PG8_BAR;
            PG8_LDA(At, 1, 1); PG8_STAGE_A(PG8_SA(1, 0), a2, gcur, k3, 0);
            PG8_BAR; PG8_WAIT_L(0); PG8_MMA(1, 0, At, B0); PG8_BAR; PG8_SCHED;
            PG8_STAGE(PG8_SB(1, 1), b3 + hstep, voffB);
            PG8_WAIT_V(6); PG8_BAR; PG8_MMA(1, 1, At, B1); PG8_BAR;
            }
        }
        if constexpr (ALIGN_EPI) { if (wr == 0) PG8_BAR; }
        cur.wt = (MK_WT_LAST && !has_next) ? 1 : 0;
        if constexpr (Epi::PREF) { if (has_next) E.prefetch(nxt, lds, (ui + 1) & 1, tid); E(acc, cur, wr, wc, fr, fq, (const LAS float*)(lds + 131072 + 10240 + (ui & 1) * 1024)); }
        else E(acc, cur, wr, wc, fr, fq);
#ifdef MK_EXP_EPI2
        if constexpr (Epi::TWICE) { asm volatile("" ::: "memory"); E(acc, cur, wr, wc, fr, fq); }
#endif
        if (!has_next) break;
#pragma unroll
        for (int a = 0; a < 2; ++a)
#pragma unroll
            for (int b = 0; b < 2; ++b)
#pragma unroll
                for (int m = 0; m < 4; ++m)
#pragma unroll
                    for (int n = 0; n < 2; ++n) {
#if MK_ZERO64
                        typedef float f32x2z __attribute__((ext_vector_type(2))); f32x2z zlo, zhi;
                        asm volatile("v_mov_b64 %0, 0" : "=v"(zlo)); asm volatile("v_mov_b64 %0, 0" : "=v"(zhi));
                        acc[a][b][m][n] = __builtin_shufflevector(zlo, zhi, 0, 1, 2, 3);
#else
                        acc[a][b][m][n] = (f32x4){0.f, 0.f, 0.f, 0.f};
#endif
                    }
        cur = nxt; cA = nA; cB = nB; ++ui;
        if constexpr (ALIGN_EPI) { if (wr == 1) PG8_BAR; }
    }
    PG8_WAIT_V(0);
    if constexpr (!ALIGN_EPI) { if (wr == 0) PG8_BAR; }
    PG8_BAR;
#undef PG8_SA
#undef PG8_SB
#undef PG8_STAGE
#undef PG8_STAGE_A
#undef PG8_GSWITCH
#undef PG8_LDA
#undef PG8_LD32
#undef PG8_LDB
#undef PG8_MMA
#undef PG8_WAIT_V
#undef PG8_WAIT_L
#undef PG8_BAR
#undef PG8_SCHED
}
}
constexpr int NWAVES = 8, NTHR = 512;
constexpr int NEXP = 64, NEXP1 = 65;
constexpr int LDS_BYTES = 147456;
constexpr int RING_OFF = 0, RING_BYTES = 131072, LDSCTL_OFF = RING_BYTES, MISC_OFF = LDSCTL_OFF + 320;

struct Lay {
    size_t ctl, mod, cs128, cs64, kmean, ssq, hist, starts, cnts, tokmask, tokpos, stok, sw, tw, logits;
    size_t wd, wgu, win, win8, wuq, wukv, wo, wr;
    size_t h1, qa, ka, va, cq, ckv, kr, qmn, qmr, kn, vm, mix, y, x1, h2, h2f8, h1f8, hb, slot, end;
};
constexpr size_t CTL_BYTES = 64 * 1024;
constexpr Lay make_lay_fast() {
    Lay L{};
    L.ctl = 0; L.mod = 1 * MiB; L.cs128 = 2 * MiB; L.cs64 = 3 * MiB; L.kmean = 3 * MiB + 512 * 1024; L.ssq = 4 * MiB  ; L.hist = 5 * MiB; L.starts = 5 * MiB + 128 * 1024; L.cnts = 5 * MiB + 192 * 1024;
    L.tokmask = 5 * MiB + 256 * 1024; L.tokpos = 6 * MiB; L.stok = 6 * MiB + 512 * 1024  ; L.sw = 7 * MiB + 64 * 1024; L.tw = 8 * MiB; L.logits = 12 * MiB;
    L.wd = 16 * MiB; L.x1 = 146 * MiB; L.hb = 274 * MiB; L.win = 420 * MiB; L.wuq = 438 * MiB; L.wukv = 440 * MiB; L.wo = 442 * MiB; L.wr = 450 * MiB; L.wgu = 452 * MiB;
    L.h1 = 146 * MiB; L.qa = 210 * MiB; L.ka = 242 * MiB; L.va = 274 * MiB; L.cq = 306 * MiB; L.ckv = 322 * MiB; L.kr = 338 * MiB; L.qmn = 340 * MiB; L.qmr = 372 * MiB; L.kn = 388 * MiB;
    L.vm = 712 * MiB; L.mix = 744 * MiB; L.y = 808 * MiB; L.h2 = 936 * MiB; L.h2f8 = 1000 * MiB; L.h1f8 = 808 * MiB  ; L.win8 = 0; L.slot = 548 * MiB; L.end = 1060 * MiB;
    return L;
}
constexpr Lay make_lay_dbg() {
    Lay L{}; const size_t B0 = 632 * MiB;
    L.ctl = B0; L.mod = B0 + 1 * MiB; L.cs128 = B0 + 2 * MiB; L.cs64 = B0 + 3 * MiB; L.kmean = B0 + 3 * MiB + 512 * 1024; L.ssq = B0 + 4 * MiB; L.hist = B0 + 5 * MiB; L.starts = B0 + 5 * MiB + 128 * 1024; L.cnts = B0 + 5 * MiB + 192 * 1024;
    L.tokmask = B0 + 5 * MiB + 256 * 1024; L.tokpos = B0 + 6 * MiB; L.stok = B0 + 6 * MiB + 512 * 1024; L.sw = B0 + 7 * MiB + 64 * 1024; L.tw = 0; L.logits = 0;
    L.win = B0 + 8 * MiB; L.wuq = B0 + 26 * MiB; L.wukv = B0 + 28 * MiB; L.wo = B0 + 30 * MiB; L.wr = B0 + 38 * MiB;
    L.h1 = B0 + 40 * MiB; L.qa = B0 + 104 * MiB; L.ka = B0 + 136 * MiB; L.va = B0 + 168 * MiB; L.cq = B0 + 200 * MiB; L.ckv = B0 + 216 * MiB; L.kr = B0 + 232 * MiB; L.qmn = B0 + 234 * MiB; L.qmr = B0 + 266 * MiB; L.kn = B0 + 282 * MiB;
    L.vm = B0 + 314 * MiB; L.mix = B0 + 346 * MiB; L.end = B0 + 410 * MiB;
    L.wd = 0; L.wgu = 0; L.x1 = 0; L.hb = 0; L.y = 0; L.h2 = 0; L.h2f8 = 0; L.slot = 0; L.h1f8 = B0 + 346 * MiB  ; L.win8 = B0 + 34 * MiB;
    return L;
}
#ifndef MK_LAYOUT_DBG
#define MK_LAYOUT_DBG 0
#endif
constexpr Lay WL = MK_LAYOUT_DBG ? make_lay_dbg() : make_lay_fast();

struct Args { const float* in[22]; float* out; unsigned char* ws; int ph_lo, ph_hi; unsigned flags; int pad; };
struct Frame {
    LAS unsigned char* lds; volatile LAS unsigned* MISC;
    int tid, lane, wave, G, vcu;
    unsigned char* ws;
};
#define LDS_WAIT() asm volatile("s_waitcnt lgkmcnt(0)" ::: "memory")
#define VM_WAIT() asm volatile("s_waitcnt vmcnt(0)" ::: "memory")

__device__ __forceinline__ float wave_sum(float v) {
#pragma unroll
    for (int o = 1; o < 64; o <<= 1) v += __shfl_xor(v, o);
    return v;
}

struct TileOrder {
    int nM, nN, nwg, G, c;
    __device__ __forceinline__ void init(int nM_, int nN_, int G_, int c_) { nM = nM_; nN = nN_; nwg = nM * nN; G = G_; c = c_; }
    __device__ __forceinline__ bool get(int i, int& pm, int& pn) const {
        const long L = (long)i * G + c; if (L >= nwg) return false;
        const int wgid = pg8::xcd_remap((int)L, nwg);
        const int nig = 8 * nN, gid = wgid / nig, fm = gid * 8, gsz = (nM - fm) < 8 ? (nM - fm) : 8;
        pm = fm + ((wgid % nig) % gsz); pn = (wgid % nig) / gsz; return true;
    }
};
#ifndef MK_RD_NT
#define MK_RD_NT 1
#endif
template <class Map>
__device__ __forceinline__ void tr_item(const float* __restrict__ W, int ldw, int k0, int n0, bf16_t* __restrict__ WT, int ldk, const Map& map, const float* __restrict__ kscale, LAS float* scr, int lane) {
    float tv[32];
#pragma unroll
    for (int i = 0; i < 32; ++i) { const int kk = 2 * i + (lane >> 5); tv[i] = __builtin_nontemporal_load(W + (size_t)(k0 + kk) * ldw + n0 + (lane & 31)); }
#pragma unroll
    for (int i = 0; i < 32; ++i) { const int kk = 2 * i + (lane >> 5); float v = tv[i]; if (kscale) v *= kscale[k0 + kk]; scr[kk * 33 + (lane & 31)] = v; }
    LDS_WAIT(); asm volatile("" ::: "memory");
    const int c = lane & 7;
#pragma unroll
    for (int j = 0; j < 4; ++j) { const int n = (lane >> 3) + 8 * j; const LAS float* s = scr + (8 * c) * 33 + n; const int row = map(n0 + n);
        u32x4 o; o.x = pk2(s[0 * 33], s[1 * 33]); o.y = pk2(s[2 * 33], s[3 * 33]); o.z = pk2(s[4 * 33], s[5 * 33]); o.w = pk2(s[6 * 33], s[7 * 33]);
        if (row >= 0) *(u32x4*)(WT + (size_t)row * ldk + k0 + 8 * c) = o; }
    LDS_WAIT(); asm volatile("" ::: "memory");
}
__device__ __forceinline__ void tr_load(const float* __restrict__ W, int ldw, int k0, int n0, int lane, float (&tv)[32]) {
#pragma unroll
    for (int i = 0; i < 32; ++i) { const int kk = 2 * i + (lane >> 5); tv[i] = __builtin_nontemporal_load(W + (size_t)(k0 + kk) * ldw + n0 + (lane & 31)); }
}
template <class Map>
__device__ __forceinline__ void tr_finish8(const float (&tv)[32], int k0, int n0, unsigned char* __restrict__ WT, int ldk, const Map& map, LAS float* scr, int lane, const float* __restrict__ kscale = nullptr) {
#pragma unroll
    for (int i = 0; i < 32; ++i) { const int kk = 2 * i + (lane >> 5); float v = tv[i] * 64.f; if (kscale) v *= kscale[k0 + kk]; scr[kk * 33 + (lane & 31)] = v; }
    LDS_WAIT(); asm volatile("" ::: "memory");
    const int c = lane & 7;
#pragma unroll
    for (int j = 0; j < 4; ++j) { const int n = (lane >> 3) + 8 * j; const LAS float* s = scr + (8 * c) * 33 + n; const int row = map(n0 + n);
        u32x2 o; o.x = pk4_fp8(s[0 * 33], s[1 * 33], s[2 * 33], s[3 * 33]); o.y = pk4_fp8(s[4 * 33], s[5 * 33], s[6 * 33], s[7 * 33]);
        if (row >= 0) *(u32x2*)(WT + (size_t)row * ldk + k0 + 8 * c) = o; }
    LDS_WAIT(); asm volatile("" ::: "memory");
}
template <class Map>
__device__ __forceinline__ void tr_item8(const float* __restrict__ W, int ldw, int k0, int n0, unsigned char* __restrict__ WT, int ldk, const Map& map, LAS float* scr, int lane, const float* __restrict__ kscale = nullptr) {
    float tv[32]; tr_load(W, ldw, k0, n0, lane, tv); tr_finish8(tv, k0, n0, WT, ldk, map, scr, lane, kscale);
}
__device__ __forceinline__ void tx_load(const float* __restrict__ W, int ldw, int k0, int n0, int lane, f32x4 (&tv)[16]) {
    const float* p = W + (size_t)(k0 + 16 * (lane >> 4)) * ldw + n0 + 4 * (lane & 15);
#pragma unroll
    for (int i = 0; i < 16; ++i) tv[i] = __builtin_nontemporal_load((const f32x4*)(p + (size_t)i * ldw));
}
template <class Map>
__device__ __forceinline__ void tx_finish8(const f32x4 (&tv)[16], int k0, int n0, unsigned char* __restrict__ WT, int ldk, const Map& map, int lane) {
    const int kq = lane >> 4, n4 = lane & 15;
#pragma unroll
    for (int j = 0; j < 4; ++j) { u32x4 o;
        o.x = pk4_fp8(tv[0][j] * 64.f, tv[1][j] * 64.f, tv[2][j] * 64.f, tv[3][j] * 64.f); o.y = pk4_fp8(tv[4][j] * 64.f, tv[5][j] * 64.f, tv[6][j] * 64.f, tv[7][j] * 64.f);
        o.z = pk4_fp8(tv[8][j] * 64.f, tv[9][j] * 64.f, tv[10][j] * 64.f, tv[11][j] * 64.f); o.w = pk4_fp8(tv[12][j] * 64.f, tv[13][j] * 64.f, tv[14][j] * 64.f, tv[15][j] * 64.f);
        const int row = map(n0 + 4 * n4 + j);
        *(u32x4*)(WT + (size_t)row * ldk + k0 + 16 * kq) = o; }
}
#ifndef MK_TX_NTST
#define MK_TX_NTST 1
#endif
#ifndef MK_TX_NT
#define MK_TX_NT 1
#endif
__device__ __forceinline__ void tx_load_b(const float* __restrict__ W, int ldw, int k0, int n0, int lane, f32x4 (&tv)[16]) {
    const float* p = W + (size_t)(k0 + 16 * (lane >> 3)) * ldw + n0 + 4 * (lane & 7);
#pragma unroll
    for (int i = 0; i < 16; ++i) tv[i] = MK_TX_NT ? __builtin_nontemporal_load((const f32x4*)(p + (size_t)i * ldw)) : *(const f32x4*)(p + (size_t)i * ldw);
}
template <class Map>
__device__ __forceinline__ void tx_finish8_b(const f32x4 (&tv)[16], int k0, int n0, unsigned char* __restrict__ WT, int ldk, const Map& map, int lane) {
    const int kq = lane >> 3, n4 = lane & 7;
#pragma unroll
    for (int j = 0; j < 4; ++j) { u32x4 o;
        o.x = pk4_fp8(tv[0][j] * 64.f, tv[1][j] * 64.f, tv[2][j] * 64.f, tv[3][j] * 64.f); o.y = pk4_fp8(tv[4][j] * 64.f, tv[5][j] * 64.f, tv[6][j] * 64.f, tv[7][j] * 64.f);
        o.z = pk4_fp8(tv[8][j] * 64.f, tv[9][j] * 64.f, tv[10][j] * 64.f, tv[11][j] * 64.f); o.w = pk4_fp8(tv[12][j] * 64.f, tv[13][j] * 64.f, tv[14][j] * 64.f, tv[15][j] * 64.f);
        const int row = map(n0 + 4 * n4 + j);
        if (MK_TX_NTST) __builtin_nontemporal_store(o, (u32x4*)(WT + (size_t)row * ldk + k0 + 16 * kq)); else *(u32x4*)(WT + (size_t)row * ldk + k0 + 16 * kq) = o; }
}
struct MapId { __device__ __forceinline__ int operator()(int n) const { return n; } };
struct MapWin { __device__ __forceinline__ int operator()(int n) const {
    if (n < 2048) { const int d = n & 127; return (n & ~127) + (d < 64 ? 2 * d : 2 * (d - 64) + 1); }
    if (n < 4096) return n;
    const int d = n - 4096; return 4096 + (d < 32 ? 2 * d : 2 * (d - 32) + 1); } };
struct MapWuq { __device__ __forceinline__ int operator()(int n) const { const int h = n / 192, d = n - 192 * h; if (d < 128) return 128 * h + d; const int r = d - 128; return 1024 + 64 * h + (r < 32 ? 2 * r : 2 * (r - 32) + 1); } };
struct MapGu { int up; __device__ __forceinline__ int operator()(int n) const { return 256 * (n >> 7) + 128 * up + (n & 127); } };

__device__ __forceinline__ void p0_mod(Frame& F, const float* __restrict__ c, const float* __restrict__ w_ada, const float* __restrict__ b_ada, float* __restrict__ mod) {
    LAS float* sc = (LAS float*)(F.lds + RING_OFF); LAS float* red = (LAS float*)(F.lds + RING_OFF + 65536);
    for (int i = F.tid; i < 8 * 2048; i += NTHR) { const float v = c[i]; sc[i] = v / (1.f + __expf(-v)); }
    __syncthreads();
    const int q = F.tid % 12, kg = F.tid / 12;
    for (int item = F.vcu; item < 256; item += F.G) {
        const int col = item * 48 + q * 4;
        if (kg < 40) {
            f32x4 a[8];
#pragma unroll
            for (int b = 0; b < 8; ++b) a[b] = (f32x4){0.f, 0.f, 0.f, 0.f};
            for (int k = kg; k < 2048; k += 40) { const f32x4 w = MK_RD_NT ? __builtin_nontemporal_load((const f32x4*)(w_ada + (size_t)k * 12288 + col)) : *(const f32x4*)(w_ada + (size_t)k * 12288 + col);
#pragma unroll
                for (int b = 0; b < 8; ++b) a[b] += w * sc[b * 2048 + k]; }
#pragma unroll
            for (int b = 0; b < 8; ++b) *(LAS f32x4*)(red + (kg * 8 + b) * 48 + q * 4) = a[b];
        }
        __syncthreads();
        if (F.tid < 384) { const int b = F.tid / 48, cc = F.tid % 48; float s = b_ada[item * 48 + cc];
            for (int g = 0; g < 40; ++g) s += red[(g * 8 + b) * 48 + cc];
            mod[b * 12288 + item * 48 + cc] = s; }
        __syncthreads();
    }
}
__device__ __forceinline__ void p0_rope_tab(Frame& F, float2* __restrict__ cs128, float2* __restrict__ cs64) {
    for (int idx = F.vcu * NTHR + F.tid; idx < S * 64; idx += F.G * NTHR) {
        { const int pos = idx / 64, i = idx % 64; const float inv = (float)(1.0 / pow(10000.0, (double)(2 * i) / 128.0)); const float a = (float)pos * inv; cs128[idx] = make_float2((float)cos((double)a), (float)sin((double)a)); }
        if (idx < S * 32) { const int pos = idx / 32, i = idx % 32; const float inv = (float)(1.0 / pow(10000.0, (double)(2 * i) / 64.0)); const float a = (float)pos * inv; cs64[idx] = make_float2((float)cos((double)a), (float)sin((double)a)); }
    }
}
__device__ __forceinline__ void p0_convert_experts(Frame& F, const Args& A);
__device__ __forceinline__ void p0_convert_experts(Frame& F, const Args& A, int it0, int step, int itEnd, int list);
__device__ __forceinline__ void p0_convert(Frame& F, const Args& A, unsigned flags) {
    LAS float* scr = (LAS float*)(F.lds + RING_OFF + F.wave * 16384);
    const int gw = F.vcu * NWAVES + F.wave, NGW = F.G * NWAVES;
    const float *w_in = A.in[4], *g_cq = A.in[5], *w_uq = A.in[6], *g_ckv = A.in[7], *w_ukv = A.in[8], *w_o = A.in[9], *w_router = A.in[12];
    unsigned char* Win8 = F.ws + WL.win; unsigned char* WuqT = F.ws + WL.wuq; unsigned char* WukvT = F.ws + WL.wukv; unsigned char* WoT = F.ws + WL.wo; bf16_t* WrT = (bf16_t*)(F.ws + WL.wr);
    if (flags & 1u) {
        constexpr int I_IN = 32 * 130, I_UQ = 8 * 48, I_UKV = 8 * 64, I_O = 32 * 64, I_ALL = I_IN + I_UQ + I_UKV + I_O;
        for (int it = gw; it < I_ALL; it += NGW) { int r = it;
            if (r < I_IN) { tr_item8(w_in, INW, 64 * (r / 130), 32 * (r % 130), Win8, 2048, MapWin{}, scr, F.lane); continue; } r -= I_IN;
            if (r < I_UQ) { tr_item8(w_uq, 1536, 64 * (r / 48), 32 * (r % 48), WuqT, 512, MapWuq{}, scr, F.lane, g_cq); continue; } r -= I_UQ;
            if (r < I_UKV) { tr_item8(w_ukv, 2048, 64 * (r / 64), 32 * (r % 64), WukvT, 512, MapId{}, scr, F.lane, g_ckv); continue; } r -= I_UKV;
            tr_item8(w_o, 2048, 64 * (r / 64), 32 * (r % 64), WoT, 2048, MapId{}, scr, F.lane); }
        for (int i = gw * 64 + F.lane; i < 2048 * 64; i += NGW * 64) { const int k = i >> 6, e = i & 63; const float v = w_router[i]; const unsigned hi = f2bf(v); const float lo = v - bf2f(hi);
            WrT[(size_t)e * 2048 + k] = (bf16_t)hi; WrT[(size_t)(64 + e) * 2048 + k] = (bf16_t)f2bf(lo); }
    }
#ifdef MK_CONV_EXP
    if (flags & 2u) { if ((F.vcu >> 2) % MK_CONV_EXP == 0) { const int idx = ((F.vcu >> 2) / MK_CONV_EXP) * 4 + (F.vcu & 3), n = (63 / MK_CONV_EXP + 1) * 4; p0_convert_experts(F, A, idx * NWAVES + F.wave, n * NWAVES, NEXP1 * 768, 2); } }
#else
    if (flags & 2u) p0_convert_experts(F, A);
#endif
}
#ifndef MK_TX128
#define MK_TX128 1
#endif
struct MapExp { int kind; __device__ __forceinline__ int operator()(int n) const { return kind == 2 ? n : 256 * (n >> 7) + 128 * kind + (n & 127); } };
#ifndef MK_POOL_E0
#define MK_POOL_E0 39
#endif
constexpr int CONV_NV0 = NEXP1 * 512 + MK_POOL_E0 * 256, CONV_NV1 = (NEXP1 - MK_POOL_E0) * 256;
__device__ __forceinline__ int conv_remap(int list, int v) {
    if (list == 0) { if (v < NEXP1 * 512) return (v >> 9) * 768 + (v & 511); const int j = v - NEXP1 * 512; return (j >> 8) * 768 + 512 + (j & 255); }
    if (list == 1) return (MK_POOL_E0 + (v >> 8)) * 768 + 512 + (v & 255);
    return v;
}
__device__ __forceinline__ void p0_convert_experts(Frame& F, const Args& A, int it0, int step, int itEnd, int list = 2) {
    const float *w_gate = A.in[14], *w_up = A.in[15], *w_down = A.in[16], *ws_gate = A.in[17], *ws_up = A.in[18], *ws_down = A.in[19];
    unsigned char* WguT = F.ws + WL.wgu; unsigned char* WdT = F.ws + WL.wd;
    constexpr int I_G = 32 * 8, I_D = 8 * 32, I_E = 2 * I_G + I_D;
#if MK_TX128
#define P0_ITEM(it_, Wp_, ldw_, k0_, n0_, Dp_, ldk_, kind_) do { const int e_ = (it_) / I_E; int r_ = (it_) % I_E; \
        if (r_ < I_G) { Wp_ = e_ < NEXP ? w_gate + (size_t)e_ * 2048 * 512 : ws_gate; ldw_ = 512; k0_ = 128 * (r_ / 16); n0_ = 32 * (r_ % 16); Dp_ = WguT + (size_t)e_ * 1024 * 2048; ldk_ = 2048; kind_ = 0; } \
        else if (r_ < 2 * I_G) { r_ -= I_G; Wp_ = e_ < NEXP ? w_up + (size_t)e_ * 2048 * 512 : ws_up; ldw_ = 512; k0_ = 128 * (r_ / 16); n0_ = 32 * (r_ % 16); Dp_ = WguT + (size_t)e_ * 1024 * 2048; ldk_ = 2048; kind_ = 1; } \
        else { r_ -= 2 * I_G; Wp_ = e_ < NEXP ? w_down + (size_t)e_ * 512 * 2048 : ws_down; ldw_ = 2048; k0_ = 128 * (r_ / 64); n0_ = 32 * (r_ % 64); Dp_ = WdT + (size_t)e_ * 2048 * 512; ldk_ = 512; kind_ = 2; } } while (0)
#define TX_LOAD tx_load_b
#define TX_FIN tx_finish8_b
#else
#define P0_ITEM(it_, Wp_, ldw_, k0_, n0_, Dp_, ldk_, kind_) do { const int e_ = (it_) / I_E; int r_ = (it_) % I_E; \
        if (r_ < I_G) { Wp_ = e_ < NEXP ? w_gate + (size_t)e_ * 2048 * 512 : ws_gate; ldw_ = 512; k0_ = 64 * (r_ / 8); n0_ = 64 * (r_ % 8); Dp_ = WguT + (size_t)e_ * 1024 * 2048; ldk_ = 2048; kind_ = 0; } \
        else if (r_ < 2 * I_G) { r_ -= I_G; Wp_ = e_ < NEXP ? w_up + (size_t)e_ * 2048 * 512 : ws_up; ldw_ = 512; k0_ = 64 * (r_ / 8); n0_ = 64 * (r_ % 8); Dp_ = WguT + (size_t)e_ * 1024 * 2048; ldk_ = 2048; kind_ = 1; } \
        else { r_ -= 2 * I_G; Wp_ = e_ < NEXP ? w_down + (size_t)e_ * 512 * 2048 : ws_down; ldw_ = 2048; k0_ = 64 * (r_ / 32); n0_ = 64 * (r_ % 32); Dp_ = WdT + (size_t)e_ * 2048 * 512; ldk_ = 512; kind_ = 2; } } while (0)
#define TX_LOAD tx_load
#define TX_FIN tx_finish8
#endif
#define P0_LOAD(itx_, tv_) do { const int v_ = (itx_); if (v_ < itEnd) { const int i_ = conv_remap(list, v_); const float* W_; int lw_, k_, n_, lk_, kd_; unsigned char* D_; P0_ITEM(i_, W_, lw_, k_, n_, D_, lk_, kd_); (void)D_; (void)lk_; (void)kd_; TX_LOAD(W_, lw_, k_, n_, F.lane, tv_); } } while (0)
#define P0_FIN(itx_, tv_) do { const int v_ = (itx_); if (v_ < itEnd) { const int i_ = conv_remap(list, v_); const float* W_; int lw_, k_, n_, lk_, kd_; unsigned char* D_; P0_ITEM(i_, W_, lw_, k_, n_, D_, lk_, kd_); (void)W_; (void)lw_; TX_FIN(tv_, k_, n_, D_, lk_, MapExp{kd_}, F.lane); } } while (0)
    f32x4 ta[16], tb[16], tc[16];
    P0_LOAD(it0, ta); P0_LOAD(it0 + step, tb);
#pragma unroll 1
    for (int it = it0; it < itEnd; it += 3 * step) {
        P0_LOAD(it + 2 * step, tc); P0_FIN(it, ta);
        P0_LOAD(it + 3 * step, ta); P0_FIN(it + step, tb);
        P0_LOAD(it + 4 * step, tb); P0_FIN(it + 2 * step, tc);
    }
#undef P0_FIN
#undef TX_LOAD
#undef TX_FIN
#undef P0_LOAD
#undef P0_ITEM
}
__device__ __forceinline__ void p0_convert_experts(Frame& F, const Args& A) { p0_convert_experts(F, A, F.vcu * NWAVES + F.wave, F.G * NWAVES, NEXP1 * 768); }
__device__ __forceinline__ void p0_convert_experts_p4(Frame& F, const Args& A) { p0_convert_experts(F, A, F.vcu * NWAVES + F.wave, F.G * NWAVES, CONV_NV0, 0); }
#ifndef MK_CONV_DW
#define MK_CONV_DW 100
#endif
__device__ __forceinline__ int conv_cum(int c) { const int bh = c >> 2, y = c & 3; return bh * 4000 + y * 1000 + (MK_CONV_DW * y * (4 - y)) / 2; }
__device__ __forceinline__ void p0_convert_experts_w(Frame& F, const Args& A) {
    if (F.G != 256) { p0_convert_experts(F, A); return; }
    const int s0 = conv_cum(F.vcu) * 195 / 1000, s1 = conv_cum(F.vcu + 1) * 195 / 1000;
    p0_convert_experts(F, A, s0 + F.wave, NWAVES, s1);
}
__device__ __forceinline__ void p1_h1(Frame& F, const float* __restrict__ x, const float* __restrict__ mod, unsigned char* __restrict__ H1F8) {
    const int gw = F.vcu * NWAVES + F.wave, NGW = F.G * NWAVES;
    for (int t0 = gw; t0 < T; t0 += 2 * NGW) {
        f32x4 v[2][8];
#pragma unroll
        for (int p = 0; p < 2; ++p) { const int t = t0 + p * NGW; if (t < T) { const GAS f32x4* xr = (const GAS f32x4*)(x + (size_t)t * D) + F.lane;
#pragma unroll
            for (int j = 0; j < 8; ++j) v[p][j] = MK_RD_NT ? __builtin_nontemporal_load((const f32x4*)(xr + 64 * j)) : xr[64 * j]; } }
#pragma unroll
        for (int p = 0; p < 2; ++p) { const int t = t0 + p * NGW; if (t < T) { const int b = t >> 11; const float* m = mod + b * 12288;
            GAS unsigned* o8 = (GAS unsigned*)(H1F8 + (size_t)t * D) + F.lane;
#pragma unroll
            for (int j = 0; j < 8; ++j) { const f32x4 sh = *(const f32x4*)(m + 256 * j + 4 * F.lane), sc = *(const f32x4*)(m + 2048 + 256 * j + 4 * F.lane);
                const f32x4 h = v[p][j] * (sc + 1.f) + sh; o8[64 * j] = pk4_fp8(h[0], h[1], h[2], h[3]); } } }
    }
}
#ifndef EXP_EPI_IN2
#define EXP_EPI_IN2 0
#endif
#ifndef EXP_EPI_MLA2
#define EXP_EPI_MLA2 0
#endif
struct SchedIn {
    TileOrder o; const char* A; const char* Bt; int pn0, rowb;
    __device__ __forceinline__ bool next(int i, pg8::Unit& u) const { int pm, pl; if (!o.get(i, pm, pl)) return false; const int pn = pn0 + pl;
        u.pm = pm; u.pn = pn; u.kind = pn < 8 ? 0 : (pn < 12 ? 1 : (pn < 16 ? 2 : 3)); u.aux = 0; u.rows = nullptr; u.nvalid = 256;
        u.a = A + (size_t)pm * 256 * rowb; u.b = Bt + (size_t)pl * 256 * rowb; return true; }
};
__device__ __forceinline__ void rope8(f32x4& v0, f32x4& v1, const f32x4 c0, const f32x4 c1) {
    const f32x4 a = v0, b = v1;
    v0[0] = a[0] * c0[0] - a[1] * c0[1]; v0[1] = a[1] * c0[0] + a[0] * c0[1]; v0[2] = a[2] * c0[2] - a[3] * c0[3]; v0[3] = a[3] * c0[2] + a[2] * c0[3];
    v1[0] = b[0] * c1[0] - b[1] * c1[1]; v1[1] = b[1] * c1[0] + b[0] * c1[1]; v1[2] = b[2] * c1[2] - b[3] * c1[3]; v1[3] = b[3] * c1[2] + b[2] * c1[3];
}
__device__ __forceinline__ u32x4 pack8(const f32x4 v0, const f32x4 v1) { u32x4 w; w.x = cvt_pk_bf16(v0[0], v0[1]); w.y = cvt_pk_bf16(v0[2], v0[3]); w.z = cvt_pk_bf16(v1[0], v1[1]); w.w = cvt_pk_bf16(v1[2], v1[3]); return w; }
template <int KMASK  > struct EpiInT {
    static constexpr bool PERM = true, TWICE = (EXP_EPI_IN2 != 0), B64 = false, PREF = false; static constexpr int RELAX = 0;
    bf16_t *QA, *KA, *VA; unsigned char *CQ, *CKV; bf16_t* KR; float* SSQ; const float* cs128; const float* cs64;
    __device__ __forceinline__ void operator()(const f32x4 (&acc)[2][2][4][2], const pg8::Unit& u, int wr, int wc, int fr, int fq) const {
        asm volatile("" : "+v"(fr), "+v"(fq));
        int row0 = u.pm * 256 + wr * 64 + fr, cl = wc * 32 + 8 * fq;
        if ((KMASK & 1) && u.kind == 0) {
            bf16_t* dst = (u.pn < 4 ? QA : KA) + (u.pn & 3) * 256 + cl;
#pragma unroll
            for (int ai = 0; ai < 2; ++ai) {
                f32x4 c0[4], c1[4];
#pragma unroll
                for (int m = 0; m < 4; ++m) { const int row = row0 + ai * 128 + m * 16; const float* cp = cs128 + ((size_t)(row & 2047) * 64 + (cl >> 1)) * 2; c0[m] = *(const f32x4*)cp; c1[m] = *(const f32x4*)(cp + 4); }
                asm volatile("" : "+v"(c0[0]), "+v"(c0[1]), "+v"(c0[2]), "+v"(c0[3]), "+v"(c1[0]), "+v"(c1[1]), "+v"(c1[2]), "+v"(c1[3]));
#pragma unroll
                for (int m = 0; m < 4; ++m) { const int row = row0 + ai * 128 + m * 16;
#pragma unroll
                    for (int bj = 0; bj < 2; ++bj) { f32x4 v0 = acc[ai][bj][m][0], v1 = acc[ai][bj][m][1]; rope8(v0, v1, c0[m], c1[m]);
                        ST16NT(dst + (size_t)row * 1024 + bj * 128, pack8(v0, v1)); } } }
        } else if ((KMASK & 2) && u.kind == 1) {
            bf16_t* dst = VA + (u.pn - 8) * 256 + cl;
#pragma unroll
            for (int ai = 0; ai < 2; ++ai)
#pragma unroll
                for (int m = 0; m < 4; ++m) { const int row = row0 + ai * 128 + m * 16;
#pragma unroll
                    for (int bj = 0; bj < 2; ++bj) ST16NT(dst + (size_t)row * 1024 + bj * 128, pack8(acc[ai][bj][m][0], acc[ai][bj][m][1])); }
        } else if ((KMASK & 4) && u.kind == 2) {
            const int which = (u.pn - 12) >> 1, half = (u.pn - 12) & 1;
            unsigned char* dst = (which ? CKV : CQ) + half * 256 + cl; float* sq = SSQ + (size_t)which * T * 8 + half * 4 + wc;
#pragma unroll
            for (int ai = 0; ai < 2; ++ai)
#pragma unroll
                for (int m = 0; m < 4; ++m) { const int row = row0 + ai * 128 + m * 16; float s = 0.f;
#pragma unroll
                    for (int bj = 0; bj < 2; ++bj) { const f32x4 v0 = acc[ai][bj][m][0], v1 = acc[ai][bj][m][1];
                        s += (v0[0] * v0[0] + v0[1] * v0[1]) + (v0[2] * v0[2] + v0[3] * v0[3]) + (v1[0] * v1[0] + v1[1] * v1[1]) + (v1[2] * v1[2] + v1[3] * v1[3]);
                        { u32x2 o; o.x = pk4_fp8(v0[0], v0[1], v0[2], v0[3]); o.y = pk4_fp8(v1[0], v1[1], v1[2], v1[3]); *(u32x2*)(dst + (size_t)row * 512 + bj * 128) = o; } }
                    s += __shfl_xor(s, 16); s += __shfl_xor(s, 32);
                    if (fq == 0) sq[(size_t)row * 8] = s; }
        } else if ((KMASK & 8) && u.kind == 3) {
            if (wc < 2) {
#pragma unroll
                for (int ai = 0; ai < 2; ++ai)
#pragma unroll
                    for (int m = 0; m < 4; ++m) { const int row = row0 + ai * 128 + m * 16; const float* cp = cs64 + ((size_t)(row & 2047) * 32 + (cl >> 1)) * 2;
                        const f32x4 c0 = *(const f32x4*)cp, c1 = *(const f32x4*)(cp + 4);
                        f32x4 v0 = acc[ai][0][m][0], v1 = acc[ai][0][m][1]; rope8(v0, v1, c0, c1);
                        ST16NT(KR + (size_t)row * 64 + cl, pack8(v0, v1)); }
            }
        }
    }
};

__device__ __forceinline__ void p2_kr(Frame& F, const unsigned char* __restrict__ H1F8, const unsigned char* __restrict__ Wkr8  , const float* __restrict__ cs64, bf16_t* __restrict__ KR) {
    for (int blk = F.vcu; blk < 256; blk += F.G) {
        const int fr = F.lane & 15, fq = F.lane >> 4; f32x4 acc[4][4];
#pragma unroll
        for (int mi = 0; mi < 4; ++mi)
#pragma unroll
            for (int ni = 0; ni < 4; ++ni) acc[mi][ni] = (f32x4){0.f, 0.f, 0.f, 0.f};
#pragma unroll
        for (int ks = 0; ks < 2; ++ks) { const int k = F.wave * 256 + ks * 128 + fq * 32; pg8::v8i a[4], bh[4];
#pragma unroll
            for (int mi = 0; mi < 4; ++mi) a[mi] = *(const pg8::v8i*)(H1F8 + (size_t)(blk * 64 + mi * 16 + fr) * D + k);
#pragma unroll
            for (int ni = 0; ni < 4; ++ni) bh[ni] = *(const pg8::v8i*)(Wkr8 + (size_t)(ni * 16 + fr) * D + k);
#pragma unroll
            for (int mi = 0; mi < 4; ++mi)
#pragma unroll
                for (int ni = 0; ni < 4; ++ni) acc[mi][ni] = __builtin_amdgcn_mfma_scale_f32_16x16x128_f8f6f4(a[mi], bh[ni], acc[mi][ni], 0, 0, 0, 0x7f7f7f7f, 0, 0x79797979); }
        LAS float* red = (LAS float*)(F.lds + RING_OFF) + F.wave * 4096;
#pragma unroll
        for (int mi = 0; mi < 4; ++mi)
#pragma unroll
            for (int ni = 0; ni < 4; ++ni)
#pragma unroll
                for (int r = 0; r < 4; ++r) red[(mi * 16 + 4 * fq + r) * 64 + ni * 16 + fr] = acc[mi][ni][r];
        __syncthreads();
#pragma unroll
        for (int q = 0; q < 4; ++q) { const int idx = F.tid + q * NTHR, row = idx >> 5, i = idx & 31; float x1 = 0.f, x2 = 0.f;
#pragma unroll
            for (int w = 0; w < 8; ++w) { x1 += ((LAS float*)(F.lds + RING_OFF))[w * 4096 + row * 64 + 2 * i]; x2 += ((LAS float*)(F.lds + RING_OFF))[w * 4096 + row * 64 + 2 * i + 1]; }
            const int t = blk * 64 + row; const float cs = cs64[((size_t)(t & 2047) * 32 + i) * 2], sn = cs64[((size_t)(t & 2047) * 32 + i) * 2 + 1];
            *(unsigned*)(KR + (size_t)t * 64 + 2 * i) = cvt_pk_bf16(x1 * cs - x2 * sn, x2 * cs + x1 * sn); }
        __syncthreads();
    }
}
__device__ __forceinline__ void p1_h1_kr(Frame& F, const float* __restrict__ x, const float* __restrict__ mod, unsigned char* __restrict__ H1F8, const unsigned char* __restrict__ Wkr8, const float* __restrict__ cs64, bf16_t* __restrict__ KR) {
    LAS unsigned char* img = F.lds + RING_OFF; const int blk = F.vcu;
#pragma unroll 1
    for (int i = 0; i < 8; i += 2) {
        f32x4 v[2][8];
#pragma unroll
        for (int p = 0; p < 2; ++p) { const int t = blk * 64 + F.wave * 8 + i + p; const GAS f32x4* xr = (const GAS f32x4*)(x + (size_t)t * D) + F.lane;
#pragma unroll
            for (int j = 0; j < 8; ++j) v[p][j] = __builtin_nontemporal_load((const f32x4*)(xr + 64 * j)); }
#pragma unroll
        for (int p = 0; p < 2; ++p) { const int r = F.wave * 8 + i + p, t = blk * 64 + r, b = t >> 11; const float* m = mod + b * 12288;
            GAS unsigned* o8 = (GAS unsigned*)(H1F8 + (size_t)t * D) + F.lane; LAS unsigned char* irow = img + r * 2048 + ((F.lane & 7) << 2);
#pragma unroll
            for (int j = 0; j < 8; ++j) { const f32x4 sh = *(const f32x4*)(m + 256 * j + 4 * F.lane), sc = *(const f32x4*)(m + 2048 + 256 * j + 4 * F.lane);
                const f32x4 h = v[p][j] * (sc + 1.f) + sh; const unsigned pk = pk4_fp8(h[0], h[1], h[2], h[3]); o8[64 * j] = pk;
                *(LAS unsigned*)(irow + (((8 * j + (F.lane >> 3)) ^ (r & 15)) << 5)) = pk; } }
    }
    __syncthreads();
    {
        const int fr = F.lane & 15, fq = F.lane >> 4; f32x4 acc[4][4];
#pragma unroll
        for (int mi = 0; mi < 4; ++mi)
#pragma unroll
            for (int ni = 0; ni < 4; ++ni) acc[mi][ni] = (f32x4){0.f, 0.f, 0.f, 0.f};
#pragma unroll
        for (int ks = 0; ks < 2; ++ks) { const int k = F.wave * 256 + ks * 128 + fq * 32, ch = F.wave * 8 + ks * 4 + fq; pg8::v8i a[4], bh[4];
#pragma unroll
            for (int mi = 0; mi < 4; ++mi) { const LAS unsigned char* ap = img + (mi * 16 + fr) * 2048 + ((ch ^ fr) << 5); a[mi] = __builtin_shufflevector(*(const LAS pg8::v4i*)ap, *(const LAS pg8::v4i*)(ap + 16), 0, 1, 2, 3, 4, 5, 6, 7); }
#pragma unroll
            for (int ni = 0; ni < 4; ++ni) bh[ni] = *(const pg8::v8i*)(Wkr8 + (size_t)(ni * 16 + fr) * D + k);
#pragma unroll
            for (int mi = 0; mi < 4; ++mi)
#pragma unroll
                for (int ni = 0; ni < 4; ++ni) acc[mi][ni] = __builtin_amdgcn_mfma_scale_f32_16x16x128_f8f6f4(a[mi], bh[ni], acc[mi][ni], 0, 0, 0, 0x7f7f7f7f, 0, 0x79797979); }
        __syncthreads();
        LAS float* red = (LAS float*)(F.lds + RING_OFF) + F.wave * 4096;
#pragma unroll
        for (int mi = 0; mi < 4; ++mi)
#pragma unroll
            for (int ni = 0; ni < 4; ++ni)
#pragma unroll
                for (int r = 0; r < 4; ++r) red[(mi * 16 + 4 * fq + r) * 64 + ni * 16 + fr] = acc[mi][ni][r];
        __syncthreads();
#pragma unroll
        for (int q = 0; q < 4; ++q) { const int idx = F.tid + q * NTHR, row = idx >> 5, i = idx & 31; float x1 = 0.f, x2 = 0.f;
#pragma unroll
            for (int w = 0; w < 8; ++w) { x1 += ((LAS float*)(F.lds + RING_OFF))[w * 4096 + row * 64 + 2 * i]; x2 += ((LAS float*)(F.lds + RING_OFF))[w * 4096 + row * 64 + 2 * i + 1]; }
            const int t = blk * 64 + row; const float cs = cs64[((size_t)(t & 2047) * 32 + i) * 2], sn = cs64[((size_t)(t & 2047) * 32 + i) * 2 + 1];
            *(unsigned*)(KR + (size_t)t * 64 + 2 * i) = cvt_pk_bf16(x1 * cs - x2 * sn, x2 * cs + x1 * sn); }
        __syncthreads();
    }
}
__device__ __forceinline__ void p3_kmean(Frame& F, const bf16_t* __restrict__ KA, float* __restrict__ KMEAN, int first, int stride) {
    LAS float* red = (LAS float*)(F.lds + RING_OFF);
    const int rg = F.tid >> 4, c8 = (F.tid & 15) * 8;
    for (int item = first; item < 512; item += stride) { const int h = item & 7, blk = (item >> 3) & 7, b = item >> 6;
        float a[8];
#pragma unroll
        for (int j = 0; j < 8; ++j) a[j] = 0.f;
        for (int r = rg; r < 256; r += 32) { const u32x4 w = __builtin_nontemporal_load((const u32x4*)(KA + (size_t)(b * 2048 + blk * 256 + r) * 1024 + h * 128 + c8));
            a[0] += bf2f(w.x & 0xffffu); a[1] += bf2f(w.x >> 16); a[2] += bf2f(w.y & 0xffffu); a[3] += bf2f(w.y >> 16); a[4] += bf2f(w.z & 0xffffu); a[5] += bf2f(w.z >> 16); a[6] += bf2f(w.w & 0xffffu); a[7] += bf2f(w.w >> 16); }
#pragma unroll
        for (int j = 0; j < 8; ++j) red[rg * 128 + c8 + j] = a[j];
        __syncthreads();
        if (F.tid < 128) { float s = 0.f; for (int g = 0; g < 32; ++g) s += red[g * 128 + F.tid]; KMEAN[((b * 8 + h) * 8 + blk) * 128 + F.tid] = s * (1.f / 256.f); }
        __syncthreads();
    }
}
struct SchedMla {
    TileOrder o; const char *CQ, *CKV, *WuqT, *WukvT;
    __device__ __forceinline__ bool next(int i, pg8::Unit& u) const { int pm, pn; if (!o.get(i, pm, pn)) return false;
        u.pm = pm; u.pn = pn; u.rows = nullptr; u.nvalid = 256; u.aux = 0;
        if (pn < 6) { u.kind = pn < 4 ? 0 : 1; u.a = CQ + (size_t)pm * 256 * 512; u.b = WuqT + (size_t)pn * 256 * 512; }
        else { u.kind = 2; u.a = CKV + (size_t)pm * 256 * 512; u.b = WukvT + (size_t)(pn - 6) * 256 * 512; }
        return true; }
};
struct EpiMla {
    static constexpr bool PERM = true, TWICE = (EXP_EPI_MLA2 != 0), B64 = false, PREF = false; static constexpr int RELAX = 0;
    bf16_t *QMN, *QMR, *KN, *VM; const float* SSQ; const float* cs64;
    __device__ __forceinline__ void operator()(const f32x4 (&acc)[2][2][4][2], const pg8::Unit& u, int wr, int wc, int fr, int fq) const {
        asm volatile("" : "+v"(fr), "+v"(fq));
        int row0 = u.pm * 256 + wr * 64 + fr, cl = wc * 32 + 8 * fq;
        const float* sq = SSQ + (u.kind == 2 ? (size_t)T * 8 : 0);
#pragma unroll
        for (int ai = 0; ai < 2; ++ai) {
            f32x4 p0[4], p1[4], c0[4], c1[4];
#pragma unroll
            for (int m = 0; m < 4; ++m) { const int row = row0 + ai * 128 + m * 16; p0[m] = *(const f32x4*)(sq + (size_t)row * 8); p1[m] = *(const f32x4*)(sq + (size_t)row * 8 + 4);
                if (u.kind == 1) { const float* cp = cs64 + ((size_t)(row & 2047) * 32 + ((cl & 63) >> 1)) * 2; c0[m] = *(const f32x4*)cp; c1[m] = *(const f32x4*)(cp + 4); } else { c0[m] = p0[m]; c1[m] = p1[m]; } }
            asm volatile("" : "+v"(p0[0]), "+v"(p0[1]), "+v"(p0[2]), "+v"(p0[3]), "+v"(p1[0]), "+v"(p1[1]), "+v"(p1[2]), "+v"(p1[3]));
            asm volatile("" : "+v"(c0[0]), "+v"(c0[1]), "+v"(c0[2]), "+v"(c0[3]), "+v"(c1[0]), "+v"(c1[1]), "+v"(c1[2]), "+v"(c1[3]));
#pragma unroll
            for (int m = 0; m < 4; ++m) { const int row = row0 + ai * 128 + m * 16;
                const float rs = 1.f / sqrtf((((p0[m][0] + p0[m][1]) + (p0[m][2] + p0[m][3])) + ((p1[m][0] + p1[m][1]) + (p1[m][2] + p1[m][3]))) * (1.f / 512.f) + 1e-6f);
                if (u.kind == 0) {
#pragma unroll
                    for (int bj = 0; bj < 2; ++bj) ST16NT(QMN + (size_t)row * 1024 + u.pn * 256 + bj * 128 + cl, pack8(acc[ai][bj][m][0] * rs, acc[ai][bj][m][1] * rs));
                } else if (u.kind == 1) {
#pragma unroll
                    for (int bj = 0; bj < 2; ++bj) { f32x4 v0 = acc[ai][bj][m][0] * rs, v1 = acc[ai][bj][m][1] * rs; rope8(v0, v1, c0[m], c1[m]);
                        ST16NT(QMR + (size_t)row * 512 + (u.pn - 4) * 256 + bj * 128 + cl, pack8(v0, v1)); }
                } else {
                    ST16NT(KN + (size_t)row * 1024 + (u.pn - 6) * 128 + cl, pack8(acc[ai][0][m][0] * rs, acc[ai][0][m][1] * rs));
                    ST16NT(VM + (size_t)row * 1024 + (u.pn - 6) * 128 + cl, pack8(acc[ai][1][m][0] * rs, acc[ai][1][m][1] * rs));
                } } }
    }
};
#ifndef MK_ATT_NT
#define MK_ATT_NT 0
#endif
namespace att {
#ifndef EXP_EARLY_WAIT
#define EXP_EARLY_WAIT 0
#endif
constexpr int NW = 8, QBLK = 32, KVBLK = 64, QB = NW * QBLK;
constexpr int SHM_V = KVBLK * 128 * 2, SHM_K = KVBLK * 128 * 2, SHM_KR = KVBLK * 64 * 2;
constexpr int OFF_V = 0, OFF_K = 2 * SHM_V, OFF_KR = OFF_K + 2 * SHM_K, OFF_WS = OFF_KR + 2 * SHM_KR, OFF_QR = OFF_WS + NW * 64 * 4, ATT_LDS = OFF_QR + NW * 4096;
constexpr float THR = 8.f;

#define KSWZ(row, colB) ((row) * 256 + ((colB) ^ (((row) & 7) << 4)))
#define KRSWZ(row, colB) ((row) * 128 + ((colB) ^ (((row) & 7) << 4)))
#define SBAR() __builtin_amdgcn_sched_barrier(0)
__device__ __forceinline__ int v_st(int k, int c) { const int kk = (k & ~0xC) | ((k & 4) << 1) | ((k & 8) >> 1); return ((kk >> 3) * 4 + (c >> 5)) * 512 + ((kk & 7) * 32 + (c & 31)) * 2; }
__device__ __forceinline__ int v_rd_base(int lane) { return ((lane & 3) << 3) | (((lane >> 2) & 3) << 6) | (((lane >> 4) & 1) << 5) | (((lane >> 5) & 1) << 8); }
constexpr int v_rd_off(int d0, int ks, int half) { return d0 * 512 + ks * 4096 + half * 2048; }
__device__ __forceinline__ int crow(int r, int hi) { return (r & 3) + 8 * (r >> 2) + 4 * hi; }
__device__ __forceinline__ bf16x8 load8(const bf16_t* p) { return *reinterpret_cast<const bf16x8*>(p); }

__device__ __forceinline__ void mask_tile(f32x16& p0, f32x16& p1, int dq) {
    const float NEG = -__builtin_inff();
#pragma unroll
    for (int r = 0; r < 16; ++r) {
        const int c = (r & 3) + 8 * (r >> 2);
        if (dq - c < 0) p0[r] = NEG;
        if (dq - c - 32 < 0) p1[r] = NEG;
    }
}
template <bool MLA>
__device__ __forceinline__ void partialSM(f32x16& p0, f32x16& p1, float& m_reg, float& mn, float& alpha, bool keep) {
    constexpr float SCALE = MLA ? 0.07216878364870323f : 0.08838834764831845f;
    float pmax = p0[0]; for (int r = 1; r < 16; ++r) pmax = fmaxf(pmax, p0[r]); for (int r = 0; r < 16; ++r) pmax = fmaxf(pmax, p1[r]);
    if (!MLA) { if (!keep) pmax = -__builtin_inff(); }
    { auto rr = __builtin_amdgcn_permlane32_swap(__float_as_uint(pmax), __float_as_uint(pmax), false, false);
      pmax = fmaxf(__uint_as_float(rr[0]), __uint_as_float(rr[1])); }
    constexpr float C2 = 1.4426950408889634f * SCALE;
    if (__builtin_expect(__all((pmax - m_reg) * SCALE <= THR), 1)) { mn = m_reg; alpha = 1.f; }
    else { mn = fmaxf(m_reg, pmax); alpha = __builtin_amdgcn_exp2f((m_reg - mn) * C2); m_reg = mn; }
    float mnL = -mn * C2;
    if (!MLA) { if (!keep) mnL = -__builtin_inff(); }
    for (int r = 0; r < 16; ++r) p0[r] = fmaf(p0[r], C2, mnL); for (int r = 0; r < 16; ++r) p1[r] = fmaf(p1[r], C2, mnL);
    for (int r = 0; r < 16; ++r) p0[r] = __builtin_amdgcn_exp2f(p0[r]);
}
__device__ __forceinline__ void finishSM(f32x16& p0, f32x16& p1, float alpha, float& l_reg, bf16x8& pa0, bf16x8& pa1, bf16x8& pa2, bf16x8& pa3) {
    for (int r = 0; r < 16; ++r) p1[r] = __builtin_amdgcn_exp2f(p1[r]);
    float ps = 0; for (int r = 0; r < 16; ++r) ps += p0[r]; for (int r = 0; r < 16; ++r) ps += p1[r];
    { auto rr = __builtin_amdgcn_permlane32_swap(__float_as_uint(ps), __float_as_uint(ps), false, false);
      ps = __uint_as_float(rr[0]) + __uint_as_float(rr[1]); }
    l_reg = l_reg * alpha + ps;
#define PK4(P, B_, OUT) do { unsigned a0 = cvt_pk_bf16(P[B_+0], P[B_+1]), a1 = cvt_pk_bf16(P[B_+2], P[B_+3]);                          \
        unsigned b0 = cvt_pk_bf16(P[B_+4], P[B_+5]), b1 = cvt_pk_bf16(P[B_+6], P[B_+7]);                                             \
        auto r0 = __builtin_amdgcn_permlane32_swap(a0, b0, false, false); auto r1 = __builtin_amdgcn_permlane32_swap(a1, b1, false, false); \
        u32x4 w = {r0[0], r1[0], r0[1], r1[1]}; OUT = *reinterpret_cast<bf16x8*>(&w); } while (0)
    PK4(p0, 0, pa0); PK4(p0, 8, pa1); PK4(p1, 0, pa2); PK4(p1, 8, pa3);
#undef PK4
}
template <int KB, bool MLA>
__device__ __forceinline__ void qkt(f32x16& p0, f32x16& p1, const char* lds, int r32, int hi, const bf16x8* qr, const char* qr2l) {
    p0 = f32x16{}; p1 = f32x16{};
    const char* kb[4];
#pragma unroll
    for (int dd = 0; dd < 4; ++dd) kb[dd] = lds + OFF_K + KB * SHM_K + KSWZ(r32, (dd * 16 + hi * 8) * 2);
#pragma unroll
    for (int d0 = 0; d0 < 8; ++d0) { const char* a = kb[d0 & 3] + (d0 >> 2) * 128;
        bf16x8 b0 = *reinterpret_cast<const bf16x8*>(a);
        bf16x8 b1 = *reinterpret_cast<const bf16x8*>(a + 32 * 256);
        p0 = __builtin_amdgcn_mfma_f32_32x32x16_bf16(b0, qr[d0], p0, 0, 0, 0);
        p1 = __builtin_amdgcn_mfma_f32_32x32x16_bf16(b1, qr[d0], p1, 0, 0, 0); }
    if constexpr (MLA) {
#pragma unroll
        for (int d0 = 0; d0 < 4; ++d0) { const char* a = lds + OFF_KR + KB * SHM_KR + KRSWZ(r32, (d0 * 16 + hi * 8) * 2);
            bf16x8 b0 = *reinterpret_cast<const bf16x8*>(a);
            bf16x8 b1 = *reinterpret_cast<const bf16x8*>(a + 32 * 128);
            const bf16x8 q2 = *reinterpret_cast<const bf16x8*>(qr2l + KRSWZ(r32, (d0 * 16 + hi * 8) * 2));
            p0 = __builtin_amdgcn_mfma_f32_32x32x16_bf16(b0, q2, p0, 0, 0, 0);
            p1 = __builtin_amdgcn_mfma_f32_32x32x16_bf16(b1, q2, p1, 0, 0, 0); }
    }
}
template <int VB>
__device__ __forceinline__ void pv_tile(f32x16* o, int vb0, bf16x8 pa0, bf16x8 pa1, bf16x8 pa2, bf16x8 pa3) {
#define TRRD(dst, off) asm volatile("ds_read_b64_tr_b16 %0, %1 offset:%2" : "=&v"(dst) : "v"(vb0), "i"(off) : "memory")
#define PV_D0(d0) do { s16x4 l0, l1, l2, l3, h0, h1, h2, h3; constexpr int b_ = OFF_V + VB * SHM_V + v_rd_off(d0, 0, 0);   \
        TRRD(l0, b_); TRRD(h0, b_ + 2048); TRRD(l1, b_ + 4096); TRRD(h1, b_ + 6144); TRRD(l2, b_ + 8192); TRRD(h2, b_ + 10240); TRRD(l3, b_ + 12288); TRRD(h3, b_ + 14336); \
        asm volatile("s_waitcnt lgkmcnt(0)" ::: "memory"); SBAR();   \
        o[d0] = __builtin_amdgcn_mfma_f32_32x32x16_bf16(pa0, (bf16x8){l0[0], l0[1], l0[2], l0[3], h0[0], h0[1], h0[2], h0[3]}, o[d0], 0, 0, 0);   \
        o[d0] = __builtin_amdgcn_mfma_f32_32x32x16_bf16(pa1, (bf16x8){l1[0], l1[1], l1[2], l1[3], h1[0], h1[1], h1[2], h1[3]}, o[d0], 0, 0, 0);   \
        o[d0] = __builtin_amdgcn_mfma_f32_32x32x16_bf16(pa2, (bf16x8){l2[0], l2[1], l2[2], l2[3], h2[0], h2[1], h2[2], h2[3]}, o[d0], 0, 0, 0);   \
        o[d0] = __builtin_amdgcn_mfma_f32_32x32x16_bf16(pa3, (bf16x8){l3[0], l3[1], l3[2], l3[3], h3[0], h3[1], h3[2], h3[3]}, o[d0], 0, 0, 0); } while (0)
    PV_D0(0); PV_D0(1); PV_D0(2); PV_D0(3);
#undef PV_D0
#undef TRRD
}
struct BlockRef { const bf16_t* Q; const bf16_t* Qr; const bf16_t* K; const bf16_t* Kr; const bf16_t* V; unsigned char* O; const float* kmean; int P0; };
template <bool MLA> struct Seam { bf16x8 qr[8]; bf16x8 st_v0, st_v1, st_k0, st_k1; };

#define ROWK(p, k0, rr) ((p) + (size_t)((k0) + (rr)) * 1024 + sc)
#define VMW() asm volatile("s_waitcnt vmcnt(0)" ::: "memory")
#define VMWN(n) asm volatile("s_waitcnt vmcnt(%0)" :: "i"(n) : "memory")
#define SLOAD_H(Kp, Krp, Vp, k0, bf) do { S.st_v0 = load8(ROWK(Vp, k0, sr)); S.st_v1 = load8(ROWK(Vp, k0, 32 + sr));              \
                           \
                         __builtin_amdgcn_global_load_lds((const unsigned*)((Kp) + (size_t)(k0) * 1024 + kd0), (LAS unsigned*)(ldsl + OFF_K + (bf) * SHM_K + wid * 1024), 16, 0, 0);          \
                         __builtin_amdgcn_global_load_lds((const unsigned*)((Kp) + (size_t)(k0) * 1024 + kd1), (LAS unsigned*)(ldsl + OFF_K + (bf) * SHM_K + 8192 + wid * 1024), 16, 0, 0);   \
                         if constexpr (MLA) __builtin_amdgcn_global_load_lds((const unsigned*)((Krp) + (size_t)(k0) * 64 + kdr), (LAS unsigned*)(ldsl + OFF_KR + (bf) * SHM_KR + wid * 1024), 16, 0, 0); } while (0)
#define SWRITE_HK(bf) do { } while (0)
#define SWRITE_HV(bf) do { *(bf16x8*)(lds + OFF_V + (bf) * SHM_V + vst0) = S.st_v0; *(bf16x8*)(lds + OFF_V + (bf) * SHM_V + vst1) = S.st_v1; } while (0)
#define SWRITE_H(bf) do { SWRITE_HV(bf); SWRITE_HK(bf); } while (0)
#define QLOAD(ref) do { _Pragma("unroll") for (int d0 = 0; d0 < 8; ++d0) S.qr[d0] = MK_ATT_NT ? __builtin_nontemporal_load(reinterpret_cast<const bf16x8*>((ref).Q + (size_t)(wid * QBLK + r32) * 1024 + d0 * 16 + hi * 8)) : load8((ref).Q + (size_t)(wid * QBLK + r32) * 1024 + d0 * 16 + hi * 8); } while (0)

template <bool MLA>
__device__ __forceinline__ void prime(const BlockRef& cur, char* lds, LAS char* ldsl, Seam<MLA>& S) {
    const int tid = threadIdx.x, wid = __builtin_amdgcn_readfirstlane(tid >> 6), lane = tid & 63, r32 = lane & 31, hi = lane >> 5;
    const int sr = tid >> 4, sc = (tid & 15) * 8, kws = KSWZ(sr, sc * 2);
    int kd0, kd1, kdr; { const int g0 = wid * 64 + lane, r0 = g0 >> 4, p0 = g0 & 15; kd0 = r0 * 1024 + ((p0 ^ (r0 & 7)) << 3); const int g1 = 512 + g0, r1 = g1 >> 4, p1 = g1 & 15; kd1 = r1 * 1024 + ((p1 ^ (r1 & 7)) << 3);
        const int rr = g0 >> 3, pr = g0 & 7; kdr = rr * 64 + ((pr ^ (rr & 7)) << 3); }
    QLOAD(cur);
    S.st_v0 = load8(ROWK(cur.V, 0, sr)); S.st_v1 = load8(ROWK(cur.V, 0, 32 + sr));
    __builtin_amdgcn_global_load_lds((const unsigned*)(cur.K + kd0), (LAS unsigned*)(ldsl + OFF_K + wid * 1024), 16, 0, 0);
    __builtin_amdgcn_global_load_lds((const unsigned*)(cur.K + kd1), (LAS unsigned*)(ldsl + OFF_K + 8192 + wid * 1024), 16, 0, 0);
    if constexpr (MLA) __builtin_amdgcn_global_load_lds((const unsigned*)(cur.Kr + kdr), (LAS unsigned*)(ldsl + OFF_KR + wid * 1024), 16, 0, 0);
    VMW(); (void)kws;
    __syncthreads();
}
template <bool MLA>
__device__ __forceinline__ void block(const BlockRef& cur, const BlockRef& nxt, char* lds, LAS char* ldsl, Seam<MLA>& S) {
    const int tid = threadIdx.x, wid = __builtin_amdgcn_readfirstlane(tid >> 6), lane = tid & 63, r32 = lane & 31, hi = lane >> 5;
    const int NT = (cur.P0 + QB) / KVBLK;
    const int qlo = cur.P0 + wid * QBLK, qm = qlo + r32 - 4 * hi;
    float* ws = (float*)(lds + OFF_WS) + wid * 64; float* li_l = ws, * al_l = ws + 32;
    float m_reg = -1e30f, l_reg = 0; f32x16 o[4] = {};
    const int vb0 = (int)(uintptr_t)lds + v_rd_base(lane);
    const bf16_t* Kh = cur.K; const bf16_t* Krh = cur.Kr; const bf16_t* Vh = cur.V;
    const char* qr2l = lds + OFF_QR + wid * 4096;
    if constexpr (MLA) {
        bf16x8 tq[4];
#pragma unroll
        for (int d0 = 0; d0 < 4; ++d0) tq[d0] = load8(cur.Qr + (size_t)(wid * QBLK + r32) * 512 + d0 * 16 + hi * 8);
#pragma unroll
        for (int d0 = 0; d0 < 4; ++d0) *(bf16x8*)(lds + OFF_QR + wid * 4096 + KRSWZ(r32, (d0 * 16 + hi * 8) * 2)) = tq[d0];
        asm volatile("s_waitcnt lgkmcnt(0)" ::: "memory");
    }
#define OPQ_TID() ({ int t_ = threadIdx.x; asm volatile("" : "+v"(t_)); t_; })
#define SLOAD_P(Kp, Krp, Vp, k0, bf) do { const int t_ = OPQ_TID(), w_ = t_ >> 6, l_ = t_ & 63, g0_ = w_ * 64 + l_, r0_ = g0_ >> 4, p0_ = g0_ & 15, g1_ = 512 + g0_, r1_ = g1_ >> 4, p1_ = g1_ & 15; \
        const int kd0 = r0_ * 1024 + ((p0_ ^ (r0_ & 7)) << 3), kd1 = r1_ * 1024 + ((p1_ ^ (r1_ & 7)) << 3), kdr = 0; const int sr = t_ >> 4, sc = (t_ & 15) * 8; (void)kdr; SLOAD_H(Kp, Krp, Vp, k0, bf); } while (0)
#define SWRITE_PV(bf) do { const int t_ = OPQ_TID(), sr_ = t_ >> 4, sc_ = (t_ & 15) * 8; const int vst0 = v_st(sr_, sc_), vst1 = v_st(32 + sr_, sc_); SWRITE_HV(bf); } while (0)
    unsigned selm = 0u; const int own = cur.P0 >> 8;
    if constexpr (!MLA) {
        if (own > 0) {
            f32x16 g = {};
#pragma unroll
            for (int d0 = 0; d0 < 8; ++d0) { bf16x8 ah = {0, 0, 0, 0, 0, 0, 0, 0}, al = {0, 0, 0, 0, 0, 0, 0, 0};
                if (r32 < 8) { const float* kp = cur.kmean + r32 * 128 + d0 * 16 + hi * 8; const f32x4 x0 = *(const f32x4*)kp, x1 = *(const f32x4*)(kp + 4);
                    unsigned hh[4], ll[4];
#pragma unroll
                    for (int j = 0; j < 2; ++j) { const float a0 = x0[2 * j], a1 = x0[2 * j + 1], b0 = x1[2 * j], b1 = x1[2 * j + 1];
                        const unsigned ha0 = f2bf(a0), ha1 = f2bf(a1), hb0 = f2bf(b0), hb1 = f2bf(b1);
                        hh[j] = ha0 | (ha1 << 16); hh[2 + j] = hb0 | (hb1 << 16);
                        ll[j] = f2bf(a0 - bf2f(ha0)) | (f2bf(a1 - bf2f(ha1)) << 16); ll[2 + j] = f2bf(b0 - bf2f(hb0)) | (f2bf(b1 - bf2f(hb1)) << 16); }
                    u32x4 wh = {hh[0], hh[1], hh[2], hh[3]}, wl = {ll[0], ll[1], ll[2], ll[3]}; ah = *reinterpret_cast<bf16x8*>(&wh); al = *reinterpret_cast<bf16x8*>(&wl); }
                g = __builtin_amdgcn_mfma_f32_32x32x16_bf16(ah, S.qr[d0], g, 0, 0, 0);
                g = __builtin_amdgcn_mfma_f32_32x32x16_bf16(al, S.qr[d0], g, 0, 0, 0); }
            float gt[8];
#pragma unroll
            for (int r = 0; r < 4; ++r) { auto rr = __builtin_amdgcn_permlane32_swap(__float_as_uint(g[r]), __float_as_uint(g[r]), false, false); gt[r] = __uint_as_float(rr[0]); gt[r + 4] = __uint_as_float(rr[1]); }
#pragma unroll
            for (int n = 0; n < 8; ++n) { int rank = 0;
#pragma unroll
                for (int j = 0; j < 8; ++j) rank += (j < own && (gt[j] > gt[n] || (gt[j] == gt[n] && j < n))) ? 1 : 0;
                if (n < own && rank < 3) selm |= 1u << n; }
        }
    }
#define RESC(a) do { if (__any((a) < 1.f)) { if (hi == 0) al_l[r32] = (a); asm volatile("s_waitcnt lgkmcnt(0)" ::: "memory");              \
                     for (int d_ = 0; d_ < 4; ++d_) for (int r = 0; r < 16; ++r) o[d_][r] *= al_l[crow(r, hi)]; } } while (0)
#define KBASE(t) ((t) * KVBLK)
#define KEEP(t) (MLA || (KBASE(t) >> 8) >= own || ((selm >> (KBASE(t) >> 8)) & 1u))
#define MASKT(P0_, P1_, t) do { const int kb_ = KBASE(t); if (kb_ + KVBLK - 1 > qlo) mask_tile(P0_, P1_, qm - kb_); } while (0)
    constexpr int NQL = 8;
#define SEAM_K0() do { VMWN(NQL); SWRITE_HK(0); SBAR(); } while (0)
    f32x16 pA0, pA1, pB0, pB1; float mnA, mnB, alA, alB; bf16x8 pa0, pa1, pa2, pa3;
    SWRITE_PV(0); SBAR();
    if (NT > 1) SLOAD_P(Kh, Krh, Vh, KBASE(1), 1);
    SBAR(); qkt<0, MLA>(pA0, pA1, lds, r32, hi, S.qr, qr2l);
    MASKT(pA0, pA1, 0); partialSM<MLA>(pA0, pA1, m_reg, mnA, alA, KEEP(0));
    if (NT > 1) { VMW(); SWRITE_PV(1); }
    __syncthreads();
#define HALF_STEP(PX0, PX1, mnX, alX, PY0, PY1, alY, t, KB, VB, SB) do {                                                      \
        SBAR(); qkt<KB, MLA>(PX0, PX1, lds, r32, hi, S.qr, qr2l);                                                            \
        finishSM(PY0, PY1, alY, l_reg, pa0, pa1, pa2, pa3); SBAR();                                                           \
        if ((t) + 1 < NT) { SLOAD_P(Kh, Krh, Vh, KBASE((t) + 1), SB); SBAR(); }                                                   \
        pv_tile<VB>(o, vb0, pa0, pa1, pa2, pa3); MASKT(PX0, PX1, (t)); partialSM<MLA>(PX0, PX1, m_reg, mnX, alX, KEEP(t));    \
        __syncthreads();                                                                                                      \
        if ((t) + 1 < NT) { VMW(); SWRITE_PV(SB); }                                                                            \
        RESC(alX); __syncthreads(); } while (0)
    for (int t = 1; t + 1 < NT; t += 2) {
        HALF_STEP(pB0, pB1, mnB, alB, pA0, pA1, alA, t, 1, 0, 0);
        HALF_STEP(pA0, pA1, mnA, alA, pB0, pB1, alB, t + 1, 0, 1, 1);
    }
    SBAR(); qkt<1, MLA>(pB0, pB1, lds, r32, hi, S.qr, qr2l); SBAR();
    SLOAD_P(nxt.K, nxt.Kr, nxt.V, 0, 0); SBAR();
    QLOAD(nxt);
    SBAR();
    finishSM(pA0, pA1, alA, l_reg, pa0, pa1, pa2, pa3); SBAR();
    pv_tile<0>(o, vb0, pa0, pa1, pa2, pa3);
    MASKT(pB0, pB1, NT - 1); partialSM<MLA>(pB0, pB1, m_reg, mnB, alB, KEEP(NT - 1)); __syncthreads(); RESC(alB);
    finishSM(pB0, pB1, alB, l_reg, pa0, pa1, pa2, pa3); SBAR(); pv_tile<1>(o, vb0, pa0, pa1, pa2, pa3);
    SBAR(); SEAM_K0();
    if (hi == 0) li_l[r32] = l_reg; asm volatile("s_waitcnt lgkmcnt(0)" ::: "memory");
    float rli[16];
#pragma unroll
    for (int r = 0; r < 16; ++r) rli[r] = __builtin_amdgcn_rcpf(li_l[crow(r, hi)]);
    unsigned char* Ow = cur.O + (size_t)(wid * QBLK) * 2048;
    {
        unsigned char* stg = (unsigned char*)(lds + OFF_QR + wid * 4096);
#pragma unroll
        for (int r = 0; r < 16; ++r) { const int orow = crow(r, hi);
#pragma unroll
            for (int d0 = 0; d0 < 4; ++d0) { const float v = o[d0][r] * rli[r];
                stg[orow * 128 + d0 * 32 + r32] = (unsigned char)(__builtin_amdgcn_cvt_pk_fp8_f32(v * 64.f, 0.f, 0u, false) & 0xffu); } }
        asm volatile("s_waitcnt lgkmcnt(0)" ::: "memory");
#pragma unroll
        for (int i = 0; i < 4; ++i) { const u32x4 w = *(const u32x4*)(stg + i * 1024 + lane * 16); if (MK_ATT_NT) __builtin_nontemporal_store(w, (u32x4*)(Ow + (size_t)(i * 8 + (lane >> 3)) * 2048 + (lane & 7) * 16)); else ST16NT(Ow + (size_t)(i * 8 + (lane >> 3)) * 2048 + (lane & 7) * 16, w); }
    }
    if constexpr (MLA) VMW();
    __syncthreads();
#undef RESC
#undef KBASE
#undef KEEP
#undef MASKT
#undef SEAM_K0
#undef HALF_STEP
#undef SLOAD_P
#undef SWRITE_PV
#undef OPQ_TID
}
template <bool MLA>
__device__ __forceinline__ void block_np(const BlockRef& cur, const BlockRef& nxt, char* lds, LAS char* ldsl, Seam<MLA>& S) {
    const int tid = threadIdx.x, wid = __builtin_amdgcn_readfirstlane(tid >> 6), lane = tid & 63, r32 = lane & 31, hi = lane >> 5;
    const int NT = (cur.P0 + QB) / KVBLK;
    const int qlo = cur.P0 + wid * QBLK, qm = qlo + r32 - 4 * hi;
    float* ws = (float*)(lds + OFF_WS) + wid * 64; float* li_l = ws, * al_l = ws + 32;
    float m_reg = -1e30f, l_reg = 0; f32x16 o[4] = {};
    const int sr = tid >> 4, sc = (tid & 15) * 8, vst0 = v_st(sr, sc), vst1 = v_st(32 + sr, sc), kws = 0; (void)kws;
    int kd0, kd1, kdr; { const int g0 = wid * 64 + lane, r0 = g0 >> 4, p0 = g0 & 15; kd0 = r0 * 1024 + ((p0 ^ (r0 & 7)) << 3); const int g1 = 512 + g0, r1 = g1 >> 4, p1 = g1 & 15; kd1 = r1 * 1024 + ((p1 ^ (r1 & 7)) << 3);
        const int rr = g0 >> 3, pr = g0 & 7; kdr = rr * 64 + ((pr ^ (rr & 7)) << 3); }
    const int vb0 = (int)(uintptr_t)lds + v_rd_base(lane);
    const char* qr2l = lds + OFF_QR + wid * 4096;
#define KV_LOAD(Kp, Krp, Vp, k0, bf) do { S.st_v0 = load8(ROWK(Vp, k0, sr)); S.st_v1 = load8(ROWK(Vp, k0, 32 + sr));                                                                        \
        __builtin_amdgcn_global_load_lds((const unsigned*)((Kp) + (size_t)(k0) * 1024 + kd0), (LAS unsigned*)(ldsl + OFF_K + (bf) * SHM_K + wid * 1024), 16, 0, 0);                       \
        __builtin_amdgcn_global_load_lds((const unsigned*)((Kp) + (size_t)(k0) * 1024 + kd1), (LAS unsigned*)(ldsl + OFF_K + (bf) * SHM_K + 8192 + wid * 1024), 16, 0, 0);                \
        if constexpr (MLA) __builtin_amdgcn_global_load_lds((const unsigned*)((Krp) + (size_t)(k0) * 64 + kdr), (LAS unsigned*)(ldsl + OFF_KR + (bf) * SHM_KR + wid * 1024), 16, 0, 0); } while (0)
    if constexpr (MLA) {
        bf16x8 tq[4];
#pragma unroll
        for (int d0 = 0; d0 < 4; ++d0) tq[d0] = load8(cur.Qr + (size_t)(wid * QBLK + r32) * 512 + d0 * 16 + hi * 8);
#pragma unroll
        for (int d0 = 0; d0 < 4; ++d0) *(bf16x8*)(lds + OFF_QR + wid * 4096 + KRSWZ(r32, (d0 * 16 + hi * 8) * 2)) = tq[d0];
    }
    unsigned selm = 0u; const int own = cur.P0 >> 8;
    if constexpr (!MLA) {
        if (own > 0) {
            f32x16 g = {};
#pragma unroll
            for (int d0 = 0; d0 < 8; ++d0) { bf16x8 ah = {0, 0, 0, 0, 0, 0, 0, 0}, al = {0, 0, 0, 0, 0, 0, 0, 0};
                if (r32 < 8) { const float* kp = cur.kmean + r32 * 128 + d0 * 16 + hi * 8; const f32x4 x0 = *(const f32x4*)kp, x1 = *(const f32x4*)(kp + 4);
                    unsigned hh[4], ll[4];
#pragma unroll
                    for (int j = 0; j < 2; ++j) { const float a0 = x0[2 * j], a1 = x0[2 * j + 1], b0 = x1[2 * j], b1 = x1[2 * j + 1];
                        const unsigned ha0 = f2bf(a0), ha1 = f2bf(a1), hb0 = f2bf(b0), hb1 = f2bf(b1);
                        hh[j] = ha0 | (ha1 << 16); hh[2 + j] = hb0 | (hb1 << 16);
                        ll[j] = f2bf(a0 - bf2f(ha0)) | (f2bf(a1 - bf2f(ha1)) << 16); ll[2 + j] = f2bf(b0 - bf2f(hb0)) | (f2bf(b1 - bf2f(hb1)) << 16); }
                    u32x4 wh = {hh[0], hh[1], hh[2], hh[3]}, wl = {ll[0], ll[1], ll[2], ll[3]}; ah = *reinterpret_cast<bf16x8*>(&wh); al = *reinterpret_cast<bf16x8*>(&wl); }
                g = __builtin_amdgcn_mfma_f32_32x32x16_bf16(ah, S.qr[d0], g, 0, 0, 0);
                g = __builtin_amdgcn_mfma_f32_32x32x16_bf16(al, S.qr[d0], g, 0, 0, 0); }
            float gt[8];
#pragma unroll
            for (int r = 0; r < 4; ++r) { auto rr = __builtin_amdgcn_permlane32_swap(__float_as_uint(g[r]), __float_as_uint(g[r]), false, false); gt[r] = __uint_as_float(rr[0]); gt[r + 4] = __uint_as_float(rr[1]); }
#pragma unroll
            for (int n = 0; n < 8; ++n) { int rank = 0;
#pragma unroll
                for (int j = 0; j < 8; ++j) rank += (j < own && (gt[j] > gt[n] || (gt[j] == gt[n] && j < n))) ? 1 : 0;
                if (n < own && rank < 3) selm |= 1u << n; }
        }
    }
    SWRITE_HV(0);
    asm volatile("s_waitcnt lgkmcnt(0)" ::: "memory");
    __syncthreads();
    f32x16 p0, p1; float mn, al; bf16x8 pa0, pa1, pa2, pa3;
#define RESC(a) do { if (__any((a) < 1.f)) { if (hi == 0) al_l[r32] = (a); asm volatile("s_waitcnt lgkmcnt(0)" ::: "memory");              \
                     for (int d_ = 0; d_ < 4; ++d_) for (int r = 0; r < 16; ++r) o[d_][r] *= al_l[crow(r, hi)]; } } while (0)
#define MSTEP(t, BUF, NB) do {                                                                                               \
        const bool lastt = ((t) + 1 >= NT);                                                                                  \
        { const bf16_t* Kp_ = lastt ? nxt.K : cur.K; const bf16_t* Krp_ = lastt ? nxt.Kr : cur.Kr; const bf16_t* Vp_ = lastt ? nxt.V : cur.V; const int k0_ = lastt ? 0 : ((t) + 1) * KVBLK; \
          KV_LOAD(Kp_, Krp_, Vp_, k0_, NB); }                                                                                  \
        SBAR(); qkt<BUF, MLA>(p0, p1, lds, r32, hi, S.qr, qr2l); SBAR();                                                      \
        if (lastt) { QLOAD(nxt); SBAR(); }                                                                                   \
        { const int kb_ = (t) * KVBLK; if (kb_ + KVBLK - 1 > qlo) mask_tile(p0, p1, qm - kb_); }                              \
        partialSM<MLA>(p0, p1, m_reg, mn, al, MLA || (((t) * KVBLK) >> 8) >= own || ((selm >> (((t) * KVBLK) >> 8)) & 1u)); finishSM(p0, p1, al, l_reg, pa0, pa1, pa2, pa3); RESC(al); SBAR(); \
        if (EXP_EARLY_WAIT) VMW();                                                                                           \
        pv_tile<BUF>(o, vb0, pa0, pa1, pa2, pa3);                                                                            \
        if (!lastt) { VMW(); SWRITE_HV(NB); asm volatile("s_waitcnt lgkmcnt(0)" ::: "memory"); __syncthreads(); } } while (0)
    for (int t = 0; t < NT; t += 2) { MSTEP(t, 0, 1); MSTEP(t + 1, 1, 0); }
#undef MSTEP
#undef KV_LOAD
    if (hi == 0) li_l[r32] = l_reg; asm volatile("s_waitcnt lgkmcnt(0)" ::: "memory");
    float rli[16];
#pragma unroll
    for (int r = 0; r < 16; ++r) rli[r] = __builtin_amdgcn_rcpf(li_l[crow(r, hi)]);
    unsigned char* Ow = cur.O + (size_t)(wid * QBLK) * 2048;
    {
        unsigned char* stg = (unsigned char*)(lds + OFF_QR + wid * 4096);
#pragma unroll
        for (int r = 0; r < 16; ++r) { const int orow = crow(r, hi);
#pragma unroll
            for (int d0 = 0; d0 < 4; ++d0) { const float v = o[d0][r] * rli[r];
                stg[orow * 128 + d0 * 32 + r32] = (unsigned char)(__builtin_amdgcn_cvt_pk_fp8_f32(v * 64.f, 0.f, 0u, false) & 0xffu); } }
        asm volatile("s_waitcnt lgkmcnt(0)" ::: "memory");
#pragma unroll
        for (int i = 0; i < 4; ++i) { const u32x4 w = *(const u32x4*)(stg + i * 1024 + lane * 16); if (MK_ATT_NT) __builtin_nontemporal_store(w, (u32x4*)(Ow + (size_t)(i * 8 + (lane >> 3)) * 2048 + (lane & 7) * 16)); else ST16NT(Ow + (size_t)(i * 8 + (lane >> 3)) * 2048 + (lane & 7) * 16, w); }
    }
    VMW();
    __syncthreads();
#undef RESC
}
#undef ROWK
#undef VMW
#undef VMWN
#undef SLOAD_H
#undef SWRITE_HK
#undef SWRITE_HV
#undef SWRITE_H
#undef QLOAD

#ifndef MK_MLA_PIPE
#define MK_MLA_PIPE 0
#endif
#ifndef MK_ATT_BAL
#define MK_ATT_BAL 0
#endif
struct Tensors { const bf16_t *QA, *KA, *VA, *QMN, *QMR, *KN, *KR, *VM; unsigned char* MIX; const float* KMEAN; };
template <bool MLA>
__device__ __forceinline__ BlockRef make_ref(const Tensors& Tn, int item, int pass) {
    const int bh = item >> 2, y = item & 3, b = bh >> 3, h = bh & 7;
    const int qb = MLA && MK_ATT_BAL ? (pass ? (0x6457 >> (4 * y)) & 7 : (y + 1) & 3) : (pass ? 7 - y : y);
    BlockRef r; const size_t t0 = (size_t)b * 2048, tq = t0 + (size_t)qb * 256;
    if (MLA) { r.Q = Tn.QMN + tq * 1024 + h * 128; r.Qr = Tn.QMR + tq * 512 + h * 64; r.K = Tn.KN + t0 * 1024 + h * 128; r.Kr = Tn.KR + t0 * 64; r.V = Tn.VM + t0 * 1024 + h * 128; r.O = Tn.MIX + tq * 2048 + 1024 + h * 128; r.kmean = nullptr; }
    else { r.Q = Tn.QA + tq * 1024 + h * 128; r.Qr = nullptr; r.K = Tn.KA + t0 * 1024 + h * 128; r.Kr = nullptr; r.V = Tn.VA + t0 * 1024 + h * 128; r.O = Tn.MIX + tq * 2048 + h * 128; r.kmean = Tn.KMEAN + (size_t)bh * 8 * 128; }
    r.P0 = qb * 256; return r;
}
template <bool MLA>
__device__ __forceinline__ void phase(char* lds, LAS char* ldsl, const Tensors& Tn, int vcu, int G, int p_lo = 0, int p_hi = 2, int rev = 0) {
    constexpr int total = 256;
    int L = vcu; if (L >= total) return;
    int pass = p_lo;
    BlockRef cur = make_ref<MLA>(Tn, L, pass ^ rev);
    Seam<MLA> S;
    prime<MLA>(cur, lds, ldsl, S);
    for (;;) {
        const bool more_pass = pass + 1 < p_hi, more_item = L + G < total, last = !more_pass && !more_item;
        int passn = pass + 1, Ln = L;
        if (!more_pass) { passn = p_lo; Ln = more_item ? L + G : L; }
        const BlockRef nxt = last ? cur : make_ref<MLA>(Tn, Ln, passn ^ rev);
        if constexpr (MLA && !MK_MLA_PIPE) block_np<MLA>(cur, nxt, lds, ldsl, S); else block<MLA>(cur, nxt, lds, ldsl, S);
        if (last) break;
        cur = nxt; pass = passn; L = Ln;
    }
}
}
#ifndef MK_RT_LO
#define MK_RT_LO 0
#endif
#ifndef EXP_LNA_REP
#define EXP_LNA_REP 1
#endif
#ifndef EXP_NOREDIR
#define EXP_NOREDIR 0
#endif
#ifndef MK_RELAX9
#define MK_RELAX9 0
#endif
#ifndef MK_WFOLD
#define MK_WFOLD 1
#endif
#ifndef EXP_EPI_DOWN2
#define EXP_EPI_DOWN2 0
#endif
#ifndef EXP_EPI_GU2
#define EXP_EPI_GU2 0
#endif
#ifndef MK_ROUTE_FAST
#define MK_ROUTE_FAST 1
#endif
#if MK_ROUTE_FAST
#define RT_ROUTE rt::route_token_fast
#else
#define RT_ROUTE rt::route_token
#endif
#ifndef EXP_ROUTE_REP
#define EXP_ROUTE_REP 1
#endif
#ifndef MK_RD_NT
#define MK_RD_NT 1
#endif
#ifndef MK_OUT_NT
#define MK_OUT_NT 0
#endif
#ifndef MK_X1_NT
#define MK_X1_NT 0
#endif
struct SchedOut {
    TileOrder o; const char* A; const char* Bt;
    __device__ __forceinline__ bool next(int i, pg8::Unit& u) const { int pm, pn; if (!o.get(i, pm, pn)) return false;
        u.pm = pm; u.pn = pn; u.kind = 0; u.aux = 0; u.rows = nullptr; u.nvalid = 256; u.a = A + (size_t)pm * 256 * 2048; u.b = Bt + (size_t)pn * 256 * 2048; return true; }
};
struct EpiOut {
    static constexpr bool PERM = true, TWICE = false, B64 = false, PREF = false; static constexpr int RELAX = 0;
    const float* mod; bf16_t* Y;
    __device__ __forceinline__ void operator()(const f32x4 (&acc)[2][2][4][2], const pg8::Unit& u, int wr, int wc, int fr, int fq) const {
        int row0 = u.pm * 256 + wr * 64 + fr, col0 = u.pn * 256 + wc * 32 + 8 * fq;
        const float* g1 = mod + (size_t)(u.pm >> 3) * 12288 + 2 * 2048;
        f32x4 gv[2][2];
#pragma unroll
        for (int bj = 0; bj < 2; ++bj)
#pragma unroll
            for (int n = 0; n < 2; ++n) gv[bj][n] = *(const f32x4*)(g1 + col0 + bj * 128 + n * 4) + 1.f;
#pragma unroll
        for (int ai = 0; ai < 2; ++ai)
#pragma unroll
            for (int m = 0; m < 4; ++m) { const size_t off = (size_t)(row0 + ai * 128 + m * 16) * 2048 + col0;
#pragma unroll
                for (int bj = 0; bj < 2; ++bj) ST16NT(Y + off + bj * 128, pack8(gv[bj][0] * acc[ai][bj][m][0], gv[bj][1] * acc[ai][bj][m][1])); }
    }
};

#ifndef EXP_RT_REP
#define EXP_RT_REP 1
#endif
#ifndef EXP_LN_REP
#define EXP_LN_REP 1
#endif
#ifndef MK_P6_DESYNC
#define MK_P6_DESYNC 0
#endif
__device__ __forceinline__ void p6_ln_route_lds(Frame& F, const float* __restrict__ x, const bf16_t* __restrict__ Y, const float* __restrict__ mod, const float* __restrict__ lg, const float* __restrict__ lb, bf16_t* __restrict__ X1, unsigned char* __restrict__ H2F8,
                                                const bf16_t* __restrict__ WrT, const float* __restrict__ rbias, float* __restrict__ logits, unsigned long long* __restrict__ tokmask, float* __restrict__ tw, int* __restrict__ hist) {
    LAS unsigned char* img = F.lds + RING_OFF;
    LAS float* lgl = (LAS float*)(F.lds + RING_OFF + 65536);
    LAS unsigned long long* lm = (LAS unsigned long long*)(F.lds + LDSCTL_OFF + 2048);
    for (int blk = F.vcu; blk < 256; blk += F.G) {
        const int odd = MK_P6_DESYNC ? (F.vcu & 1) : 0, nch = odd ? 3 : 2;
#pragma unroll 1
        for (int ch = 0; ch < nch; ++ch) {
            int tid_ = F.tid; asm volatile("" : "+v"(tid_));
            const int nrows = odd ? (ch == 1 ? 32 : 16) : 32, row0 = odd ? (ch == 0 ? 0 : ch == 1 ? 16 : 48) : ch * 32, rpw = nrows >> 3; const bool two = nrows > 16;
#pragma unroll 1
            for (int lnrep_ = 0; lnrep_ < EXP_LNA_REP; ++lnrep_)
#pragma unroll 1
            for (int i = 0; i < rpw; ++i) { const int r = F.wave * rpw + i, t = blk * 64 + row0 + r, b = t >> 11; const float* m = mod + b * 12288;
                const GAS f32x4* xr = (const GAS f32x4*)(x + (size_t)t * D) + F.lane; const GAS u32x2* yr = (const GAS u32x2*)(Y + (size_t)t * D) + F.lane; f32x4 v[8]; u32x2 yv[8]; float s = 0.f;
#pragma unroll
                for (int j = 0; j < 8; ++j) { v[j] = MK_RD_NT ? __builtin_nontemporal_load((const f32x4*)(xr + 64 * j)) : xr[64 * j]; yv[j] = MK_RD_NT ? __builtin_nontemporal_load((const u32x2*)(yr + 64 * j)) : yr[64 * j]; }
#pragma unroll
                for (int j = 0; j < 8; ++j) { v[j] = v[j] * ALPHA + (f32x4){bf2f(yv[j].x & 0xffffu), bf2f(yv[j].x >> 16), bf2f(yv[j].y & 0xffffu), bf2f(yv[j].y >> 16)}; s += (v[j][0] + v[j][1]) + (v[j][2] + v[j][3]); }
                const float mean = wave_sum(s) * (1.f / D); float s2 = 0.f;
#pragma unroll
                for (int j = 0; j < 8; ++j) { v[j] = v[j] - mean; s2 += (v[j][0] * v[j][0] + v[j][1] * v[j][1]) + (v[j][2] * v[j][2] + v[j][3] * v[j][3]); }
                const float rstd = 1.f / sqrtf(wave_sum(s2) * (1.f / D) + 1e-5f);
                GAS u32x2* xo = (GAS u32x2*)(X1 + (size_t)t * D) + F.lane; GAS unsigned* h8 = (GAS unsigned*)(H2F8 + (size_t)t * D) + F.lane;
                LAS unsigned char* irow = img + r * 4096 + ((F.lane & 1) << 3);
#pragma unroll
                for (int j = 0; j < 8; ++j) { const int d = 256 * j + 4 * F.lane; const f32x4 o = v[j] * rstd * *(const f32x4*)(lg + d) + *(const f32x4*)(lb + d);
                    u32x2 w1; w1.x = cvt_pk_bf16(o[0], o[1]); w1.y = cvt_pk_bf16(o[2], o[3]); if (MK_X1_NT) __builtin_nontemporal_store(w1, (u32x2*)(xo + 64 * j)); else xo[64 * j] = w1;
                    const f32x4 h = o * (*(const f32x4*)(m + 4 * 2048 + d) + 1.f) + *(const f32x4*)(m + 3 * 2048 + d); u32x2 w; w.x = cvt_pk_bf16(h[0], h[1]); w.y = cvt_pk_bf16(h[2], h[3]);
                    *(LAS u32x2*)(irow + (((32 * j + (F.lane >> 1)) ^ (r & 15)) << 4)) = w; h8[64 * j] = pk4_fp8(h[0], h[1], h[2], h[3]); } }
            { int fr = tid_ & 15, fq = (tid_ >> 4) & 3;
              f32x4 acc[2][4];
#pragma unroll
                for (int mi = 0; mi < 2; ++mi)
#pragma unroll
                    for (int ni = 0; ni < 4; ++ni) acc[mi][ni] = (f32x4){0.f, 0.f, 0.f, 0.f};
                bf16x8 a[2], bq[3][8];
#define RT_LDB(slot_, ks_) do { const int k_ = F.wave * 256 + (ks_) * 32 + fq * 8; _Pragma("unroll") for (int ni = 0; ni < 4; ++ni) { bq[slot_][ni] = *(const bf16x8*)(WrT + (size_t)(ni * 16 + fr) * D + k_); if (MK_RT_LO) bq[slot_][4 + ni] = *(const bf16x8*)(WrT + (size_t)(64 + ni * 16 + fr) * D + k_); } } while (0)
#define RT_LDA(ks_) do { const int c_ = F.wave * 32 + (ks_) * 4 + fq; _Pragma("unroll") for (int mi = 0; mi < 2; ++mi) a[mi] = *(const LAS bf16x8*)(img + (mi * 16 + fr) * 4096 + ((c_ ^ fr) << 4)); } while (0)
#define RT_MMA(slot_) do { _Pragma("unroll") for (int mi = 0; mi < 2; ++mi) if (mi == 0 || two) _Pragma("unroll") for (int ni = 0; ni < 4; ++ni) { acc[mi][ni] = __builtin_amdgcn_mfma_f32_16x16x32_bf16(a[mi], bq[slot_][ni], acc[mi][ni], 0, 0, 0); if (MK_RT_LO) acc[mi][ni] = __builtin_amdgcn_mfma_f32_16x16x32_bf16(a[mi], bq[slot_][4 + ni], acc[mi][ni], 0, 0, 0); } } while (0)
                RT_LDB(0, 0); RT_LDB(1, 1);
                __syncthreads();
                RT_LDB(2, 2);
                RT_LDA(0); RT_MMA(0); RT_LDB(0, 3);
                RT_LDA(1); RT_MMA(1); RT_LDB(1, 4);
                RT_LDA(2); RT_MMA(2); RT_LDB(2, 5);
                RT_LDA(3); RT_MMA(0); RT_LDB(0, 6);
                RT_LDA(4); RT_MMA(1); RT_LDB(1, 7);
                RT_LDA(5); RT_MMA(2);
                RT_LDA(6); RT_MMA(0);
                RT_LDA(7); RT_MMA(1);
#undef RT_LDB
#undef RT_LDA
#undef RT_MMA
                __syncthreads();
                LAS float* red = (LAS float*)img + F.wave * 2048;
#pragma unroll
                for (int mi = 0; mi < 2; ++mi)
#pragma unroll
                    for (int ni = 0; ni < 4; ++ni)
#pragma unroll
                        for (int r = 0; r < 4; ++r) red[(mi * 16 + 4 * fq + r) * 64 + ni * 16 + fr] = acc[mi][ni][r];
                __syncthreads();
#pragma unroll
                for (int q = 0; q < 4; ++q) { const int i = tid_ + q * NTHR; float s = 0.f;
#pragma unroll
                    for (int w = 0; w < 8; ++w) s += ((LAS float*)img)[w * 2048 + i];
                    if (i < nrows * 64) { logits[(size_t)(blk * 64 + row0) * 64 + i] = s; lgl[i] = s; } }
                __syncthreads();
            }
            const float bias = rbias[F.lane];
            _Pragma("unroll 1") for (int rr_ = 0; rr_ < EXP_ROUTE_REP; ++rr_)
            for (int i = F.wave; i < nrows; i += NWAVES) { const int t = blk * 64 + row0 + i; unsigned long long mask; float w;
                RT_ROUTE(lgl[i * 64 + F.lane], bias, F.lane, mask, w);
                tw[(size_t)t * 64 + F.lane] = w; if (F.lane == 0) { tokmask[t] = mask; lm[row0 + i] = mask; } }
            __syncthreads();
        }
        if (F.tid < 64) { int c = 0; for (int i = 0; i < 64; ++i) c += (int)((lm[i] >> F.tid) & 1ull); hist[blk * 64 + F.tid] = c; }
        __syncthreads();
    }
}
__device__ __forceinline__ void p6_ln_route(Frame& F, const float* __restrict__ x, const bf16_t* __restrict__ Y, const float* __restrict__ mod, const float* __restrict__ lg, const float* __restrict__ lb, bf16_t* __restrict__ X1, bf16_t* __restrict__ H2, unsigned char* __restrict__ H2F8,
                                            const bf16_t* __restrict__ WrT, const float* __restrict__ rbias, float* __restrict__ logits, unsigned long long* __restrict__ tokmask, float* __restrict__ tw, int* __restrict__ hist) {
    for (int blk = F.vcu; blk < 256; blk += F.G) {
        for (int rep_ = 0; rep_ < EXP_LN_REP; ++rep_)
        for (int i = F.wave; i < 64; i += NWAVES) { const int t = blk * 64 + i, b = t >> 11; const float* m = mod + b * 12288;
            const GAS f32x4* xr = (const GAS f32x4*)(x + (size_t)t * D) + F.lane; const GAS u32x2* yr = (const GAS u32x2*)(Y + (size_t)t * D) + F.lane; f32x4 v[8]; u32x2 yv[8]; float s = 0.f;
#pragma unroll
            for (int j = 0; j < 8; ++j) { v[j] = MK_RD_NT ? __builtin_nontemporal_load((const f32x4*)(xr + 64 * j)) : xr[64 * j]; yv[j] = MK_RD_NT ? __builtin_nontemporal_load((const u32x2*)(yr + 64 * j)) : yr[64 * j]; }
#pragma unroll
            for (int j = 0; j < 8; ++j) { v[j] = v[j] * ALPHA + (f32x4){bf2f(yv[j].x & 0xffffu), bf2f(yv[j].x >> 16), bf2f(yv[j].y & 0xffffu), bf2f(yv[j].y >> 16)}; s += (v[j][0] + v[j][1]) + (v[j][2] + v[j][3]); }
            const float mean = wave_sum(s) * (1.f / D); float s2 = 0.f;
#pragma unroll
            for (int j = 0; j < 8; ++j) { v[j] = v[j] - mean; s2 += (v[j][0] * v[j][0] + v[j][1] * v[j][1]) + (v[j][2] * v[j][2] + v[j][3] * v[j][3]); }
            const float rstd = 1.f / sqrtf(wave_sum(s2) * (1.f / D) + 1e-5f);
            GAS u32x2* xo = (GAS u32x2*)(X1 + (size_t)t * D) + F.lane; GAS u32x2* ho = (GAS u32x2*)(H2 + (size_t)t * D) + F.lane; GAS unsigned* h8 = (GAS unsigned*)(H2F8 + (size_t)t * D) + F.lane;
#pragma unroll
            for (int j = 0; j < 8; ++j) { const int d = 256 * j + 4 * F.lane; const f32x4 o = v[j] * rstd * *(const f32x4*)(lg + d) + *(const f32x4*)(lb + d);
                u32x2 w1; w1.x = cvt_pk_bf16(o[0], o[1]); w1.y = cvt_pk_bf16(o[2], o[3]); xo[64 * j] = w1;
                const f32x4 h = o * (*(const f32x4*)(m + 4 * 2048 + d) + 1.f) + *(const f32x4*)(m + 3 * 2048 + d); u32x2 w; w.x = cvt_pk_bf16(h[0], h[1]); w.y = cvt_pk_bf16(h[2], h[3]); ho[64 * j] = w; h8[64 * j] = pk4_fp8(h[0], h[1], h[2], h[3]); } }
        VM_WAIT(); __syncthreads();
        _Pragma("unroll 1") for (int rrep_ = 0; rrep_ < EXP_RT_REP; ++rrep_) {
        { const int fr = F.lane & 15, fq = F.lane >> 4; f32x4 acc[4][4];
#pragma unroll
            for (int mi = 0; mi < 4; ++mi)
#pragma unroll
                for (int ni = 0; ni < 4; ++ni) acc[mi][ni] = (f32x4){0.f, 0.f, 0.f, 0.f};
            bf16x8 a[4], bh[4], bl[4], an[4], bhn[4], bln[4];
#define RT_LOAD(A_, BH_, BL_, ks_) do { const int k_ = F.wave * 256 + (ks_) * 32 + fq * 8; _Pragma("unroll") for (int mi = 0; mi < 4; ++mi) A_[mi] = *(const bf16x8*)(H2 + (size_t)(blk * 64 + mi * 16 + fr) * D + k_); \
                _Pragma("unroll") for (int ni = 0; ni < 4; ++ni) { BH_[ni] = *(const bf16x8*)(WrT + (size_t)(ni * 16 + fr) * D + k_); BL_[ni] = *(const bf16x8*)(WrT + (size_t)(64 + ni * 16 + fr) * D + k_); } } while (0)
            RT_LOAD(a, bh, bl, 0);
#pragma unroll 1
            for (int ks = 0; ks < 8; ks += 2) {
                RT_LOAD(an, bhn, bln, ks + 1);
#pragma unroll
                for (int mi = 0; mi < 4; ++mi)
#pragma unroll
                    for (int ni = 0; ni < 4; ++ni) { acc[mi][ni] = __builtin_amdgcn_mfma_f32_16x16x32_bf16(a[mi], bh[ni], acc[mi][ni], 0, 0, 0); acc[mi][ni] = __builtin_amdgcn_mfma_f32_16x16x32_bf16(a[mi], bl[ni], acc[mi][ni], 0, 0, 0); }
                if (ks + 2 < 8) RT_LOAD(a, bh, bl, ks + 2);
#pragma unroll
                for (int mi = 0; mi < 4; ++mi)
#pragma unroll
                    for (int ni = 0; ni < 4; ++ni) { acc[mi][ni] = __builtin_amdgcn_mfma_f32_16x16x32_bf16(an[mi], bhn[ni], acc[mi][ni], 0, 0, 0); acc[mi][ni] = __builtin_amdgcn_mfma_f32_16x16x32_bf16(an[mi], bln[ni], acc[mi][ni], 0, 0, 0); }
            }
#undef RT_LOAD
            LAS float* red = (LAS float*)(F.lds + RING_OFF) + F.wave * 4096;
#pragma unroll
            for (int mi = 0; mi < 4; ++mi)
#pragma unroll
                for (int ni = 0; ni < 4; ++ni)
#pragma unroll
                    for (int r = 0; r < 4; ++r) red[(mi * 16 + 4 * fq + r) * 64 + ni * 16 + fr] = acc[mi][ni][r];
            __syncthreads();
            float sums[8];
#pragma unroll
            for (int q = 0; q < 8; ++q) { const int i = F.tid + q * NTHR; float s = 0.f;
#pragma unroll
                for (int w = 0; w < 8; ++w) s += ((LAS float*)(F.lds + RING_OFF))[w * 4096 + i];
                sums[q] = s; }
            __syncthreads();
#pragma unroll
            for (int q = 0; q < 8; ++q) { const int i = F.tid + q * NTHR; logits[(size_t)blk * 4096 + i] = sums[q]; ((LAS float*)(F.lds + RING_OFF))[i] = sums[q]; }
            __syncthreads();
        }
        { LAS float* lg_l = (LAS float*)(F.lds + RING_OFF); LAS unsigned long long* lm = (LAS unsigned long long*)(F.lds + RING_OFF + 16384);
            const float bias = rbias[F.lane];
            for (int i = F.wave; i < 64; i += NWAVES) { const int t = blk * 64 + i; unsigned long long mask; float w;
                RT_ROUTE(lg_l[i * 64 + F.lane], bias, F.lane, mask, w);
                tw[(size_t)t * 64 + F.lane] = w; if (F.lane == 0) { tokmask[t] = mask; lm[i] = mask; } }
            __syncthreads();
            if (F.tid < 64) { int c = 0; for (int i = 0; i < 64; ++i) c += (int)((lm[i] >> F.tid) & 1ull); hist[blk * 64 + F.tid] = c; }
            __syncthreads();
        }
        }
    }
}
__device__ __forceinline__ void p7_scatter(Frame& F, const int* hist, const unsigned long long* tokmask, const float* tw, int* stok, float* sw, int* tokpos, int* starts, int* cnts, LAS int* tstart = nullptr, LAS int* ttab = nullptr) {
    LAS int* li = (LAS int*)(F.lds + RING_OFF);
    LAS unsigned long long* lm = (LAS unsigned long long*)(F.lds + RING_OFF + 8192);
    LAS float* ltw = (LAS float*)(F.lds + RING_OFF + 16384);
    for (int blk = F.vcu; blk < 256; blk += F.G) {
        { const int e = F.tid & 63, part = F.tid >> 6; int tot = 0, before = 0;
#pragma unroll 8
            for (int b = part * 32; b < part * 32 + 32; ++b) { const int c = hist[b * 64 + e]; tot += c; before += (b < blk) ? c : 0; }
            li[part * 64 + e] = tot; li[512 + part * 64 + e] = before; }
        if (F.tid < 64) lm[F.tid] = tokmask[blk * 64 + F.tid];
        for (int i = F.tid; i < 4096; i += NTHR) ltw[i] = tw[(size_t)blk * 4096 + i];
        __syncthreads();
        if (F.tid < 64) { int tot = 0, before = 0;
#pragma unroll
            for (int p = 0; p < 8; ++p) { tot += li[p * 64 + F.tid]; before += li[512 + p * 64 + F.tid]; }
            li[1024 + F.tid] = tot; li[1088 + F.tid] = before; }
        __syncthreads();
        if (tstart) {
            if (F.tid == 0) { int acc = 0, st = 0; for (int e = 0; e < 64; ++e) { tstart[e] = acc; tstart[128 + e] = st; const int c = li[1024 + e]; acc += (c + 255) >> 8; st += c; } tstart[64] = acc; tstart[128 + 64] = 131072; acc += T / 256; tstart[65] = acc; }
            __syncthreads();
            if (F.tid < 65) { const int e = F.tid, cnt = e < 64 ? li[1024 + e] : T, st = tstart[128 + e], t0 = tstart[e], nt = tstart[e + 1] - t0;
                for (int mt = 0; mt < nt; ++mt) { ttab[3 * (t0 + mt)] = e; ttab[3 * (t0 + mt) + 1] = st + mt * 256; ttab[3 * (t0 + mt) + 2] = (cnt - mt * 256) < 256 ? (cnt - mt * 256) : 256; } }
        }
        { const int e = F.tid & 63, g = F.tid >> 6; int c = 0;
#pragma unroll
            for (int i = 0; i < 8; ++i) c += (int)((lm[g * 8 + i] >> e) & 1ull);
            li[1152 + g * 64 + e] = c; }
        __syncthreads();
        { const int e = F.tid & 63, g = F.tid >> 6; int st = 0; for (int j = 0; j < e; ++j) st += li[1024 + j];
            if (blk == 0 && g == 0) { starts[e] = st; cnts[e] = li[1024 + e]; }
            int pos = st + li[1088 + e];
            for (int gg = 0; gg < g; ++gg) pos += li[1152 + gg * 64 + e];
#pragma unroll
            for (int i = 0; i < 8; ++i) { const int ti = g * 8 + i, t = blk * 64 + ti; const unsigned long long m = lm[ti];
                if ((m >> e) & 1ull) { stok[pos] = t; sw[pos] = ltw[ti * 64 + e]; tokpos[t * 8 + __popcll(m & ((1ull << e) - 1ull))] = pos; ++pos; } } }
        __syncthreads();
    }
}
struct SchedMoe {
    const LAS int* ttab; int ntiles, nN, G, c; int K;
    const char* A; const char* Bt; size_t bstride; const int* stok; bool gather;
    __device__ __forceinline__ bool next(int i, pg8::Unit& u) const {
        const long L = (long)i * G + c; const int nwg = ntiles * nN; if (L >= nwg) return false;
        const int wgid = pg8::xcd_remap((int)L, nwg);
        const int nig = 8 * nN, gid = wgid / nig, fm = gid * 8, gsz = (ntiles - fm) < 8 ? (ntiles - fm) : 8;
        const int rt_ = fm + ((wgid % nig) % gsz), pn = (wgid % nig) / gsz;
        const int e = __builtin_amdgcn_readfirstlane(ttab[3 * rt_]), row0 = __builtin_amdgcn_readfirstlane(ttab[3 * rt_ + 1]), nv = __builtin_amdgcn_readfirstlane(ttab[3 * rt_ + 2]);
        u.pm = row0; u.pn = pn; u.kind = e < 64 ? 0 : 1; u.aux = e; u.nvalid = nv;
        if (gather) { u.rows = e < 64 ? stok + row0 : nullptr; u.a = e < 64 ? A : A + (size_t)(row0 - 131072) * K; }
        else { u.rows = nullptr; u.a = A + (size_t)row0 * K; }
        u.b = Bt + (size_t)e * bstride + (size_t)pn * 256 * K;
        return true; }
};
__device__ __forceinline__ int build_tiles(Frame& F, const int* cnts, const int* starts, LAS int* tstart, LAS int* ttab) {
    if (F.tid == 0) { int acc = 0; for (int e = 0; e < 64; ++e) { tstart[e] = acc; acc += (cnts[e] + 255) >> 8; } tstart[64] = acc; acc += T / 256; tstart[65] = acc; }
    __syncthreads();
    if (F.tid < 65) { const int e = F.tid, cnt = e < 64 ? cnts[e] : T, st = e < 64 ? starts[e] : 131072, t0 = tstart[e], nt = tstart[e + 1] - t0;
        for (int mt = 0; mt < nt; ++mt) { ttab[3 * (t0 + mt)] = e; ttab[3 * (t0 + mt) + 1] = st + mt * 256; ttab[3 * (t0 + mt) + 2] = (cnt - mt * 256) < 256 ? (cnt - mt * 256) : 256; } }
    __syncthreads();
    return tstart[65];
}
struct EpiGu {
    static constexpr bool PERM = true, TWICE = (EXP_EPI_GU2 != 0), B64 = false, PREF = false; static constexpr int RELAX = 0;
    unsigned char* HB; const float* sw;
    __device__ __forceinline__ void operator()(const f32x4 (&acc)[2][2][4][2], const pg8::Unit& u, int wr, int wc, int fr, int fq) const {
        asm volatile("" : "+v"(fr), "+v"(fq));
        int r0 = wr * 64 + fr, cl = wc * 32 + 8 * fq;
        const int cw = u.pn * 128 + wc * 32 + 16 * (fq >> 1);
        float wv[2][4];
        if (MK_WFOLD) {
#pragma unroll
            for (int ai = 0; ai < 2; ++ai)
#pragma unroll
                for (int m = 0; m < 4; ++m) { const int r = r0 + ai * 128 + m * 16; const int idx = (u.kind == 0) ? u.pm + min(r, u.nvalid - 1) : 0; wv[ai][m] = sw[idx]; }
#pragma unroll
            for (int ai = 0; ai < 2; ++ai)
#pragma unroll
                for (int m = 0; m < 4; ++m) wv[ai][m] = (u.kind == 0) ? 4.f * wv[ai][m] : 4.f;
            asm volatile("" : "+v"(wv[0][0]), "+v"(wv[0][1]), "+v"(wv[0][2]), "+v"(wv[0][3]), "+v"(wv[1][0]), "+v"(wv[1][1]), "+v"(wv[1][2]), "+v"(wv[1][3]));
        }
#pragma unroll
        for (int ai = 0; ai < 2; ++ai)
#pragma unroll
            for (int mp = 0; mp < 2; ++mp) { unsigned x[2][2];
#pragma unroll
                for (int q = 0; q < 2; ++q) { const int m = 2 * mp + q; f32x4 h0, h1;
#pragma unroll
                    for (int j = 0; j < 4; ++j) { h0[j] = siluf(acc[ai][0][m][0][j]) * acc[ai][1][m][0][j]; h1[j] = siluf(acc[ai][0][m][1][j]) * acc[ai][1][m][1][j]; }
                    if (MK_WFOLD) { h0 = h0 * wv[ai][m]; h1 = h1 * wv[ai][m]; }
                    x[q][0] = pk4_fp8(h0[0], h0[1], h0[2], h0[3]); x[q][1] = pk4_fp8(h1[0], h1[1], h1[2], h1[3]); }
                const auto s0 = __builtin_amdgcn_permlane16_swap(x[0][0], x[1][0], false, false), s1 = __builtin_amdgcn_permlane16_swap(x[0][1], x[1][1], false, false);
                const int r = r0 + ai * 128 + (2 * mp + (fq & 1)) * 16;
                if (r < u.nvalid) { const u32x4 ov = {s0[0], s1[0], s0[1], s1[1]}; if (u.wt) st16_wt(HB + (size_t)(u.pm + r) * 512 + cw, ov); else ST16NT(HB + (size_t)(u.pm + r) * 512 + cw, ov); } }
    }
};
#ifndef MK_B64
#define MK_B64 true
#endif
#ifndef MK_SLOT_NT
#define MK_SLOT_NT 0
#endif
#ifndef MK_SWPREF
#define MK_SWPREF false
#endif
constexpr int SWSTASH_OFF = LDSCTL_OFF + 10240;
struct EpiDown {
    static constexpr bool PERM = true, TWICE = (EXP_EPI_DOWN2 != 0), B64 = MK_B64, PREF = MK_SWPREF; static constexpr int RELAX = MK_RELAX9;
    unsigned char* SLOT; const float* sw; unsigned char* DUMP;
    __device__ __forceinline__ void prefetch(const pg8::Unit& u, LAS unsigned char* lds, int par, int tid) const {
        const int wid = __builtin_amdgcn_readfirstlane(tid >> 6), lane = tid & 63;
        if (wid < 4 && u.kind == 0) { const int r = wid * 64 + lane; const float* src = sw + u.pm + min(r, u.nvalid - 1);
            __builtin_amdgcn_global_load_lds((const unsigned*)src, (LAS unsigned*)(lds + SWSTASH_OFF + par * 1024 + wid * 256), 4, 0, 0); }
    }
    __device__ __forceinline__ void operator()(const f32x4 (&acc)[2][2][4][2], const pg8::Unit& u, int wr, int wc, int fr, int fq, const LAS float* stash = nullptr) const {
        asm volatile("" : "+v"(fr), "+v"(fq));
        int r0 = wr * 64 + fr, cl = wc * 32 + 8 * fq;
        float wv[2][4];
#pragma unroll
        for (int ai = 0; ai < 2; ++ai)
#pragma unroll
            for (int m = 0; m < 4; ++m) { const int r = r0 + ai * 128 + m * 16;
                if constexpr (PREF) wv[ai][m] = stash[r];
                else if (MK_WFOLD) wv[ai][m] = 1.f;
                else { const int idx = (u.kind == 0) ? u.pm + min(r, u.nvalid - 1) : 0;
                    wv[ai][m] = sw[idx]; } }
#pragma unroll
        for (int ai = 0; ai < 2; ++ai)
#pragma unroll
            for (int m = 0; m < 4; ++m) wv[ai][m] = MK_WFOLD ? 1.f : (u.kind == 0) ? 64.f * wv[ai][m] : 64.f;
        if (!MK_WFOLD) asm volatile("" : "+v"(wv[0][0]), "+v"(wv[0][1]), "+v"(wv[0][2]), "+v"(wv[0][3]), "+v"(wv[1][0]), "+v"(wv[1][1]), "+v"(wv[1][2]), "+v"(wv[1][3]));
        const int cw = B64 ? wc * 64 + (fq & 1) * 32 + 16 * (fq >> 1) : (fq & 1) * 128 + wc * 32 + 16 * (fq >> 1);
#pragma unroll
        for (int ai = 0; ai < 2; ++ai)
#pragma unroll
            for (int m = 0; m < 4; ++m) { const int r = r0 + ai * 128 + m * 16; const float w = wv[ai][m];
                const f32x4 a0 = MK_WFOLD ? acc[ai][0][m][0] : acc[ai][0][m][0] * w, a1 = MK_WFOLD ? acc[ai][0][m][1] : acc[ai][0][m][1] * w, b0 = MK_WFOLD ? acc[ai][1][m][0] : acc[ai][1][m][0] * w, b1 = MK_WFOLD ? acc[ai][1][m][1] : acc[ai][1][m][1] * w;
                const unsigned x0 = pk4_fp8(a0[0], a0[1], a0[2], a0[3]), x1 = pk4_fp8(a1[0], a1[1], a1[2], a1[3]), y0 = pk4_fp8(b0[0], b0[1], b0[2], b0[3]), y1 = pk4_fp8(b1[0], b1[1], b1[2], b1[3]);
                const auto s0 = __builtin_amdgcn_permlane16_swap(x0, y0, false, false), s1 = __builtin_amdgcn_permlane16_swap(x1, y1, false, false);
                if constexpr (RELAX > 0 && !EXP_NOREDIR) { const u32x4 ov = {s0[0], s1[0], s0[1], s1[1]}; unsigned char* dp = (r < u.nvalid) ? SLOT + (size_t)(u.pm + r) * 2048 + u.pn * 256 + cw : DUMP + (size_t)r * 2048 + u.pn * 256 + cw; ST16NT(dp, ov); }
                else if (r < u.nvalid) { const u32x4 ov = {s0[0], s1[0], s0[1], s1[1]}; if (MK_SLOT_NT) __builtin_nontemporal_store(ov, (u32x4*)(SLOT + (size_t)(u.pm + r) * 2048 + u.pn * 256 + cw)); else if (u.wt) st16_wt(SLOT + (size_t)(u.pm + r) * 2048 + u.pn * 256 + cw, ov); else ST16NT(SLOT + (size_t)(u.pm + r) * 2048 + u.pn * 256 + cw, ov); } }
    }
};
__device__ __forceinline__ void p10_final(Frame& F, const bf16_t* __restrict__ Z, const unsigned char* __restrict__ SLOT, const int* __restrict__ tokpos, const float* __restrict__ mod, const float* __restrict__ lg, const float* __restrict__ lb, float* __restrict__ out) {
    const int gw = F.vcu * NWAVES + F.wave, NGW = F.G * NWAVES;
    int pv = (gw < T) ? tokpos[gw * 8 + (F.lane & 7)] : 0;
    for (int t = gw; t < T; t += NGW) { const int b = t >> 11; const float* g2 = mod + b * 12288 + 5 * 2048;
        int pos[9];
#pragma unroll
        for (int j = 0; j < 8; ++j) pos[j] = __builtin_amdgcn_readlane(pv, j);
        pos[8] = 131072 + t;
        { const int tn = t + NGW; pv = (tn < T) ? tokpos[tn * 8 + (F.lane & 7)] : 0; }
        f32x4 v[4][2]; float s = 0.f;
#pragma unroll
        for (int q = 0; q < 4; ++q) { const int d = 512 * q + 8 * F.lane; f32x4 a0 = {0.f, 0.f, 0.f, 0.f}, a1 = {0.f, 0.f, 0.f, 0.f};
#pragma unroll
            for (int j = 0; j < 9; ++j) { const u32x2 w = MK_RD_NT ? __builtin_nontemporal_load((const u32x2*)(SLOT + (size_t)pos[j] * 2048 + d)) : *(const u32x2*)(SLOT + (size_t)pos[j] * 2048 + d);
                const auto p0 = __builtin_amdgcn_cvt_pk_f32_fp8(w.x, false), p1 = __builtin_amdgcn_cvt_pk_f32_fp8(w.x, true), p2 = __builtin_amdgcn_cvt_pk_f32_fp8(w.y, false), p3 = __builtin_amdgcn_cvt_pk_f32_fp8(w.y, true);
                a0[0] += p0[0]; a0[1] += p0[1]; a0[2] += p1[0]; a0[3] += p1[1]; a1[0] += p2[0]; a1[1] += p2[1]; a1[2] += p3[0]; a1[3] += p3[1]; }
            a0 = a0 * (1.f / 64.f); a1 = a1 * (1.f / 64.f);
            const u32x4 zw = MK_RD_NT ? __builtin_nontemporal_load((const u32x4*)(Z + (size_t)t * D + d)) : *(const u32x4*)(Z + (size_t)t * D + d); const f32x4 z0 = {bf2f(zw.x & 0xffffu), bf2f(zw.x >> 16), bf2f(zw.y & 0xffffu), bf2f(zw.y >> 16)}, z1 = {bf2f(zw.z & 0xffffu), bf2f(zw.z >> 16), bf2f(zw.w & 0xffffu), bf2f(zw.w >> 16)};
            v[q][0] = z0 * ALPHA + (*(const f32x4*)(g2 + d) + 1.f) * a0; v[q][1] = z1 * ALPHA + (*(const f32x4*)(g2 + d + 4) + 1.f) * a1;
            s += ((v[q][0][0] + v[q][0][1]) + (v[q][0][2] + v[q][0][3])) + ((v[q][1][0] + v[q][1][1]) + (v[q][1][2] + v[q][1][3]));
            if (q & 1) asm volatile("" : "+v"(v[q][0]), "+v"(v[q][1]), "+v"(v[q - 1][0]), "+v"(v[q - 1][1]) :: "memory"); }
        const float mean = wave_sum(s) * (1.f / D); float s2 = 0.f;
#pragma unroll
        for (int q = 0; q < 4; ++q)
#pragma unroll
            for (int k = 0; k < 2; ++k) { v[q][k] = v[q][k] - mean; s2 += (v[q][k][0] * v[q][k][0] + v[q][k][1] * v[q][k][1]) + (v[q][k][2] * v[q][k][2] + v[q][k][3] * v[q][k][3]); }
        const float rstd = 1.f / sqrtf(wave_sum(s2) * (1.f / D) + 1e-5f);
#pragma unroll
        for (int q = 0; q < 4; ++q)
#pragma unroll
            for (int k = 0; k < 2; ++k) { const int d = 512 * q + 8 * F.lane + 4 * k; const f32x4 ov = v[q][k] * rstd * *(const f32x4*)(lg + d) + *(const f32x4*)(lb + d); if (MK_OUT_NT) __builtin_nontemporal_store(ov, (f32x4*)(out + (size_t)t * D + d)); else *(f32x4*)(out + (size_t)t * D + d) = ov; }
    }
}
constexpr int N_PHASES = 11;
__global__ void __launch_bounds__(NTHR, 2) mk_fwd(Args args) {
    extern __shared__ __attribute__((aligned(16))) unsigned char lds[];
    Frame F;
    F.lds = (LAS unsigned char*)lds; F.MISC = (volatile LAS unsigned*)(F.lds + MISC_OFF);
    F.tid = threadIdx.x; F.lane = F.tid & 63; F.wave = __builtin_amdgcn_readfirstlane(F.tid >> 6);
    F.G = gridDim.x; { const int bx = blockIdx.x; F.vcu = (F.G % 8 == 0) ? (bx % 8) * (F.G / 8) + bx / 8 : bx; }
    F.ws = args.ws;
    unsigned char* ws = args.ws;
    for (int u = F.tid; u < (LDS_BYTES - LDSCTL_OFF) / 4; u += NTHR) ((LAS unsigned*)(F.lds + LDSCTL_OFF))[u] = 0u;
    __syncthreads();
    const int lo = args.ph_lo, hi = args.ph_hi;
    XcdBarrier bar; bar.bar = (unsigned*)(ws + WL.ctl) + 1024; bar.x = 0; bar.st = nullptr;
    if (hi - lo > 1) bar = xcd_barrier_post((unsigned*)(ws + WL.ctl) + 1024, F.MISC + 8);
#ifndef MK_PHASE_MASK
#define MK_PHASE_MASK 0x7ffu
#endif
#define IN(k) ((((MK_PHASE_MASK) >> (k)) & 1u) && lo <= (k) && (k) < hi)
#define SEAM(k) do { if (IN(k) && IN((k) + 1)) { xcd_barrier(bar); for (int sb_ = 1; sb_ < EXP_BAR_REP; ++sb_) xcd_barrier(bar); } } while (0)
#ifdef MK_PROBE
    unsigned long long* stamps = (unsigned long long*)(ws + WL.ctl + 48 * 1024);
#define STAMP(k) do { if (blockIdx.x == 0 && F.tid == 0) stamps[k] = wall_clock64(); } while (0)
#else
#define STAMP(k) do { } while (0)
#endif
#ifndef EXP_P0_REP
#define EXP_P0_REP 1
#endif
#ifndef MK_P6_LDS
#define MK_P6_LDS 1
#endif
#ifndef EXP_P6_REP
#define EXP_P6_REP 1
#endif
#ifndef MK_CONV_FN1
#define MK_CONV_FN1 p0_convert_experts
#endif
#ifndef MK_P1_KR
#define MK_P1_KR 1
#endif
#ifndef MK_P7_TILES
#define MK_P7_TILES 0
#endif
#ifndef EXP_BT_REP
#define EXP_BT_REP 1
#endif
#ifndef EXP_KR_REP
#define EXP_KR_REP 1
#endif
#ifndef EXP_P7_REP
#define EXP_P7_REP 1
#endif
#ifndef EXP_P10_REP
#define EXP_P10_REP 1
#endif
#ifndef EXP_P1_REP
#define EXP_P1_REP 1
#endif
#ifndef EXP_MOBA_REP
#define EXP_MOBA_REP 1
#endif
#ifndef EXP_MLA_REP
#define EXP_MLA_REP 1
#endif
#ifndef EXP_P2_REP
#define EXP_P2_REP 1
#endif
#ifndef EXP_P5_REP
#define EXP_P5_REP 1
#endif
#ifndef EXP_KM_REP
#define EXP_KM_REP 1
#endif
#ifndef EXP_CONV_REP
#define EXP_CONV_REP 1
#endif
#define MK_CONV_FN(F_, a_) do { _Pragma("unroll 1") for (int cr_ = 0; cr_ < EXP_CONV_REP; ++cr_) MK_CONV_FN1(F_, a_); } while (0)
#ifndef MK_POOL
#define MK_POOL 0
#endif
#ifndef MK_CONV_NG
#define MK_CONV_NG 3
#endif
#ifndef MK_CONV_W4
#define MK_CONV_W4 0
#endif
#ifndef MK_ATT_REV
#define MK_ATT_REV 0
#endif
#ifndef EXP_P9_REP
#define EXP_P9_REP 1
#endif
#ifndef EXP_P8_REP
#define EXP_P8_REP 1
#endif
#ifndef EXP_BAR_REP
#define EXP_BAR_REP 1
#endif
#ifndef MK_P3_SPLIT
#define MK_P3_SPLIT 1
#endif
#ifndef MK_CONV_G4
#define MK_CONV_G4 0
#endif
#ifndef MK_CONV_P4
#define MK_CONV_P4 1
#endif
#ifndef MK_DESYNC_TICKS
#define MK_DESYNC_TICKS 0
#endif
    const unsigned dly = (unsigned)(blockIdx.x >> 3 & 7) * MK_DESYNC_TICKS;
    const float* x = args.in[0]; const float* mod = (const float*)(ws + WL.mod);
    const float* cs128 = (const float*)(ws + WL.cs128); const float* cs64 = (const float*)(ws + WL.cs64);

    STAMP(0);
    if (IN(0)) _Pragma("unroll 1") for (int p0rep_ = 0; p0rep_ < EXP_P0_REP; ++p0rep_) { p0_mod(F, args.in[1], args.in[2], args.in[3], (float*)(ws + WL.mod)); p0_rope_tab(F, (float2*)(ws + WL.cs128), (float2*)(ws + WL.cs64)); p0_convert(F, args, MK_CONV_P4 ? (args.flags & 1u) : args.flags); }
    SEAM(0);
    STAMP(1);
    const bool p1kr = MK_P1_KR && F.G == 256;
    if (IN(1)) { if (p1kr) p1_h1_kr(F, x, mod, ws + WL.h1, ws + WL.win + (size_t)4096 * 2048, cs64, (bf16_t*)(ws + WL.kr)); else p1_h1(F, x, mod, ws + WL.h1); }
    SEAM(1);
    STAMP(2);
    if (IN(2)) {
        if (!p1kr) p2_kr(F, ws + WL.h1, ws + WL.win + (size_t)4096 * 2048, cs64, (bf16_t*)(ws + WL.kr));
        typedef EpiInT<7> EpiIn;
        EpiIn E{(bf16_t*)(ws + WL.qa), (bf16_t*)(ws + WL.ka), (bf16_t*)(ws + WL.va), ws + WL.cq, ws + WL.ckv, (bf16_t*)(ws + WL.kr), (float*)(ws + WL.ssq), cs128, cs64};
        SchedIn Sx; Sx.o.init(64, 16, F.G, (int)blockIdx.x); Sx.A = (const char*)(ws + WL.h1); Sx.Bt = (const char*)(ws + WL.win); Sx.pn0 = 0; Sx.rowb = 2048;
        pg8::gemm_phase<EpiIn, SchedIn, true, true>(F.lds + RING_OFF, 2048, Sx, E, dly);
#if EXP_P2_REP > 1
        asm volatile("" ::: "memory"); pg8::gemm_phase<EpiIn, SchedIn, true, true>(F.lds + RING_OFF, 2048, Sx, E, dly);
#endif
    }
    SEAM(2);
    STAMP(3);
    if (IN(3)) {
        const bool p3_split = MK_P3_SPLIT && F.G == 256;
        if (!p3_split) p3_kmean(F, (const bf16_t*)(ws + WL.ka), (float*)(ws + WL.kmean), F.vcu, F.G);
        SchedMla Sx; Sx.o.init(64, 14, F.G, (int)blockIdx.x); Sx.CQ = (const char*)(ws + WL.cq); Sx.CKV = (const char*)(ws + WL.ckv); Sx.WuqT = (const char*)(ws + WL.wuq); Sx.WukvT = (const char*)(ws + WL.wukv);
        EpiMla E{(bf16_t*)(ws + WL.qmn), (bf16_t*)(ws + WL.qmr), (bf16_t*)(ws + WL.kn), (bf16_t*)(ws + WL.vm), (const float*)(ws + WL.ssq), cs64};
        pg8::gemm_phase<EpiMla, SchedMla, true, true>(F.lds + RING_OFF, 512, Sx, E, dly);
        if (p3_split && blockIdx.x >= 128) _Pragma("unroll 1") for (int kmrep_ = 0; kmrep_ < EXP_KM_REP; ++kmrep_) p3_kmean(F, (const bf16_t*)(ws + WL.ka), (float*)(ws + WL.kmean), (int)blockIdx.x - 128, 128);
    }
    SEAM(3);
    STAMP(4);
    if (IN(4)) {
        att::Tensors Tn{(const bf16_t*)(ws + WL.qa), (const bf16_t*)(ws + WL.ka), (const bf16_t*)(ws + WL.va), (const bf16_t*)(ws + WL.qmn), (const bf16_t*)(ws + WL.qmr), (const bf16_t*)(ws + WL.kn), (const bf16_t*)(ws + WL.kr),
                        (const bf16_t*)(ws + WL.vm), ws + WL.mix, (const float*)(ws + WL.kmean)};
#if MK_CONV_W4
        const int cgrp = (MK_CONV_P4 && (args.flags & 2u)) ? (F.vcu >> 2) & 3 : -1;
        if (cgrp == 0) MK_CONV_FN(F, args);
        if (cgrp == 2) {
            att::phase<true>((char*)lds + RING_OFF, (LAS char*)(F.lds + RING_OFF), Tn, F.vcu, F.G, 0, 2, MK_ATT_REV);
            MK_CONV_FN(F, args);
            att::phase<false>((char*)lds + RING_OFF, (LAS char*)(F.lds + RING_OFF), Tn, F.vcu, F.G, 0, 2, MK_ATT_REV);
        } else {
            att::phase<false>((char*)lds + RING_OFF, (LAS char*)(F.lds + RING_OFF), Tn, F.vcu, F.G, 0, 2, MK_ATT_REV);
            if (cgrp == 1) MK_CONV_FN(F, args);
            att::phase<true>((char*)lds + RING_OFF, (LAS char*)(F.lds + RING_OFF), Tn, F.vcu, F.G, 0, 2, MK_ATT_REV);
        }
        if (cgrp == 3) MK_CONV_FN(F, args);
#else
        const int cy = F.vcu & 3, cgrp = (MK_CONV_P4 && (args.flags & 2u)) ? (MK_CONV_G4 && cy == 3 ? 3 : MK_CONV_NG == 2 ? 2 * ((F.vcu >> 2) & 1) : (F.vcu >> 2) % 3) : -1;
        if (cgrp == 0) MK_CONV_FN(F, args);
        _Pragma("unroll 1") for (int ar_ = 0; ar_ < EXP_MOBA_REP; ++ar_) att::phase<false>((char*)lds + RING_OFF, (LAS char*)(F.lds + RING_OFF), Tn, F.vcu, F.G, 0, 2, MK_ATT_REV);
        if (cgrp == 1) MK_CONV_FN(F, args);
        { const int nseg = cgrp == 3 ? 2 : 1;
#pragma unroll 1
            for (int seg = 0; seg < nseg * EXP_MLA_REP; ++seg) {
                att::phase<true>((char*)lds + RING_OFF, (LAS char*)(F.lds + RING_OFF), Tn, F.vcu, F.G, cgrp == 3 ? seg : 0, cgrp == 3 ? seg + 1 : 2, cgrp == 3 ? 1 : MK_ATT_REV);
                if (cgrp == 3 && seg == 0) MK_CONV_FN(F, args); } }
        if (cgrp == 2) MK_CONV_FN(F, args);
#endif
    }
    SEAM(4);
    STAMP(5);
    if (IN(5)) {
        SchedOut Sx; Sx.o.init(64, 8, F.G, (int)blockIdx.x); Sx.A = (const char*)(ws + WL.mix); Sx.Bt = (const char*)(ws + WL.wo);
        EpiOut E{mod, (bf16_t*)(ws + WL.y)};
        pg8::gemm_phase<EpiOut, SchedOut, true, true>(F.lds + RING_OFF, 2048, Sx, E, dly, 0x79797979, 0x79797979);
#if EXP_P5_REP > 1
        asm volatile("" ::: "memory"); pg8::gemm_phase<EpiOut, SchedOut, true, true>(F.lds + RING_OFF, 2048, Sx, E, dly, 0x79797979, 0x79797979);
#endif
    }
    SEAM(5);
    STAMP(6);
    if (IN(6)) {
#if MK_P6_LDS
        p6_ln_route_lds(F, x, (const bf16_t*)(ws + WL.y), mod, args.in[10], args.in[11], (bf16_t*)(ws + WL.x1), ws + WL.h2f8, (const bf16_t*)(ws + WL.wr), args.in[13], (float*)(ws + WL.logits),
                        (unsigned long long*)(ws + WL.tokmask), (float*)(ws + WL.tw), (int*)(ws + WL.hist));
#if EXP_P6_REP > 1
        asm volatile("" ::: "memory");
        p6_ln_route_lds(F, x, (const bf16_t*)(ws + WL.y), mod, args.in[10], args.in[11], (bf16_t*)(ws + WL.x1), ws + WL.h2f8, (const bf16_t*)(ws + WL.wr), args.in[13], (float*)(ws + WL.logits),
                        (unsigned long long*)(ws + WL.tokmask), (float*)(ws + WL.tw), (int*)(ws + WL.hist));
#endif
#else
        _Pragma("unroll 1") for (int p6rep_ = 0; p6rep_ < EXP_P6_REP; ++p6rep_) p6_ln_route(F, x, (const bf16_t*)(ws + WL.y), mod, args.in[10], args.in[11], (bf16_t*)(ws + WL.x1), (bf16_t*)(ws + WL.h2), ws + WL.h2f8, (const bf16_t*)(ws + WL.wr), args.in[13], (float*)(ws + WL.logits),
                             (unsigned long long*)(ws + WL.tokmask), (float*)(ws + WL.tw), (int*)(ws + WL.hist));
#endif
    }
    SEAM(6);
    LAS int* tstart = (LAS int*)(F.lds + LDSCTL_OFF + 1024); LAS int* ttab = (LAS int*)(F.lds + LDSCTL_OFF + 2048);
    STAMP(7);
    if (IN(7)) _Pragma("unroll 1") for (int p7rep_ = 0; p7rep_ < EXP_P7_REP; ++p7rep_) { p7_scatter(F, (const int*)(ws + WL.hist), (const unsigned long long*)(ws + WL.tokmask), (const float*)(ws + WL.tw), (int*)(ws + WL.stok), (float*)(ws + WL.sw), (int*)(ws + WL.tokpos), (int*)(ws + WL.starts), (int*)(ws + WL.cnts), MK_P7_TILES ? tstart : nullptr, ttab); }
    SEAM(7);
#ifndef MK_ALIGN9
#define MK_ALIGN9 true
#endif
    STAMP(8);
    if (IN(8)) {
        const int ntiles = (MK_P7_TILES && IN(7)) ? tstart[65] : build_tiles(F, (const int*)(ws + WL.cnts), (const int*)(ws + WL.starts), tstart, ttab);
        SchedMoe Sx; Sx.ttab = ttab; Sx.ntiles = ntiles; Sx.nN = 4; Sx.G = F.G; Sx.c = (int)blockIdx.x; Sx.K = 2048;
        Sx.A = (const char*)(ws + WL.h2f8); Sx.Bt = (const char*)(ws + WL.wgu); Sx.bstride = (size_t)1024 * 2048; Sx.stok = (const int*)(ws + WL.stok); Sx.gather = true;
        EpiGu E{ws + WL.hb, (const float*)(ws + WL.sw)};
        pg8::gemm_phase<EpiGu, SchedMoe, true, true>(F.lds + RING_OFF, 2048, Sx, E, dly);
        if (MK_POOL && MK_CONV_P4 && (args.flags & 2u)) {
            const int U = ntiles * 4, G = F.G, c = (int)blockIdx.x, N = (U + G - 1) / G, c0 = U - (N - 1) * G, nidle = G - c0;
            if (nidle >= 64) { if (c >= c0) p0_convert_experts(F, args, (c - c0) * NWAVES + F.wave, nidle * NWAVES, CONV_NV1, 1); }
            else p0_convert_experts(F, args, c * NWAVES + F.wave, G * NWAVES, CONV_NV1, 1);
        }
#if EXP_P8_REP > 1
        asm volatile("" ::: "memory"); pg8::gemm_phase<EpiGu, SchedMoe, true, true>(F.lds + RING_OFF, 2048, Sx, E, dly);
#endif
    }
    SEAM(8);
    STAMP(9);
    if (IN(9)) {
        const int ntiles = (MK_P7_TILES && IN(7)) ? tstart[65] : build_tiles(F, (const int*)(ws + WL.cnts), (const int*)(ws + WL.starts), tstart, ttab);
        SchedMoe Sx; Sx.ttab = ttab; Sx.ntiles = ntiles; Sx.nN = 8; Sx.G = F.G; Sx.c = (int)blockIdx.x; Sx.K = 512;
        Sx.A = (const char*)(ws + WL.hb); Sx.Bt = (const char*)(ws + WL.wd); Sx.bstride = (size_t)2048 * 512; Sx.stok = nullptr; Sx.gather = false;
        EpiDown E{ws + WL.slot, (const float*)(ws + WL.sw), ws + WL.h2};
        pg8::gemm_phase<EpiDown, SchedMoe, true, true, MK_ALIGN9>(F.lds + RING_OFF, 512, Sx, E, dly, MK_WFOLD ? 0x7f7f7f7f : 0x79797979, MK_WFOLD ? 0x7d7d7d7d : 0x7f7f7f7f);
#if EXP_P9_REP > 1
        asm volatile("" ::: "memory"); pg8::gemm_phase<EpiDown, SchedMoe, true, true, MK_ALIGN9>(F.lds + RING_OFF, 512, Sx, E, dly, MK_WFOLD ? 0x7f7f7f7f : 0x79797979, MK_WFOLD ? 0x7d7d7d7d : 0x7f7f7f7f);
#endif
    }
    SEAM(9);
    STAMP(10);
    if (IN(10)) _Pragma("unroll 1") for (int p10rep_ = 0; p10rep_ < EXP_P10_REP; ++p10rep_) { p10_final(F, (const bf16_t*)(ws + WL.x1), ws + WL.slot, (const int*)(ws + WL.tokpos), mod, args.in[20], args.in[21], args.out); }
#ifdef MK_PROBE
    xcd_barrier(bar);
    STAMP(11);
    xcd_barrier(bar);
    {
        const double tA = 20.0 * rint((double)(stamps[MK_PROBE_A1 + 1] - stamps[MK_PROBE_A0]) * 0.01 * 0.05), tB = 20.0 * rint((double)(stamps[MK_PROBE_B1 + 1] - stamps[MK_PROBE_B0]) * 0.01 * 0.05);
        const float f = 1.f + (float)sqrt(tA * 1e-5);
#ifdef MK_PROBE_RAW
        for (size_t i = (size_t)blockIdx.x * NTHR + F.tid; i < (size_t)T * D; i += (size_t)F.G * NTHR) args.out[i] = (i == 0) ? 20.f * rintf((float)tB * 0.05f) : 0.f;
        (void)f;
#else
        for (size_t i = (size_t)blockIdx.x * NTHR + F.tid; i < (size_t)T * D; i += (size_t)F.G * NTHR) { float v = args.out[i] * f; if (i == 0) v += 2.f + (float)(tB * 0.1); args.out[i] = v; }
#endif
    }
#endif
#undef IN
#undef SEAM
}

namespace fh {
static int g_grid = 0;
static void setup() {
    if (g_grid) return;
    int dev = 0, cus = 0; hipGetDevice(&dev); hipDeviceGetAttribute(&cus, hipDeviceAttributeMultiprocessorCount, dev);
    hipFuncSetAttribute((const void*)mk_fwd, hipFuncAttributeMaxDynamicSharedMemorySize, LDS_BYTES);
    int per_cu = 0; hipOccupancyMaxActiveBlocksPerMultiprocessor(&per_cu, (const void*)mk_fwd, NTHR, LDS_BYTES); (void)hipGetLastError();
    g_grid = cus > 0 ? cus : 256; if (per_cu < 1) fprintf(stderr, "mk_fwd: occupancy query reports %d blocks/CU\n", per_cu);
}
static void launch(void* const* d_in, float* out, unsigned char* ws, int lo, int hi, unsigned flags, hipStream_t st) {
    setup();
    Args a{}; for (int i = 0; i < 22; ++i) a.in[i] = (const float*)d_in[i];
    a.out = out; a.ws = ws; a.ph_lo = lo; a.ph_hi = hi; a.flags = flags; a.pad = 0;
    hipLaunchKernelGGL(mk_fwd, dim3(g_grid), dim3(NTHR), LDS_BYTES, st, a);
}
}
#ifndef MK_N_LAUNCHES
#define MK_N_LAUNCHES 1
#endif
extern "C" void kernel_launch(void* const* d_in, const int* in_sizes, int n_in, void* d_out, int out_size, void* d_ws, size_t ws_size, hipStream_t stream) {
    (void)in_sizes; (void)n_in; (void)out_size;
    unsigned char* ws = (unsigned char*)d_ws; float* out = (float*)d_out;
    if (ws_size < WL.end) { nvh::run(d_in, out, ws, stream); return; }
    hipMemsetAsync(ws + WL.ctl, 0, CTL_BYTES, stream);
    if (MK_N_LAUNCHES == 1) fh::launch(d_in, out, ws, 0, N_PHASES, 3u, stream);
    else for (int ph = 0; ph < N_PHASES; ++ph) fh::launch(d_in, out, ws, ph, ph + 1, 3u, stream);
}
```
